# Optimizing an MI355X kernel written in HIP

```python
import jax
import jax.numpy as jnp
from jax import lax
import numpy as np

D_MODEL = 1024
BATCH = 8
SEQ = 4096
DEPTH = 4

CTX_LEN = 256
GRID_W = 64

FOURIER_GROUPS = 4
FOURIER_GROUP_DIM = D_MODEL // 8
FOURIER_WIDTH = FOURIER_GROUPS * FOURIER_GROUP_DIM
DN_HEADS = 8
DN_HEAD_DIM = D_MODEL // 8
DN_WIDTH = DN_HEADS * DN_HEAD_DIM
CHUNK = 64
SHORT_CONV = 3
N_DIRS = 2
N_BRANCHES = 2
N_GROUPS = 4
EXPERTS_PER_GROUP = 8
N_EXPERTS = N_GROUPS * EXPERTS_PER_GROUP
TOP_K = 2
EXPERT_DIM = D_MODEL // 2
MOE_BLOCK = 256
N_MOD = 6
EPS = 1e-6

OFF_QKV = 0
OFF_A = OFF_QKV + 3 * DN_WIDTH
OFF_B = OFF_A + N_DIRS * DN_HEADS
OFF_Z = OFF_B + N_DIRS * DN_HEADS
OFF_F = OFF_Z + DN_WIDTH
OFF_G = OFF_F + FOURIER_WIDTH
IN_COLS = OFF_G + N_BRANCHES * D_MODEL

kernel_name = 'hybrid_fourier_gdn_hmoe_diffusion'


def rmsnorm(x, w):
    xf = x.astype(jnp.float32)
    y = xf * lax.rsqrt(jnp.mean(xf * xf, axis=-1, keepdims=True) + EPS)
    return (y * w.astype(jnp.float32)).astype(x.dtype)


def l2norm(x):
    return x * lax.rsqrt(jnp.sum(x * x, axis=-1, keepdims=True) + EPS)


def modulate(h, shift, scale):
    return h * (1 + scale) + shift


def centred_dwconv(x, w):
    taps = w.shape[0]
    half = taps // 2
    t = x.shape[-2]
    xp = jnp.pad(x, [(0, 0)] * (x.ndim - 2) + [(half, half), (0, 0)])
    return sum(w[j] * xp[..., j:j + t, :] for j in range(taps))


def fourier_mix(u):
    b, t, _ = u.shape
    ug = u.astype(jnp.float32).reshape(b, t, FOURIER_GROUPS, FOURIER_GROUP_DIM)
    y = jnp.fft.fftn(ug, axes=(1, 3), norm='ortho').real
    return y.reshape(b, t, FOURIER_WIDTH).astype(u.dtype)


def delta_inputs(p, conv_w, a_log, dt_bias, rows):
    b, t, _ = p.shape
    qkv = p[..., OFF_QKV:OFF_A]
    if rows is None:
        qkv = centred_dwconv(qkv, conv_w)
    else:
        qkv = centred_dwconv(qkv.reshape(b, rows, GRID_W, 3 * DN_WIDTH), conv_w).reshape(b, t, 3 * DN_WIDTH)
    qkv = jax.nn.silu(qkv).astype(jnp.float32)
    q, k, v = (qkv[..., j * DN_WIDTH:(j + 1) * DN_WIDTH].reshape(b, t, DN_HEADS, DN_HEAD_DIM) for j in range(3))
    q = jnp.swapaxes(l2norm(q), 1, 2) * DN_HEAD_DIM ** -0.5
    k = jnp.swapaxes(l2norm(k), 1, 2)
    v = jnp.swapaxes(v, 1, 2)
    a = p[..., OFF_A:OFF_B].astype(jnp.float32).reshape(b, t, N_DIRS, DN_HEADS)
    bg = p[..., OFF_B:OFF_Z].astype(jnp.float32).reshape(b, t, N_DIRS, DN_HEADS)
    g = -jnp.exp(a_log.astype(jnp.float32)) * jax.nn.softplus(a + dt_bias.astype(jnp.float32))
    beta = jax.nn.sigmoid(bg)
    g = jnp.transpose(g, (2, 0, 3, 1))
    beta = jnp.transpose(beta, (2, 0, 3, 1))
    return q, k, v, g, beta


def gated_delta_chunked(q, k, v, g, beta, state0, need_out):
    b, h, t, dk = q.shape
    dv = v.shape[-1]
    n = t // CHUNK
    q, k, v = (u.reshape(b, h, n, CHUNK, u.shape[-1]) for u in (q, k, v))
    beta = beta.reshape(b, h, n, CHUNK)
    gcum = jnp.cumsum(g.reshape(b, h, n, CHUNK), axis=-1)
    tri = jnp.tril(jnp.ones((CHUNK, CHUNK), bool))
    strict = jnp.tril(jnp.ones((CHUNK, CHUNK), bool), -1)
    diff = gcum[..., :, None] - gcum[..., None, :]
    decay = jnp.where(tri, jnp.exp(jnp.where(tri, diff, 0.0)), 0.0)
    kk = jnp.einsum('bhnid,bhnjd->bhnij', k, k)
    lower = jnp.where(strict, beta[..., :, None] * kk * decay, 0.0)
    rhs = jnp.concatenate([v * beta[..., None], k * (beta * jnp.exp(gcum))[..., None]], axis=-1)
    sol = lax.linalg.triangular_solve(lower + jnp.eye(CHUNK, dtype=jnp.float32), rhs,
                                      left_side=True, lower=True, unit_diagonal=True)
    u, w = sol[..., :dv], sol[..., dv:]
    g_last = gcum[..., -1]
    k_tail = k * jnp.exp(g_last[..., None] - gcum)[..., None]
    seq_in = (k_tail, u, w, g_last)
    if need_out:
        q_dec = q * jnp.exp(gcum)[..., None]
        qk = jnp.einsum('bhnid,bhnjd->bhnij', q, k) * decay
        seq_in = seq_in + (q_dec, qk)
    seq_in = tuple(jnp.moveaxis(s, 2, 0) for s in seq_in)

    def step(state, xs):
        k_c, u_c, w_c, gl_c = xs[:4]
        v_new = u_c - jnp.einsum('bhck,bhkv->bhcv', w_c, state)
        new_state = state * jnp.exp(gl_c)[..., None, None] + jnp.einsum('bhck,bhcv->bhkv', k_c, v_new)
        if not need_out:
            return new_state, None
        q_c, qk_c = xs[4:]
        o = jnp.einsum('bhck,bhkv->bhcv', q_c, state) + jnp.einsum('bhcs,bhsv->bhcv', qk_c, v_new)
        return new_state, o

    final, o = lax.scan(step, state0, seq_in)
    if not need_out:
        return None, final
    return jnp.moveaxis(o, 0, 2).reshape(b, h, t, dv), final


def bidir_gated_delta(ctx_in, lat_in, need_ctx_out):
    qc, kc, vc, gc, bc = ctx_in
    ql, kl, vl, gl, bl = lat_in
    zero = jnp.zeros((ql.shape[0], DN_HEADS, DN_HEAD_DIM, DN_HEAD_DIM), jnp.float32)
    rev = lambda s: jnp.flip(s, axis=2)
    oc_f, s_f = gated_delta_chunked(qc, kc, vc, gc[0], bc[0], zero, need_ctx_out)
    ol_f, _ = gated_delta_chunked(ql, kl, vl, gl[0], bl[0], s_f, True)
    oc_b, s_b = gated_delta_chunked(rev(qc), rev(kc), rev(vc), rev(gc[1]), rev(bc[1]), zero, need_ctx_out)
    ol_b, _ = gated_delta_chunked(rev(ql), rev(kl), rev(vl), rev(gl[1]), rev(bl[1]), s_b, True)
    o_ctx = oc_f + rev(oc_b) if need_ctx_out else None
    return o_ctx, ol_f + rev(ol_b)


def branch_merge(p, o, w_fourier, w_delta, w_out, out_norm):
    b, t, _ = p.shape
    z = p[..., OFF_Z:OFF_F].reshape(b, t, DN_HEADS, DN_HEAD_DIM).astype(jnp.float32)
    o = jnp.swapaxes(o, 1, 2)
    od = (rmsnorm(o, out_norm) * jax.nn.silu(z)).astype(p.dtype).reshape(b, t, DN_WIDTH)
    pa = fourier_mix(p[..., OFF_F:OFF_G]) @ w_fourier
    pb = od @ w_delta
    gates = jax.nn.sigmoid(p[..., OFF_G:])
    return (gates[..., :D_MODEL] * pa + gates[..., D_MODEL:] * pb) @ w_out


def hier_moe(h, w_rg, b_rg, w_re, b_re, w_gate, w_up, w_down):
    n, d = h.shape
    lg = (h @ w_rg).astype(jnp.float32) + b_rg.astype(jnp.float32)
    grp = jnp.argmax(lg, axis=-1).astype(jnp.int32)
    p_grp = jnp.take_along_axis(jax.nn.softmax(lg, axis=-1), grp[:, None], axis=-1)
    le = ((h @ w_re).astype(jnp.float32) + b_re.astype(jnp.float32)).reshape(n, N_GROUPS, EXPERTS_PER_GROUP)
    le = jnp.take_along_axis(le, grp[:, None, None], axis=1)[:, 0]
    top_v, top_i = lax.top_k(le, TOP_K)
    comb = (p_grp * jax.nn.softmax(top_v, axis=-1)).astype(h.dtype)
    eid = (grp[:, None] * EXPERTS_PER_GROUP + top_i).reshape(-1).astype(jnp.int32)
    n_assign = n * TOP_K
    tok = jnp.arange(n_assign, dtype=jnp.int32) // TOP_K
    order = jnp.argsort(eid)
    e_sorted = eid[order]
    counts = jnp.bincount(eid, length=N_EXPERTS).astype(jnp.int32)
    padded = (counts + MOE_BLOCK - 1) // MOE_BLOCK * MOE_BLOCK
    pad_end = jnp.cumsum(padded)
    pad_start = pad_end - padded
    start = jnp.cumsum(counts) - counts
    slot = pad_start[e_sorted] + jnp.arange(n_assign, dtype=jnp.int32) - start[e_sorted]
    n_slots = -(-n_assign // MOE_BLOCK) * MOE_BLOCK + N_EXPERTS * MOE_BLOCK
    n_blocks = n_slots // MOE_BLOCK
    slot_tok = jnp.full((n_slots,), n, jnp.int32).at[slot].set(tok[order])
    h_pad = jnp.concatenate([h, jnp.zeros((1, d), h.dtype)], axis=0)
    xs = h_pad[slot_tok].reshape(n_blocks, MOE_BLOCK, d)
    blk_start = jnp.arange(n_blocks, dtype=jnp.int32) * MOE_BLOCK
    blk_e = jnp.minimum(jnp.searchsorted(pad_end, blk_start, side='right'), N_EXPERTS - 1).astype(jnp.int32)

    def expert_block(args):
        xb, e = args
        return (jax.nn.silu(xb @ w_gate[e]) * (xb @ w_up[e])) @ w_down[e]

    ys = lax.map(expert_block, (xs, blk_e)).reshape(n_slots, d)
    slot_of = jnp.zeros((n_assign,), jnp.int32).at[order].set(slot)
    y = ys[slot_of].reshape(n, TOP_K, d)
    return jnp.einsum('nkd,nk->nd', y, comb)


def setup_inputs(seed: int = 0) -> dict:
    key = jax.random.key(seed)
    ks = jax.random.split(key, 26)
    f32 = jnp.float32
    nrm = lambda k, shape, fan_in: jax.random.normal(k, shape, f32) * fan_in ** -0.5
    dt = jnp.exp(jax.random.uniform(ks[9], (DEPTH, N_DIRS, DN_HEADS), f32, np.log(1e-3), np.log(1e-1)))
    return {
        'x': jax.random.normal(ks[0], (BATCH, SEQ, D_MODEL), f32),
        'c': jax.random.normal(ks[1], (BATCH, D_MODEL), f32),
        'ctx': jax.random.normal(ks[2], (BATCH, CTX_LEN, D_MODEL), f32),
        'c_ctx': jax.random.normal(ks[3], (D_MODEL,), f32),
        'w_mod': 0.02 * jax.random.normal(ks[4], (DEPTH, D_MODEL, N_MOD * D_MODEL), f32),
        'b_mod': 0.02 * jax.random.normal(ks[5], (DEPTH, N_MOD * D_MODEL), f32),
        'norm_mix': 1.0 + 0.05 * jax.random.normal(ks[6], (DEPTH, D_MODEL), f32),
        'norm_ffn': 1.0 + 0.05 * jax.random.normal(ks[7], (DEPTH, D_MODEL), f32),
        'w_in': nrm(ks[8], (DEPTH, D_MODEL, IN_COLS), D_MODEL),
        'conv_w': nrm(ks[10], (DEPTH, SHORT_CONV, 3 * DN_WIDTH), SHORT_CONV),
        'a_log': jnp.log(jax.random.uniform(ks[11], (DEPTH, N_DIRS, DN_HEADS), f32, 1.0, 16.0)),
        'dt_bias': dt + jnp.log(-jnp.expm1(-dt)),
        'out_norm': 1.0 + 0.05 * jax.random.normal(ks[12], (DEPTH, DN_HEAD_DIM), f32),
        'w_fourier': nrm(ks[13], (DEPTH, FOURIER_WIDTH, D_MODEL), FOURIER_WIDTH),
        'w_delta': nrm(ks[14], (DEPTH, DN_WIDTH, D_MODEL), DN_WIDTH),
        'w_out': nrm(ks[15], (DEPTH, D_MODEL, D_MODEL), D_MODEL),
        'w_route_group': nrm(ks[16], (DEPTH, D_MODEL, N_GROUPS), D_MODEL),
        'b_route_group': 0.01 * jax.random.normal(ks[17], (DEPTH, N_GROUPS), f32),
        'w_route_expert': nrm(ks[18], (DEPTH, D_MODEL, N_EXPERTS), D_MODEL),
        'b_route_expert': 0.01 * jax.random.normal(ks[19], (DEPTH, N_EXPERTS), f32),
        'w_gate': nrm(ks[20], (DEPTH, N_EXPERTS, D_MODEL, EXPERT_DIM), D_MODEL),
        'w_up': nrm(ks[21], (DEPTH, N_EXPERTS, D_MODEL, EXPERT_DIM), D_MODEL),
        'w_down': nrm(ks[22], (DEPTH, N_EXPERTS, EXPERT_DIM, D_MODEL), EXPERT_DIM),
        'final_norm': 1.0 + 0.05 * jax.random.normal(ks[23], (D_MODEL,), f32),
    }


def reference(x, c, ctx, c_ctx, w_mod, b_mod, norm_mix, norm_ffn, w_in, conv_w, a_log, dt_bias, out_norm,
              w_fourier, w_delta, w_out, w_route_group, b_route_group, w_route_expert, b_route_expert,
              w_gate, w_up, w_down, final_norm):
    bsz, seq, d = x.shape
    rows = seq // GRID_W
    xl, xc = x, ctx
    s_lat = jax.nn.silu(c)
    s_ctx = jax.nn.silu(c_ctx)
    for i in range(DEPTH):
        need_ctx = i < DEPTH - 1
        sh1_l, sc1_l, g1_l, sh2_l, sc2_l, g2_l = jnp.split(s_lat @ w_mod[i] + b_mod[i], N_MOD, axis=-1)
        sh1_c, sc1_c, g1_c, sh2_c, sc2_c, g2_c = jnp.split(s_ctx @ w_mod[i] + b_mod[i], N_MOD, axis=-1)

        hl = modulate(rmsnorm(xl, norm_mix[i]), sh1_l[:, None], sc1_l[:, None])
        hc = modulate(rmsnorm(xc, norm_mix[i]), sh1_c, sc1_c)
        pl = hl @ w_in[i]
        pc = hc @ (w_in[i] if need_ctx else w_in[i][:, :OFF_Z])
        lat_in = delta_inputs(pl, conv_w[i], a_log[i], dt_bias[i], rows)
        ctx_in = delta_inputs(pc, conv_w[i], a_log[i], dt_bias[i], None)
        o_ctx, o_lat = bidir_gated_delta(ctx_in, lat_in, need_ctx)
        xl = xl + g1_l[:, None] * branch_merge(pl, o_lat, w_fourier[i], w_delta[i], w_out[i], out_norm[i])
        if need_ctx:
            xc = xc + g1_c * branch_merge(pc, o_ctx, w_fourier[i], w_delta[i], w_out[i], out_norm[i])

        hl2 = modulate(rmsnorm(xl, norm_ffn[i]), sh2_l[:, None], sc2_l[:, None]).reshape(-1, d)
        moe_args = (w_route_group[i], b_route_group[i], w_route_expert[i], b_route_expert[i],
                    w_gate[i], w_up[i], w_down[i])
        if need_ctx:
            hc2 = modulate(rmsnorm(xc, norm_ffn[i]), sh2_c, sc2_c).reshape(-1, d)
            n_ctx = hc2.shape[0]
            y = hier_moe(jnp.concatenate([hc2, hl2], axis=0), *moe_args)
            xc = xc + g2_c * y[:n_ctx].reshape(xc.shape)
            yl = y[n_ctx:]
        else:
            yl = hier_moe(hl2, *moe_args)
        xl = xl + g2_l[:, None] * yl.reshape(xl.shape)
    return rmsnorm(xl, final_norm)
```

```cpp
#include <hip/hip_runtime.h>
#include <cstdio>
#include <cstdint>

#ifndef ONE_LAUNCH
#define ONE_LAUNCH 0
#endif
#ifndef PHMASK
#define PHMASK 0xFFFFu
#endif
#define PHON(k) ((PHMASK >> (k)) & 1u)

#define GAS __attribute__((address_space(1)))
#define LAS __attribute__((address_space(3)))
typedef unsigned short bf16;
typedef short bf16x8 __attribute__((ext_vector_type(8)));
typedef float f32x4 __attribute__((ext_vector_type(4)));
typedef float f32x2 __attribute__((ext_vector_type(2)));
typedef unsigned u32x4 __attribute__((ext_vector_type(4)));
typedef unsigned u32x2 __attribute__((ext_vector_type(2)));

constexpr int D = 1024, NB = 8, SEQ = 4096, DEPTH = 4, CTXL = 256;
constexpr int NCTX = NB * CTXL;
constexpr int NLAT = NB * SEQ;
constexpr int NTOK = NCTX + NLAT;
constexpr int NTILE = NTOK / 256;
constexpr int IN_COLS = 6688, OFF_A = 3072, OFF_Z = 3104, OFF_F = 4128, OFF_G = 4640;
constexpr int PM_LD = 6400;
constexpr int PM_Z = 3072, PM_GA = 4096, PM_GB = 5120, PM_AB = 6144;
constexpr int WIN_ROWS = 6912;
constexpr int NEXP = 32, EDIM = 512, NSLOT = 77824, MAXTILES = 304;
constexpr float EPS = 1e-6f;

constexpr size_t MiB = 1u << 20;
constexpr size_t WS_CTL = 0, CTL_ZERO_BYTES = 1 * MiB;
constexpr size_t WS_MOD = 1 * MiB;
constexpr size_t WS_X = 2 * MiB;
constexpr size_t WS_WIN = WS_X + 136 * MiB;
constexpr size_t WS_WPA = WS_WIN + 54 * MiB;
constexpr size_t WS_WDL = WS_WPA + 8 * MiB;
constexpr size_t WS_WOUT = WS_WDL + 8 * MiB;
constexpr size_t WS_DFTL = WS_WOUT + 8 * MiB;
constexpr size_t WS_DFTC = WS_DFTL + 64 * MiB;
constexpr size_t WS_MOEW = WS_DFTC + 1 * MiB;
constexpr size_t WS_MOEWD = WS_MOEW + 64 * MiB;
constexpr size_t WS_H = WS_MOEW + 96 * MiB;
constexpr size_t WS_PM = WS_H + 68 * MiB;
constexpr size_t WS_XS = WS_PM;
constexpr size_t WS_HID = WS_XS + 152 * MiB;
constexpr size_t WS_YS = WS_HID + 76 * MiB;
constexpr size_t WS_UTL = WS_PM + 425 * MiB;
constexpr size_t WS_UTC = WS_UTL + 32 * MiB;
constexpr size_t WS_PBUF = WS_UTC + 2 * MiB;
constexpr size_t WS_OF = WS_PBUF + 68 * MiB;
constexpr size_t WS_OB = WS_OF + 68 * MiB;
constexpr size_t WS_GB = WS_OB + 68 * MiB;
constexpr size_t WS_ROUTE = WS_GB + 5 * MiB;
constexpr size_t WS_END = WS_ROUTE + 1 * MiB;
static_assert(WS_YS + 152 * MiB <= WS_UTL, "MoE overlay fits inside PM");
static_assert(WS_END <= 1145ull * MiB, "d_ws budget");
constexpr int CW_BAR = 4096;
constexpr int CW_CNT = 16384;
constexpr int CW_CUR = 16384 + 1024;

constexpr int LDS_SCRATCH = 151552;
constexpr int LDSCTL_OFF = LDS_SCRATCH;
constexpr int LDS_BYTES = LDS_SCRATCH + 4096;

#define LDS_WAIT() asm volatile("s_waitcnt lgkmcnt(0)" ::: "memory")
#define VM_WAIT() asm volatile("s_waitcnt vmcnt(0)" ::: "memory")

__device__ __forceinline__ unsigned f2bf(float f) { unsigned u = __builtin_bit_cast(unsigned, f); return (u + 0x7fffu + ((u >> 16) & 1u)) >> 16; }
__device__ __forceinline__ unsigned pk2(float lo, float hi) { return f2bf(lo) | (f2bf(hi) << 16); }
__device__ __forceinline__ float bf_lo(unsigned w) { return __builtin_bit_cast(float, w << 16); }
__device__ __forceinline__ float bf_hi(unsigned w) { return __builtin_bit_cast(float, w & 0xffff0000u); }
__device__ __forceinline__ float bf2f(bf16 b) { return __builtin_bit_cast(float, (unsigned)b << 16); }
__device__ __forceinline__ float sigmoidf_(float x) { return 1.f / (1.f + __expf(-x)); }
__device__ __forceinline__ float siluf_(float x) { return x / (1.f + __expf(-x)); }
__device__ __forceinline__ float wave_sum(float v) {
#pragma unroll
    for (int o = 1; o < 64; o <<= 1) v += __shfl_xor(v, o);
    return v;
}

#define XB_TMO      128
#define XB_XCNT(j)  (256  + 64 * (j))
#define XB_XSUB(j)  (1280 + 64 * (j))
#define XB_XGEN(j)  (2304 + 64 * (j))
#define XB_TOP      3328
#define XB_TOPGEN   3392
#define XCD_BAR_WORDS 3456
#define XB_SPIN_CAP (1u << 18)
__device__ __forceinline__ unsigned xb_ld(unsigned* p)              { return __hip_atomic_load(p, __ATOMIC_RELAXED, __HIP_MEMORY_SCOPE_AGENT); }
__device__ __forceinline__ unsigned xb_add(unsigned* p, unsigned v) { return __hip_atomic_fetch_add(p, v, __ATOMIC_RELAXED, __HIP_MEMORY_SCOPE_AGENT); }
__device__ __forceinline__ unsigned xb_xcc_id() { return (unsigned)__builtin_amdgcn_s_getreg((3 << 11) | 20) & 0xFu; }
#define XB_SPIN(cond, bar) do { unsigned _sp = 0; while (cond) { __builtin_amdgcn_s_sleep(1); \
    if ((++_sp & 255u) == 0u) { if (xb_ld(&(bar)[XB_TMO])) break; if (_sp > XB_SPIN_CAP) { atomicAdd(&(bar)[XB_TMO], 1u); break; } } } } while (0)
struct XcdBarrier { unsigned* bar; unsigned x; volatile LAS unsigned* st; };
__device__ __forceinline__ XcdBarrier xcd_barrier_post(unsigned* bar, volatile LAS unsigned* st) {
    XcdBarrier b; b.bar = bar; b.x = xb_xcc_id(); b.st = st;
    if (threadIdx.x == 0) (void)xb_add(&bar[XB_XCNT(b.x)], 1u);
    return b;
}
__device__ __forceinline__ void xcd_barrier_complete(unsigned* bar, unsigned x, unsigned& nloc, unsigned& nx) {
    const unsigned G = gridDim.x * gridDim.y * gridDim.z;
    unsigned sum, cnt, mine, sp = 0u;
    for (;;) {
        sum = 0u; cnt = 0u; mine = 0u;
#pragma unroll
        for (unsigned j = 0; j < 16; ++j) { const unsigned c = xb_ld(&bar[XB_XCNT(j)]); sum += c; cnt += (c > 0u) ? 1u : 0u; mine = (j == x) ? c : mine; }
        if (sum == G) break;
        __builtin_amdgcn_s_sleep(1);
        if ((++sp & 255u) == 0u) { if (xb_ld(&bar[XB_TMO])) break; if (sp > XB_SPIN_CAP) { atomicAdd(&bar[XB_TMO], 1u); break; } }
    }
    nloc = mine > 0u ? mine : 1u; nx = cnt > 0u ? cnt : 1u;
}
__device__ __forceinline__ void xcd_barrier(const XcdBarrier& b) {
    asm volatile("s_waitcnt vmcnt(0)" ::: "memory");
    __syncthreads();
    if (threadIdx.x == 0) {
        unsigned* bar = b.bar;
        __builtin_amdgcn_s_waitcnt(0);
        unsigned nloc = b.st[0], nx = b.st[1];
        if (nloc == 0u) { xcd_barrier_complete(bar, b.x, nloc, nx); b.st[0] = nloc; b.st[1] = nx; }
        const unsigned old = xb_add(&bar[XB_XSUB(b.x)], 1u);
        const unsigned gen = old / nloc;
        if (old + 1u == (gen + 1u) * nloc) {
            __builtin_amdgcn_fence(__ATOMIC_RELEASE, "agent");
            asm volatile("s_waitcnt vmcnt(0)" ::: "memory");
            const unsigned og = xb_add(&bar[XB_TOP], 1u);
            const unsigned tg = og / nx;
            if (og + 1u == (tg + 1u) * nx) xb_add(&bar[XB_TOPGEN], 1u);
            else XB_SPIN(xb_ld(&bar[XB_TOPGEN]) == tg, bar);
            __builtin_amdgcn_fence(__ATOMIC_ACQUIRE, "agent");
            xb_add(&bar[XB_XGEN(b.x)], 1u);
            asm volatile("s_waitcnt vmcnt(0)" ::: "memory");
        } else {
            XB_SPIN(xb_ld(&bar[XB_XGEN(b.x)]) == gen, bar);
            __builtin_amdgcn_fence(__ATOMIC_ACQUIRE, "agent");
            asm volatile("s_waitcnt vmcnt(0)" ::: "memory");
        }
    }
    __syncthreads();
}

namespace pg8 {
constexpr int BM = 256, BK = 64, HALF = 128, HTB = HALF * BK * 2, STAGE_BYTES = 8 * HTB, NXCD = 8, WGM = 8;
__device__ __forceinline__ int lds_byte(int r, int c) { const int st = (r >> 4) * 2 + (c >> 5), rr = r & 15, cc = c & 31, ob = rr * 64 + cc * 2; return st * 1024 + (ob ^ (((ob >> 9) & 1) << 5)); }
__device__ __forceinline__ void stage_rc(int b, int& R, int& C) { const int st = b / 1024, sb = b % 1024, swz = sb ^ (((sb >> 9) & 1) << 5); R = (st >> 1) * 16 + swz / 64; C = (st & 1) * 32 + (swz % 64) / 2; }
__device__ __forceinline__ int perm32(int rho) { const int n = rho >> 4, i = rho & 15; return 8 * (i >> 2) + 4 * n + (i & 3); }
__device__ __forceinline__ unsigned cvt_pk_bf16(float lo, float hi) { unsigned r; asm volatile("v_cvt_pk_bf16_f32 %0, %1, %2" : "=v"(r) : "v"(lo), "v"(hi)); return r; }

struct Unit { int pm, pn, aux; };

__device__ __forceinline__ void tile_map(int L, int nM, int nN, int& pm, int& pn) {
    const int nwg = nM * nN; int wgid = L;
    { const int q = nwg / NXCD, r = nwg % NXCD, xcd = wgid % NXCD, off = wgid / NXCD; wgid = (xcd < r ? xcd * (q + 1) : r * (q + 1) + (xcd - r) * q) + off; }
    const int nig = WGM * nN, gid = wgid / nig, fm = gid * WGM, gsz = (nM - fm) < WGM ? (nM - fm) : WGM;
    pm = fm + ((wgid % nig) % gsz); pn = (wgid % nig) / gsz;
}

template <class Epi, class Sched>
__device__ __forceinline__ void gemm_phase(LAS unsigned char* lds_v, const int lda, const int ldb, const int K, const Sched& S, const Epi& E) {
    LAS unsigned char* lds = (LAS unsigned char*)(size_t)(unsigned)__builtin_amdgcn_readfirstlane((int)(size_t)lds_v);
    int tid_ = threadIdx.x; asm volatile("" : "+v"(tid_));
    const int tid = tid_, wid = __builtin_amdgcn_readfirstlane(tid >> 6), lane = tid & 63, wr = wid >> 2, wc = wid & 3, fr = lane & 15, fq = lane >> 4;
    const int nt = K / BK;
    unsigned voffA[2], voffB[2];
#pragma unroll
    for (int i = 0; i < 2; ++i) { int R, C; stage_rc(tid * 16 + i * 8192, R, C); const int Rb = Epi::PERM ? ((R & ~31) + perm32(R & 31)) : R;
        voffA[i] = (unsigned)(R * lda + C) * 2u; voffB[i] = (unsigned)(Rb * ldb + C) * 2u; }
    const size_t kstep = (size_t)(BK * 2);
    const unsigned hstepA = (unsigned)(HALF * lda * 2), hstepB = (unsigned)(HALF * ldb * 2);
    const unsigned ldsw = (unsigned)wid * 1024u;
    const int aoff = lds_byte(wr * 64 + fr, fq * 8), boff = lds_byte(wc * 32 + fr, fq * 8);
#define PG8_SA(b, h) (((b) * 2 + (h)) * HTB)
#define PG8_SB(b, h) ((4 + (b) * 2 + (h)) * HTB)
#define PG8_STAGE(bufoff, gbase, voff) do { _Pragma("unroll") for (int _i = 0; _i < 2; ++_i) \
        __builtin_amdgcn_global_load_lds((const unsigned*)((const char*)(gbase) + (voff)[_i]), (LAS unsigned*)(lds + (bufoff) + ldsw + _i * 8192), 16, 0, 0); } while (0)
#define PG8_LDA(dst, b, h) do { _Pragma("unroll") for (int m = 0; m < 4; ++m) _Pragma("unroll") for (int k = 0; k < 2; ++k) dst[m][k] = *(const LAS bf16x8*)(lds + PG8_SA(b, h) + aoff + m * 2048 + k * 1024); } while (0)
#define PG8_LDB(dst, b, h) do { _Pragma("unroll") for (int n = 0; n < 2; ++n) _Pragma("unroll") for (int k = 0; k < 2; ++k) dst[n][k] = *(const LAS bf16x8*)(lds + PG8_SB(b, h) + boff + n * 2048 + k * 1024); } while (0)
#define PG8_MMA(ai, bj, At, Bt) do { __builtin_amdgcn_s_setprio(1); _Pragma("unroll") for (int m = 0; m < 4; ++m) _Pragma("unroll") for (int n = 0; n < 2; ++n) _Pragma("unroll") for (int k = 0; k < 2; ++k) \
        acc[ai][bj][m][n] = __builtin_amdgcn_mfma_f32_16x16x32_bf16(Bt[n][k], At[m][k], acc[ai][bj][m][n], 0, 0, 0); __builtin_amdgcn_s_setprio(0); } while (0)
#define PG8_WAIT_V(n) asm volatile("s_waitcnt vmcnt(" #n ")" ::: "memory")
#define PG8_WAIT_L(n) asm volatile("s_waitcnt lgkmcnt(" #n ")" ::: "memory")
#define PG8_BAR __builtin_amdgcn_s_barrier()
#define PG8_SCHED __builtin_amdgcn_sched_barrier(0)
    Unit cur, nxt; int ui = 0;
    if (!S.next(0, cur)) return;
    f32x4 acc[2][2][4][2];
#pragma unroll
    for (int a = 0; a < 2; ++a)
#pragma unroll
        for (int b = 0; b < 2; ++b)
#pragma unroll
            for (int m = 0; m < 4; ++m)
#pragma unroll
                for (int n = 0; n < 2; ++n) acc[a][b][m][n] = (f32x4){0.f, 0.f, 0.f, 0.f};
    bf16x8 At[4][2], B0[2][2], B1[2][2];
    const char* cA = S.a_ptr(cur); const char* cB = S.b_ptr(cur);
    PG8_STAGE(PG8_SB(0, 0), cB, voffB); PG8_STAGE(PG8_SA(0, 0), cA, voffA); PG8_STAGE(PG8_SB(0, 1), cB + hstepB, voffB); PG8_STAGE(PG8_SA(0, 1), cA + hstepA, voffA);
    if (wr == 1) PG8_BAR;
    PG8_WAIT_V(4); PG8_BAR;
    PG8_STAGE(PG8_SB(1, 0), cB + kstep, voffB); PG8_STAGE(PG8_SA(1, 0), cA + kstep, voffA); PG8_STAGE(PG8_SB(1, 1), cB + hstepB + kstep, voffB);
    PG8_WAIT_V(6); PG8_BAR;
    for (;;) {
        const bool has_next = S.next(ui + 1, nxt);
        const char* nA = has_next ? S.a_ptr(nxt) : cA; const char* nB = has_next ? S.b_ptr(nxt) : cB;
#pragma nounroll
        for (int t = 0; t < nt; t += 2) {
            const bool last = (t == nt - 2);
            const char* a1 = cA + (size_t)(t + 1) * kstep;
            const char* a2 = last ? nA : cA + (size_t)(t + 2) * kstep; const char* b2 = last ? nB : cB + (size_t)(t + 2) * kstep;
            const char* a3 = a2 + kstep; const char* b3 = b2 + kstep;
            PG8_LDB(B0, 0, 0); PG8_SCHED; PG8_LDA(At, 0, 0); PG8_STAGE(PG8_SA(1, 1), a1 + hstepA, voffA);
            PG8_WAIT_L(8); PG8_BAR; PG8_WAIT_L(0); PG8_MMA(0, 0, At, B0); PG8_BAR; PG8_SCHED;
            PG8_LDB(B1, 0, 1); PG8_STAGE(PG8_SB(0, 0), b2, voffB);
            PG8_BAR; PG8_WAIT_L(0); PG8_MMA(0, 1, At, B1); PG8_BAR;
            PG8_LDA(At, 0, 1); PG8_STAGE(PG8_SA(0, 0), a2, voffA);
            PG8_BAR; PG8_WAIT_L(0); PG8_MMA(1, 0, At, B0); PG8_BAR; PG8_SCHED;
            PG8_STAGE(PG8_SB(0, 1), b2 + hstepB, voffB);
            PG8_WAIT_V(6); PG8_BAR; PG8_MMA(1, 1, At, B1); PG8_BAR;
            PG8_LDB(B0, 1, 0); PG8_SCHED; PG8_LDA(At, 1, 0); PG8_STAGE(PG8_SA(0, 1), a2 + hstepA, voffA);
            PG8_WAIT_L(8); PG8_BAR; PG8_WAIT_L(0); PG8_MMA(0, 0, At, B0); PG8_BAR; PG8_SCHED;
            PG8_LDB(B1, 1, 1); PG8_STAGE(PG8_SB(1, 0), b3, voffB);
            PG8_BAR; PG8_WAIT_L(0); PG8_MMA(0, 1, At, B1); PG8_BAR;
            PG8_LDA(At, 1, 1); PG8_STAGE(PG8_SA(1, 0), a3, voffA);
            PG8_BAR; PG8_WAIT_L(0); PG8_MMA(1, 0, At, B0); PG8_BAR; PG8_SCHED;
            PG8_STAGE(PG8_SB(1, 1), b3 + hstepB, voffB);
            PG8_WAIT_V(6); PG8_BAR; PG8_MMA(1, 1, At, B1); PG8_BAR;
        }
        E(acc, cur, wr, wc, fr, fq);
        if (!has_next) break;
#pragma unroll
        for (int a = 0; a < 2; ++a)
#pragma unroll
            for (int b = 0; b < 2; ++b)
#pragma unroll
                for (int m = 0; m < 4; ++m)
#pragma unroll
                    for (int n = 0; n < 2; ++n) acc[a][b][m][n] = (f32x4){0.f, 0.f, 0.f, 0.f};
        cur = nxt; cA = nA; cB = nB; ++ui;
    }
    PG8_WAIT_V(0);
    if (wr == 0) PG8_BAR;
    PG8_BAR;
#undef PG8_SA
#undef PG8_SB
#undef PG8_STAGE
#undef PG8_LDA
#undef PG8_LDB
#undef PG8_MMA
#undef PG8_WAIT_V
#undef PG8_WAIT_L
#undef PG8_BAR
#undef PG8_SCHED
}
}
using pg8::Unit;
using pg8::cvt_pk_bf16;

struct Args { const float* in[24]; float* out; unsigned char* ws; int ph_lo, ph_hi; };
enum { I_X = 0, I_C, I_CTX, I_CCTX, I_WMOD, I_BMOD, I_NMIX, I_NFFN, I_WIN, I_CONVW, I_ALOG, I_DTB, I_ONORM, I_WF, I_WDL, I_WOUT, I_WRG, I_BRG, I_WRE, I_BRE, I_WG, I_WU, I_WD, I_FNORM };

struct Frame {
    LAS unsigned char* lds;
    volatile LAS unsigned* LCTL;
    unsigned char* ws;
    int tid, lane, wave, G, bid;
};
#define WSP(T, off) ((T*)(F.ws + (off)))
__device__ __forceinline__ const float* inp(const Frame& F, int i) {
    const unsigned lo = __builtin_amdgcn_readfirstlane(F.LCTL[512 + 2 * i]), hi = __builtin_amdgcn_readfirstlane(F.LCTL[513 + 2 * i]);
    return (const float*)(((unsigned long long)hi << 32) | lo);
}
#define LAUNDER(F) do { F.tid = threadIdx.x; F.ws = args.ws; F.bid = blockIdx.x; F.G = gridDim.x; F.lds = (LAS unsigned char*)lds; asm volatile("" : "+v"(F.tid), "+s"(F.ws), "+s"(F.bid), "+s"(F.G), "+v"(F.lds)); F.LCTL = (volatile LAS unsigned*)(F.lds + LDSCTL_OFF); F.lane = F.tid & 63; F.wave = __builtin_amdgcn_readfirstlane(F.tid >> 6); } while (0)

__device__ __forceinline__ void transpose_item(const float* W, int ldw, int col0, int K, int N, bf16* WT, int row_off, int row_mul, int row_add, LAS float* scr, int item, int lane) {
    const int nblk = N / 32, kb = item / nblk, nb = item % nblk, k0 = 64 * kb, n0 = 32 * nb;
#pragma unroll 8
    for (int i = 0; i < 32; ++i) { const int kk = 2 * i + (lane >> 5); scr[kk * 33 + (lane & 31)] = W[(size_t)(k0 + kk) * ldw + col0 + n0 + (lane & 31)]; }
    LDS_WAIT(); asm volatile("" ::: "memory");
    const int c = lane & 7;
#pragma unroll
    for (int j = 0; j < 4; ++j) { const int n = (lane >> 3) + 8 * j; const LAS float* s = scr + (8 * c) * 33 + n;
        u32x4 o; o.x = pk2(s[0 * 33], s[1 * 33]); o.y = pk2(s[2 * 33], s[3 * 33]); o.z = pk2(s[4 * 33], s[5 * 33]); o.w = pk2(s[6 * 33], s[7 * 33]);
        *(u32x4*)(WT + (size_t)(row_off + (n0 + n) * row_mul + row_add) * K + k0 + 8 * c) = o; }
    LDS_WAIT(); asm volatile("" ::: "memory");
}

__device__ __forceinline__ void phase_prologue(Frame& F, const Args& a) {
    const int gw = F.bid * 8 + F.wave, NGW = F.G * 8;
    const int gt = F.bid * 512 + F.tid, NGT = F.G * 512;
    LAS float* scr = (LAS float*)(F.lds + F.wave * 8448);
    {
        constexpr int I_QKV = 16 * 96, I_Z = 16 * 32, I_G = 16 * 64, I_AB = 16, I_F = 16 * 16, I_SQ = 16 * 32;
        constexpr int PER_LAYER = I_QKV + I_Z + I_G + I_AB + I_F + 2 * I_SQ;
        for (int it = gw; it < DEPTH * PER_LAYER; it += NGW) {
            const int layer = it / PER_LAYER; int r = it % PER_LAYER;
            const float* win = inp(F, I_WIN) + (size_t)layer * D * IN_COLS;
            bf16* wt = WSP(bf16, WS_WIN) + (size_t)layer * WIN_ROWS * D;
            if (r < I_QKV) { transpose_item(win, IN_COLS, 0, D, 3072, wt, 0, 1, 0, scr, r, F.lane); continue; } r -= I_QKV;
            if (r < I_Z)   { transpose_item(win, IN_COLS, OFF_Z, D, 1024, wt, PM_Z, 1, 0, scr, r, F.lane); continue; } r -= I_Z;
            if (r < I_G)   { transpose_item(win, IN_COLS, OFF_G, D, 2048, wt, PM_GA, 1, 0, scr, r, F.lane); continue; } r -= I_G;
            if (r < I_AB)  { transpose_item(win, IN_COLS, OFF_A, D, 32, wt, PM_AB, 1, 0, scr, r, F.lane); continue; } r -= I_AB;
            if (r < I_F)   { transpose_item(win, IN_COLS, OFF_F, D, 512, wt, PM_LD, 1, 0, scr, r, F.lane); continue; } r -= I_F;
            if (r < I_SQ)  { transpose_item(inp(F, I_WDL) + (size_t)layer * D * D, D, 0, D, D, WSP(bf16, WS_WDL) + (size_t)layer * D * D, 0, 1, 0, scr, r, F.lane); continue; } r -= I_SQ;
            transpose_item(inp(F, I_WOUT) + (size_t)layer * D * D, D, 0, D, D, WSP(bf16, WS_WOUT) + (size_t)layer * D * D, 0, 1, 0, scr, r, F.lane);
        }
        for (int i = gt; i < DEPTH * 224 * (D / 8); i += NGT) { const int layer = i / (224 * 128), rr = i % (224 * 128);
            *(u32x4*)(WSP(bf16, WS_WIN) + ((size_t)layer * WIN_ROWS + 6176) * D + (size_t)rr * 8) = (u32x4){0u, 0u, 0u, 0u}; }
    }
    {
        LAS float* tb = (LAS float*)(F.lds + 8 * 8448);
        if (F.tid < 128) { tb[F.tid] = cospif((float)F.tid / 64.f); tb[128 + F.tid] = -sinpif((float)F.tid / 64.f); }
        __syncthreads();
        for (int it = gw; it < DEPTH * 4 * 2 * 16 * 4; it += NGW) {
            const int cb = it & 3, nb = (it >> 2) & 15, ri = (it >> 6) & 1, g = (it >> 7) & 3, layer = it >> 9;
            const int n = nb * 64 + F.lane;
            const float* wf = inp(F, I_WF) + ((size_t)layer * 512 + g * 128) * D + n;
            float o[32];
#pragma unroll
            for (int q = 0; q < 32; ++q) o[q] = 0.f;
#pragma unroll 4
            for (int cp = 0; cp < 128; ++cp) { const float w = wf[(size_t)cp * D];
#pragma unroll
                for (int q = 0; q < 32; ++q) o[q] += tb[ri * 128 + (((cb * 32 + q) * cp) & 127)] * w; }
            bf16* dst = WSP(bf16, WS_WPA) + ((size_t)layer * D + n) * D + g * 256 + ri * 128 + cb * 32;
#pragma unroll
            for (int q8 = 0; q8 < 4; ++q8) { const float sc_ = 0.08838834764831845f;
                *(u32x4*)(dst + q8 * 8) = (u32x4){pk2(o[q8 * 8] * sc_, o[q8 * 8 + 1] * sc_), pk2(o[q8 * 8 + 2] * sc_, o[q8 * 8 + 3] * sc_), pk2(o[q8 * 8 + 4] * sc_, o[q8 * 8 + 5] * sc_), pk2(o[q8 * 8 + 6] * sc_, o[q8 * 8 + 7] * sc_)}; }
        }
        __syncthreads();
    }
    for (int i = gt; i < 8192 * 512; i += NGT) { const int row = i >> 9, t0 = (i & 511) * 8, ri = row >> 12, tp = row & 4095; float v[8];
#pragma unroll
        for (int q = 0; q < 8; ++q) { const int m = ((t0 + q) * tp) & 4095; const float x = (float)m / 2048.f; v[q] = (ri ? sinpif(x) : cospif(x)) * (1.f / 64.f); }
        *(u32x4*)(WSP(bf16, WS_DFTL) + (size_t)row * 4096 + t0) = (u32x4){pk2(v[0], v[1]), pk2(v[2], v[3]), pk2(v[4], v[5]), pk2(v[6], v[7])}; }
    for (int i = gt; i < 512 * 32; i += NGT) { const int row = i >> 5, t0 = (i & 31) * 8, ri = row >> 8, tp = row & 255; float v[8];
#pragma unroll
        for (int q = 0; q < 8; ++q) { const int m = ((t0 + q) * tp) & 255; const float x = (float)m / 128.f; v[q] = (ri ? sinpif(x) : cospif(x)) * (1.f / 16.f); }
        *(u32x4*)(WSP(bf16, WS_DFTC) + (size_t)row * 256 + t0) = (u32x4){pk2(v[0], v[1]), pk2(v[2], v[3]), pk2(v[4], v[5]), pk2(v[6], v[7])}; }
    { const f32x4* pc_ = (const f32x4*)inp(F, I_CTX); const f32x4* px_ = (const f32x4*)inp(F, I_X);
    for (size_t i = gt; i < (size_t)NTOK * D / 4; i += NGT) {
        const f32x4 v = (i < (size_t)NCTX * D / 4) ? pc_[i] : px_[i - (size_t)NCTX * D / 4];
        WSP(f32x4, WS_X)[i] = v; } }
    {
        LAS float* sc = (LAS float*)(F.lds + 8 * 8448 + 1024);
        { const float* pc_ = inp(F, I_C); const float* pcc_ = inp(F, I_CCTX);
        for (int i = F.tid; i < 9 * 1024; i += 512) { const float v = (i < 8192) ? pc_[i] : pcc_[i - 8192]; sc[i] = siluf_(v); } }
        __syncthreads();
        for (int it = gw; it < DEPTH * 192; it += NGW) {
            const int layer = it / 192, cb = it % 192, col = cb * 32 + (F.lane & 31), kp = F.lane >> 5;
            const float* wm = inp(F, I_WMOD) + (size_t)layer * D * 6144 + col;
            float acc[9];
#pragma unroll
            for (int r = 0; r < 9; ++r) acc[r] = 0.f;
#pragma unroll 4
            for (int k = kp; k < 1024; k += 2) { const float w = wm[(size_t)k * 6144];
#pragma unroll
                for (int r = 0; r < 9; ++r) acc[r] += sc[r * 1024 + k] * w; }
#pragma unroll
            for (int r = 0; r < 9; ++r) acc[r] += __shfl_xor(acc[r], 32);
            if (kp == 0) { const float bm = inp(F, I_BMOD)[layer * 6144 + col];
#pragma unroll
                for (int r = 0; r < 9; ++r) WSP(float, WS_MOD)[((size_t)layer * 9 + r) * 6144 + col] = acc[r] + bm; }
        }
        __syncthreads();
    }
}

__device__ __forceinline__ void moe_weight_convert(Frame& F, const Args& a, int layer, int w0, LAS float* scr) {
    const int nw = 8 - w0, gw = F.bid * nw + (F.wave - w0), NGW = F.G * nw;
    constexpr int PER_E = 768;
    for (int it = gw; it < NEXP * PER_E; it += NGW) {
        const int e = it / PER_E; int r = it % PER_E;
        const size_t eo = ((size_t)layer * NEXP + e) * (size_t)D * EDIM;
        bf16* wgu = WSP(bf16, WS_MOEW) + (size_t)e * 1024 * 1024;
        if (r < 256) { transpose_item(inp(F, I_WG) + eo, EDIM, 0, D, EDIM, wgu, 0, 2, 0, scr, r, F.lane); continue; } r -= 256;
        if (r < 256) { transpose_item(inp(F, I_WU) + eo, EDIM, 0, D, EDIM, wgu, 0, 2, 1, scr, r, F.lane); continue; } r -= 256;
        transpose_item(inp(F, I_WD) + eo, D, 0, EDIM, D, WSP(bf16, WS_MOEWD) + (size_t)e * 1024 * 512, 0, 1, 0, scr, r, F.lane);
    }
}

__device__ __forceinline__ int mod_row(int row) { return row < NCTX ? 8 : ((row - NCTX) >> 12); }

template <int MODE, bool COMBINE>
__device__ __forceinline__ void phase_norm(Frame& F, const Args& a, int layer) {
    const int gw = F.bid * 8 + F.wave, NGW = F.G * 8;
    const f32x4* fwp = (const f32x4*)inp(F, MODE == 1 ? I_FNORM : I_NMIX) + (MODE == 1 ? 0 : layer * 256) + F.lane; f32x4* outp = (f32x4*)inp(F, 24);
    for (int row = gw; row < NTOK; row += NGW) {
        const int mb = mod_row(row);
        f32x4* xr = WSP(f32x4, WS_X) + (size_t)row * 256 + F.lane;
        f32x4 v[4];
#pragma unroll
        for (int j = 0; j < 4; ++j) v[j] = xr[64 * j];
        if (COMBINE) {
            const int* so = WSP(int, WS_ROUTE + 2 * NTOK * 8) + row * 2; const float* cb = WSP(float, WS_ROUTE + NTOK * 8) + row * 2;
            const int s0 = so[0], s1 = so[1]; const float c0 = cb[0], c1 = cb[1];
            const f32x4* g2 = WSP(f32x4, WS_MOD) + ((size_t)(layer - 1) * 9 + mb) * 1536 + 5 * 256 + F.lane;
            const u32x2* y0 = WSP(u32x2, WS_YS) + (size_t)s0 * 256 + F.lane; const u32x2* y1 = WSP(u32x2, WS_YS) + (size_t)s1 * 256 + F.lane;
#pragma unroll
            for (int j = 0; j < 4; ++j) { const u32x2 p = y0[64 * j], q = y1[64 * j]; const f32x4 g = g2[64 * j];
                v[j].x += g.x * (c0 * bf_lo(p.x) + c1 * bf_lo(q.x)); v[j].y += g.y * (c0 * bf_hi(p.x) + c1 * bf_hi(q.x));
                v[j].z += g.z * (c0 * bf_lo(p.y) + c1 * bf_lo(q.y)); v[j].w += g.w * (c0 * bf_hi(p.y) + c1 * bf_hi(q.y));
                if (MODE == 0) xr[64 * j] = v[j]; }
        }
        float ss = 0.f;
#pragma unroll
        for (int j = 0; j < 4; ++j) ss += (v[j].x * v[j].x + v[j].y * v[j].y) + (v[j].z * v[j].z + v[j].w * v[j].w);
        const float r = rsqrtf(wave_sum(ss) * (1.f / 1024.f) + EPS);
        if (MODE == 1) {
            if (row >= NCTX) { const f32x4* fw = fwp; f32x4* o = outp + (size_t)(row - NCTX) * 256 + F.lane;
#pragma unroll
                for (int j = 0; j < 4; ++j) o[64 * j] = v[j] * r * fw[64 * j]; }
        } else {
            const f32x4* nw = fwp;
            const f32x4* sh = WSP(f32x4, WS_MOD) + ((size_t)layer * 9 + mb) * 1536 + 0 * 256 + F.lane;
            const f32x4* sc = WSP(f32x4, WS_MOD) + ((size_t)layer * 9 + mb) * 1536 + 1 * 256 + F.lane;
            u32x2* ho = WSP(u32x2, WS_H) + (size_t)row * 256 + F.lane;
#pragma unroll
            for (int j = 0; j < 4; ++j) { const f32x4 h = v[j] * r * nw[64 * j] * (sc[64 * j] + 1.f) + sh[64 * j];
                ho[64 * j] = (u32x2){pk2(h.x, h.y), pk2(h.z, h.w)}; }
        }
    }
}

__device__ __forceinline__ void ffn_row(Frame& F, const f32x4* nw, int layer, int row, f32x4 (&h)[4]) {
    const int mb = mod_row(row);
    const f32x4* xr = WSP(f32x4, WS_X) + (size_t)row * 256 + F.lane;
    f32x4 v[4]; float ss = 0.f;
#pragma unroll
    for (int j = 0; j < 4; ++j) { v[j] = xr[64 * j]; ss += (v[j].x * v[j].x + v[j].y * v[j].y) + (v[j].z * v[j].z + v[j].w * v[j].w); }
    const float r = rsqrtf(wave_sum(ss) * (1.f / 1024.f) + EPS);
    const f32x4* sh = WSP(f32x4, WS_MOD) + ((size_t)layer * 9 + mb) * 1536 + 3 * 256 + F.lane;
    const f32x4* sc = WSP(f32x4, WS_MOD) + ((size_t)layer * 9 + mb) * 1536 + 4 * 256 + F.lane;
#pragma unroll
    for (int j = 0; j < 4; ++j) h[j] = v[j] * r * nw[64 * j] * (sc[64 * j] + 1.f) + sh[64 * j];
}

__device__ __forceinline__ void phase_route(Frame& F, const Args& a, int layer) {
    const int gw = F.bid * 8 + F.wave, NGW = F.G * 8;
    LAS float* wl = (LAS float*)F.lds;
    volatile LAS unsigned* cl = F.LCTL + 64;
    const float* wrg = inp(F, I_WRG) + (size_t)layer * D * 4; const float* wre = inp(F, I_WRE) + (size_t)layer * D * 32;
    for (int i = F.tid; i < 1024 * 4; i += 512) { const int k = i >> 2, j = i & 3; wl[((k >> 2) * 37 + j) * 4 + (k & 3)] = wrg[i]; }
    for (int i = F.tid; i < 1024 * 32; i += 512) { const int k = i >> 5, j = i & 31; wl[((k >> 2) * 37 + 4 + j) * 4 + (k & 3)] = wre[i]; }
    if (F.tid < 32) cl[F.tid] = 0u;
    __syncthreads();
    const float* brg = inp(F, I_BRG) + layer * 4; const float* bre = inp(F, I_BRE) + layer * 32;
    const f32x4* nwp = (const f32x4*)(inp(F, I_NFFN) + layer * D) + F.lane;
    for (int row = gw; row < NTOK; row += NGW) {
        f32x4 h[4]; ffn_row(F, nwp, layer, row, h);
        float lg[4];
#pragma unroll
        for (int g = 0; g < 4; ++g) { float s = 0.f;
#pragma unroll
            for (int j = 0; j < 4; ++j) { const f32x4 w = *(const LAS f32x4*)(wl + ((F.lane + 64 * j) * 37 + g) * 4); s += (h[j].x * w.x + h[j].y * w.y) + (h[j].z * w.z + h[j].w * w.w); }
            lg[g] = wave_sum(s) + brg[g]; }
        int grp = 0; float mx = lg[0];
#pragma unroll
        for (int g = 1; g < 4; ++g) if (lg[g] > mx) { mx = lg[g]; grp = g; }
        float den = 0.f;
#pragma unroll
        for (int g = 0; g < 4; ++g) den += __expf(lg[g] - mx);
        const float pgrp = 1.f / den;
        float le[8];
#pragma unroll
        for (int e = 0; e < 8; ++e) { float s = 0.f;
#pragma unroll
            for (int j = 0; j < 4; ++j) { const f32x4 w = *(const LAS f32x4*)(wl + ((F.lane + 64 * j) * 37 + 4 + grp * 8 + e) * 4); s += (h[j].x * w.x + h[j].y * w.y) + (h[j].z * w.z + h[j].w * w.w); }
            le[e] = wave_sum(s) + bre[grp * 8 + e]; }
        int i0 = 0; float v0 = le[0];
#pragma unroll
        for (int e = 1; e < 8; ++e) if (le[e] > v0) { v0 = le[e]; i0 = e; }
        int i1 = -1; float v1 = -3.0e38f;
#pragma unroll
        for (int e = 0; e < 8; ++e) if (e != i0 && le[e] > v1) { v1 = le[e]; i1 = e; }
        const float e1 = __expf(v1 - v0), inv = 1.f / (1.f + e1);
        if (F.lane == 0) {
            int* eid = WSP(int, WS_ROUTE) + row * 2; float* cb = WSP(float, WS_ROUTE + NTOK * 8) + row * 2;
            eid[0] = grp * 8 + i0; eid[1] = grp * 8 + i1; cb[0] = pgrp * inv; cb[1] = pgrp * e1 * inv;
            __hip_atomic_fetch_add((LAS unsigned*)(cl + grp * 8 + i0), 1u, __ATOMIC_RELAXED, __HIP_MEMORY_SCOPE_WORKGROUP); __hip_atomic_fetch_add((LAS unsigned*)(cl + grp * 8 + i1), 1u, __ATOMIC_RELAXED, __HIP_MEMORY_SCOPE_WORKGROUP);
        }
    }
    __syncthreads();
    if (F.tid < 32) { const unsigned c = cl[F.tid]; if (c) atomicAdd(WSP(unsigned, WS_CTL) + CW_CNT + layer * 64 + F.tid, c); }
}

__device__ __forceinline__ void build_moe_tables(Frame& F, int layer) {
    if (F.tid == 0) {
        const unsigned* cnt = WSP(unsigned, WS_CTL) + CW_CNT + layer * 64;
        unsigned ps = 0; int tile = 0;
        for (int e = 0; e < NEXP; ++e) { const unsigned c = __hip_atomic_load(cnt + e, __ATOMIC_RELAXED, __HIP_MEMORY_SCOPE_AGENT); const unsigned nt = (c + 255u) >> 8;
            F.LCTL[16 + e] = ps; for (unsigned t = 0; t < nt; ++t) F.LCTL[128 + tile++] = (unsigned)e; ps += nt << 8; }
        F.LCTL[16 + NEXP] = ps;
    }
    __syncthreads();
}

__device__ __forceinline__ void phase_assign(Frame& F, const Args& a, int layer) {
    const int gw = F.bid * 8 + F.wave, NGW = F.G * 8;
    build_moe_tables(F, layer);
    const f32x4* nwp = (const f32x4*)(inp(F, I_NFFN) + layer * D) + F.lane;
    int slot = 0;
    { const int it = F.lane >> 1, row = gw + it * NGW;
      if (F.lane < 36 && row < NTOK) { const int e = WSP(int, WS_ROUTE)[row * 2 + (F.lane & 1)];
          slot = (int)F.LCTL[16 + e] + (int)atomicAdd(WSP(unsigned, WS_CTL) + CW_CUR + layer * 64 + e, 1u);
          WSP(int, WS_ROUTE + 2 * NTOK * 8)[row * 2 + (F.lane & 1)] = slot; } }
    int it = 0;
    for (int row = gw; row < NTOK; row += NGW, ++it) {
        const int s0 = __shfl(slot, 2 * it), s1 = __shfl(slot, 2 * it + 1);
        f32x4 h[4]; ffn_row(F, nwp, layer, row, h);
        u32x2* x0 = WSP(u32x2, WS_XS) + (size_t)s0 * 256 + F.lane; u32x2* x1 = WSP(u32x2, WS_XS) + (size_t)s1 * 256 + F.lane;
#pragma unroll
        for (int j = 0; j < 4; ++j) { const u32x2 p = (u32x2){pk2(h[j].x, h[j].y), pk2(h[j].z, h[j].w)}; x0[64 * j] = p; x1[64 * j] = p; }
    }
}

template <int NBLK>
__device__ __forceinline__ void conv_unit(Frame& F, const float* cw, int tok0, int slab) {
    const int r0 = F.tid >> 3, c0 = slab * 128 + (F.tid & 7) * 16;
    const int sect = slab >> 3;
    float w0[16], w1[16], w2[16];
#pragma unroll
    for (int q = 0; q < 16; ++q) { w0[q] = cw[c0 + q]; w1[q] = cw[3072 + c0 + q]; w2[q] = cw[6144 + c0 + q]; }
    float y[NBLK][16];
    constexpr int T = NBLK * 64;
#pragma unroll
    for (int j = 0; j < NBLK; ++j) {
        const int t = r0 + 64 * j;
        const bf16* p = WSP(bf16, WS_PM) + (size_t)(tok0 + t) * PM_LD + c0;
        u32x4 cu[2], pu[2], nu[2];
        cu[0] = *(const u32x4*)p; cu[1] = *(const u32x4*)(p + 8);
        if (t > 0) { pu[0] = *(const u32x4*)(p - PM_LD); pu[1] = *(const u32x4*)(p - PM_LD + 8); } else { pu[0] = pu[1] = (u32x4){0u, 0u, 0u, 0u}; }
        if (t < T - 1) { nu[0] = *(const u32x4*)(p + PM_LD); nu[1] = *(const u32x4*)(p + PM_LD + 8); } else { nu[0] = nu[1] = (u32x4){0u, 0u, 0u, 0u}; }
        float ss = 0.f;
#pragma unroll
        for (int q = 0; q < 16; ++q) { const unsigned cw_ = cu[q >> 3][(q >> 1) & 3], pw_ = pu[q >> 3][(q >> 1) & 3], nw_ = nu[q >> 3][(q >> 1) & 3];
            const float xc = (q & 1) ? bf_hi(cw_) : bf_lo(cw_), xp = (q & 1) ? bf_hi(pw_) : bf_lo(pw_), xn = (q & 1) ? bf_hi(nw_) : bf_lo(nw_);
            const float s = siluf_(w0[q] * xp + w1[q] * xc + w2[q] * xn); y[j][q] = s; ss += s * s; }
        if (sect < 2) { ss += __shfl_xor(ss, 1); ss += __shfl_xor(ss, 2); ss += __shfl_xor(ss, 4);
            const float sc = rsqrtf(ss + EPS) * (sect == 0 ? 0.08838834764831845f : 1.f);
#pragma unroll
            for (int q = 0; q < 16; ++q) y[j][q] *= sc; }
    }
    __syncthreads();
#pragma unroll
    for (int j = 0; j < NBLK; ++j) {
        bf16* p = WSP(bf16, WS_PM) + (size_t)(tok0 + r0 + 64 * j) * PM_LD + c0;
        *(u32x4*)p = (u32x4){pk2(y[j][0], y[j][1]), pk2(y[j][2], y[j][3]), pk2(y[j][4], y[j][5]), pk2(y[j][6], y[j][7])};
        *(u32x4*)(p + 8) = (u32x4){pk2(y[j][8], y[j][9]), pk2(y[j][10], y[j][11]), pk2(y[j][12], y[j][13]), pk2(y[j][14], y[j][15])};
    }
}
__device__ __forceinline__ void phase_conv(Frame& F, const Args& a, int layer) {
    const float* cw = inp(F, I_CONVW) + (size_t)layer * 3 * 3072;
    for (int u = F.bid; u < 8 * 24; u += F.G) conv_unit<4>(F, cw, (u / 24) * 256, u % 24);
    for (int u = F.bid; u < 512 * 24; u += F.G) conv_unit<1>(F, cw, NCTX + (u / 24) * 64, u % 24);
    const int gt = F.bid * 512 + F.tid, NGT = F.G * 512;
    const float dtb_ = inp(F, I_DTB)[layer * 16 + (gt & 15)], ea_ = __expf(inp(F, I_ALOG)[layer * 16 + (gt & 15)]);
    for (int i = gt; i < NTOK * 16; i += NGT) { const int tok = i >> 4, dh = i & 15;
        const bf16* p = WSP(bf16, WS_PM) + (size_t)tok * PM_LD + PM_AB;
        const float av = bf2f(p[dh]) + dtb_, bv = bf2f(p[16 + dh]);
        const float sp = av > 20.f ? av : log1pf(__expf(av));
        WSP(float, WS_GB)[(size_t)dh * NTOK + tok] = -ea_ * sp;
        WSP(float, WS_GB)[(size_t)(16 + dh) * NTOK + tok] = sigmoidf_(bv); }
}

__device__ __forceinline__ int scan_tok(int b, int dir, int s) { return s < 256 ? (b * 256 + (dir ? 255 - s : s)) : (NCTX + b * 4096 + (dir ? 4095 - (s - 256) : (s - 256))); }
__device__ __forceinline__ void scan_naive_unit(Frame& F, int unit, LAS float* base) {
    const int vq = unit & 3, dir = (unit >> 2) & 1, h = (unit >> 3) & 7, b = unit >> 6, lane = F.lane, kh = lane >> 5, vc = lane & 31;
    float S[64];
#pragma unroll
    for (int i = 0; i < 64; ++i) S[i] = 0.f;
    constexpr int BUFW = 4096 + 512 + 32;
    const float* gp = WSP(float, WS_GB) + (size_t)(dir * 8 + h) * NTOK; const float* bp = WSP(float, WS_GB) + (size_t)(16 + dir * 8 + h) * NTOK;
    const bf16* pm = WSP(bf16, WS_PM);
    bf16* obuf = WSP(bf16, dir ? WS_OB : WS_OF);
    u32x4 pq[8]; bf16 pv[8]; float pg = 0.f, pb = 0.f;
#define SCAN_ISSUE(blk) do { \
        _Pragma("unroll") for (int j = 0; j < 8; ++j) { const int id = j * 64 + lane, r = id >> 5, c = id & 31; const int tok = scan_tok(b, dir, (blk) * 16 + r); \
            pq[j] = *(const u32x4*)(pm + (size_t)tok * PM_LD + (c < 16 ? 0 : 1024) + h * 128 + (c & 15) * 8); } \
        _Pragma("unroll") for (int r = 0; r < 8; ++r) { const int tok = scan_tok(b, dir, (blk) * 16 + kh * 8 + r); pv[r] = pm[(size_t)tok * PM_LD + 2048 + h * 128 + vq * 32 + vc]; } \
        if (lane < 16) { const int tok = scan_tok(b, dir, (blk) * 16 + lane); pg = gp[tok]; pb = bp[tok]; } } while (0)
    SCAN_ISSUE(0);
    for (int blk = 0; blk < 272; ++blk) {
        LAS float* q = base + (blk & 1) * BUFW;
#pragma unroll
        for (int j = 0; j < 8; ++j) { const int id = j * 64 + lane, r = id >> 5, c = id & 31; LAS float* d = q + r * 256 + c * 8;
            *(LAS f32x4*)d = (f32x4){bf_lo(pq[j].x), bf_hi(pq[j].x), bf_lo(pq[j].y), bf_hi(pq[j].y)};
            *(LAS f32x4*)(d + 4) = (f32x4){bf_lo(pq[j].z), bf_hi(pq[j].z), bf_lo(pq[j].w), bf_hi(pq[j].w)}; }
#pragma unroll
        for (int r = 0; r < 8; ++r) q[4096 + (kh * 8 + r) * 32 + vc] = bf2f(pv[r]);
        if (lane < 16) { q[4608 + lane] = __expf(pg); q[4624 + lane] = pb; }
        if (blk + 1 < 272) SCAN_ISSUE(blk + 1);
        asm volatile("" ::: "memory");
#pragma nounroll
        for (int s = 0; s < 16; ++s) {
            const LAS float* qr = q + s * 256 + kh * 64; const LAS float* kr = qr + 128;
            const float eg = q[4608 + s], be = q[4624 + s], vv = q[4096 + s * 32 + vc];
            float ks = 0.f;
#pragma unroll
            for (int i = 0; i < 16; ++i) { const f32x4 k4 = *(const LAS f32x4*)(kr + 4 * i); ks += (k4.x * S[4 * i] + k4.y * S[4 * i + 1]) + (k4.z * S[4 * i + 2] + k4.w * S[4 * i + 3]); }
            ks += __shfl_xor(ks, 32);
            const float dd = be * (vv - eg * ks);
            float o = 0.f;
#pragma unroll
            for (int i = 0; i < 16; ++i) { const f32x4 k4 = *(const LAS f32x4*)(kr + 4 * i); const f32x4 q4 = *(const LAS f32x4*)(qr + 4 * i);
                S[4 * i] = eg * S[4 * i] + k4.x * dd; S[4 * i + 1] = eg * S[4 * i + 1] + k4.y * dd; S[4 * i + 2] = eg * S[4 * i + 2] + k4.z * dd; S[4 * i + 3] = eg * S[4 * i + 3] + k4.w * dd;
                o += (q4.x * S[4 * i] + q4.y * S[4 * i + 1]) + (q4.z * S[4 * i + 2] + q4.w * S[4 * i + 3]);
                if (i == 7) asm volatile("" ::: "memory"); }
            o += __shfl_xor(o, 32);
            if (kh == 0) { const int tok = scan_tok(b, dir, blk * 16 + s); obuf[(size_t)tok * D + h * 128 + vq * 32 + vc] = (bf16)f2bf(o); }
            asm volatile("" ::: "memory");
        }
    }
#undef SCAN_ISSUE
}

__device__ __forceinline__ void phase_od(Frame& F, const Args& a, int layer) {
    const int gw = F.bid * 8 + F.wave, NGW = F.G * 8;
    const f32x4 on = *((const f32x4*)(inp(F, I_ONORM) + layer * 128) + (F.lane & 31));
    for (int row = gw; row < NTOK; row += NGW) {
        const u32x2* of = WSP(u32x2, WS_OF) + (size_t)row * 256 + F.lane; const u32x2* ob = WSP(u32x2, WS_OB) + (size_t)row * 256 + F.lane;
        const bf16* zr = WSP(bf16, WS_PM) + (size_t)row * PM_LD + PM_Z + 4 * F.lane;
        u32x2* od = WSP(u32x2, WS_H) + (size_t)row * 256 + F.lane;
#pragma unroll
        for (int j = 0; j < 4; ++j) { const u32x2 p = of[64 * j], q = ob[64 * j]; const u32x2 z = *(const u32x2*)(zr + 256 * j);
            f32x4 o = (f32x4){bf_lo(p.x) + bf_lo(q.x), bf_hi(p.x) + bf_hi(q.x), bf_lo(p.y) + bf_lo(q.y), bf_hi(p.y) + bf_hi(q.y)};
            float ss = (o.x * o.x + o.y * o.y) + (o.z * o.z + o.w * o.w);
            ss += __shfl_xor(ss, 1); ss += __shfl_xor(ss, 2); ss += __shfl_xor(ss, 4); ss += __shfl_xor(ss, 8); ss += __shfl_xor(ss, 16);
            const float r = rsqrtf(ss * (1.f / 128.f) + EPS);
            o = o * r * on;
            o.x *= siluf_(bf_lo(z.x)); o.y *= siluf_(bf_hi(z.x)); o.z *= siluf_(bf_lo(z.y)); o.w *= siluf_(bf_hi(z.y));
            od[64 * j] = (u32x2){pk2(o.x, o.y), pk2(o.z, o.w)}; }
    }
}

struct SchedMain {
    const char* H; const char* W; int G, c;
    __device__ __forceinline__ bool next(int i, Unit& u) const {
        const int L = i * G + c; constexpr int NM = NTILE * 25;
        if (L >= NM + 2 * NTILE) return false;
        if (L < NM) { int pm, pn; pg8::tile_map(L, NTILE, 25, pm, pn); u.pm = pm; u.pn = pn; u.aux = 0; }
        else { const int f = L - NM; u.pm = f & 1; u.pn = f >> 1; u.aux = 1; }
        return true;
    }
    __device__ __forceinline__ const char* a_ptr(const Unit& u) const { return u.aux ? W + (size_t)(PM_LD + u.pm * 256) * D * 2 : H + (size_t)u.pm * 256 * D * 2; }
    __device__ __forceinline__ const char* b_ptr(const Unit& u) const { return u.aux ? H + (size_t)u.pn * 256 * D * 2 : W + (size_t)u.pn * 256 * D * 2; }
};
#define EPI_LANE_IDX int tz_ = threadIdx.x; asm volatile("" : "+v"(tz_)); const int wr_ = tz_ >> 8, wc_ = (tz_ >> 6) & 3, fr_ = tz_ & 15, fq_ = (tz_ >> 4) & 3; (void)wr; (void)wc; (void)fr; (void)fq;
#define EPI_ROWS_BEGIN EPI_LANE_IDX const int rbase = wr_ * 64 + fr_, cbase = wc_ * 32 + 8 * fq_; (void)rbase; (void)cbase;
struct EpiMain {
    static constexpr bool PERM = true;
    bf16* PM; bf16* UTL; bf16* UTC;
    __device__ __forceinline__ void operator()(const f32x4 (&acc)[2][2][4][2], const Unit& u, int wr, int wc, int fr, int fq) const {
        EPI_ROWS_BEGIN
#pragma unroll
        for (int ai = 0; ai < 2; ++ai)
#pragma unroll
            for (int m = 0; m < 4; ++m) { const int r = ai * 128 + m * 16 + rbase;
                bf16* rowp;
                if (u.aux == 0) rowp = PM + (size_t)(u.pm * 256 + r) * PM_LD + u.pn * 256 + cbase;
                else { const int ch = u.pm * 256 + r;
                    if (u.pn < 8) rowp = UTC + ((size_t)(u.pn * 512 + ch)) * 256 + cbase;
                    else { const int q = u.pn - 8; rowp = UTL + ((size_t)((q >> 4) * 512 + ch)) * 4096 + (q & 15) * 256 + cbase; } }
#pragma unroll
                for (int bj = 0; bj < 2; ++bj) { const f32x4 v0 = acc[ai][bj][m][0], v1 = acc[ai][bj][m][1];
                    *(u32x4*)(rowp + bj * 128) = (u32x4){cvt_pk_bf16(v0[0], v0[1]), cvt_pk_bf16(v0[2], v0[3]), cvt_pk_bf16(v1[0], v1[1]), cvt_pk_bf16(v1[2], v1[3])}; } }
    }
};
template <int LAT> struct SchedDft {
    const char* A; const char* B; int G, c;
    __device__ __forceinline__ bool next(int i, Unit& u) const {
        const int L = i * G + c;
        if (LAT) { if (L >= 512) return false; u.aux = L >> 6; u.pm = (L & 63) >> 1; u.pn = L & 1; }
        else { if (L >= 32) return false; u.aux = L >> 2; u.pm = (L >> 1) & 1; u.pn = L & 1; }
        return true;
    }
    __device__ __forceinline__ const char* a_ptr(const Unit& u) const { return A + (size_t)u.pm * 256 * (LAT ? 4096 : 256) * 2; }
    __device__ __forceinline__ const char* b_ptr(const Unit& u) const { return B + ((size_t)u.aux * 512 + u.pn * 256) * (LAT ? 4096 : 256) * 2; }
};
template <int LAT> struct EpiDft {
    static constexpr bool PERM = true;
    bf16* PBUF;
    __device__ __forceinline__ void operator()(const f32x4 (&acc)[2][2][4][2], const Unit& u, int wr, int wc, int fr, int fq) const {
        EPI_ROWS_BEGIN
        const int ri = LAT ? (u.pm >> 4) : u.pm;
        const int tokb = LAT ? (NCTX + u.aux * 4096 + (u.pm & 15) * 256) : (u.aux * 256);
#pragma unroll
        for (int ai = 0; ai < 2; ++ai)
#pragma unroll
            for (int m = 0; m < 4; ++m) { const int r = ai * 128 + m * 16 + rbase;
#pragma unroll
                for (int bj = 0; bj < 2; ++bj) { const int ch = u.pn * 256 + bj * 128 + cbase; const f32x4 v0 = acc[ai][bj][m][0], v1 = acc[ai][bj][m][1];
                    *(u32x4*)(PBUF + (size_t)(tokb + r) * D + (ch >> 7) * 256 + ri * 128 + (ch & 127)) =
                        (u32x4){cvt_pk_bf16(v0[0], v0[1]), cvt_pk_bf16(v0[2], v0[3]), cvt_pk_bf16(v1[0], v1[1]), cvt_pk_bf16(v1[2], v1[3])}; } }
    }
};
struct SchedRows {
    const char* A; const char* B; int G, c;
    __device__ __forceinline__ bool next(int i, Unit& u) const {
        const int L = i * G + c; if (L >= NTILE * 4) return false;
        int pm, pn; pg8::tile_map(L, NTILE, 4, pm, pn); u.pm = pm; u.pn = pn; u.aux = 0; return true;
    }
    __device__ __forceinline__ const char* a_ptr(const Unit& u) const { return A + (size_t)u.pm * 256 * D * 2; }
    __device__ __forceinline__ const char* b_ptr(const Unit& u) const { return B + (size_t)u.pn * 256 * D * 2; }
};
template <int MODE> struct EpiGate {
    static constexpr bool PERM = true;
    bf16* M; const bf16* PM;
    __device__ __forceinline__ void operator()(const f32x4 (&acc)[2][2][4][2], const Unit& u, int wr, int wc, int fr, int fq) const {
        EPI_ROWS_BEGIN
#pragma unroll
        for (int ai = 0; ai < 2; ++ai)
#pragma unroll
            for (int m = 0; m < 4; ++m) { const int row = u.pm * 256 + ai * 128 + m * 16 + rbase;
#pragma unroll
                for (int bj = 0; bj < 2; ++bj) { const int col = u.pn * 256 + bj * 128 + cbase; const f32x4 v0 = acc[ai][bj][m][0], v1 = acc[ai][bj][m][1];
                    const u32x4 g = *(const u32x4*)(PM + (size_t)row * PM_LD + (MODE == 0 ? PM_GA : PM_GB) + col);
                    float o[8] = {v0[0] * sigmoidf_(bf_lo(g.x)), v0[1] * sigmoidf_(bf_hi(g.x)), v0[2] * sigmoidf_(bf_lo(g.y)), v0[3] * sigmoidf_(bf_hi(g.y)),
                                  v1[0] * sigmoidf_(bf_lo(g.z)), v1[1] * sigmoidf_(bf_hi(g.z)), v1[2] * sigmoidf_(bf_lo(g.w)), v1[3] * sigmoidf_(bf_hi(g.w))};
                    u32x4* mp = (u32x4*)(M + (size_t)row * D + col);
                    if (MODE == 1) { const u32x4 p = *mp; o[0] += bf_lo(p.x); o[1] += bf_hi(p.x); o[2] += bf_lo(p.y); o[3] += bf_hi(p.y); o[4] += bf_lo(p.z); o[5] += bf_hi(p.z); o[6] += bf_lo(p.w); o[7] += bf_hi(p.w); }
                    *mp = (u32x4){cvt_pk_bf16(o[0], o[1]), cvt_pk_bf16(o[2], o[3]), cvt_pk_bf16(o[4], o[5]), cvt_pk_bf16(o[6], o[7])}; } }
    }
};
struct EpiResid {
    static constexpr bool PERM = false;
    float* X; const float* MODL;
    __device__ __forceinline__ void operator()(const f32x4 (&acc)[2][2][4][2], const Unit& u, int wr, int wc, int fr, int fq) const {
        EPI_LANE_IDX
        const int rbase = wr_ * 64 + fr_, cb = u.pn * 256 + wc_ * 32 + 4 * fq_;
        const int mb = mod_row(u.pm * 256);
        f32x4 gv[2][2];
#pragma unroll
        for (int bj = 0; bj < 2; ++bj)
#pragma unroll
            for (int n = 0; n < 2; ++n) gv[bj][n] = *(const f32x4*)(MODL + (size_t)mb * 6144 + 2048 + cb + bj * 128 + n * 16);
#pragma unroll
        for (int ai = 0; ai < 2; ++ai)
#pragma unroll
            for (int m = 0; m < 4; ++m) { float* rowp = X + (size_t)(u.pm * 256 + ai * 128 + m * 16 + rbase) * D + cb;
#pragma unroll
                for (int bj = 0; bj < 2; ++bj)
#pragma unroll
                    for (int n = 0; n < 2; ++n) { f32x4* p = (f32x4*)(rowp + bj * 128 + n * 16); *p = *p + gv[bj][n] * acc[ai][bj][m][n]; } }
    }
};
template <int KD> struct SchedMoe {
    const char* A; const char* W; volatile LAS unsigned* LCTL; int G, c, ntile;
    __device__ __forceinline__ bool next(int i, Unit& u) const {
        const int L = i * G + c;
        if (L >= ntile * 4) return false;
        u.pm = L >> 2; u.pn = L & 3; u.aux = __builtin_amdgcn_readfirstlane((int)LCTL[128 + (L >> 2)]); return true;
    }
    __device__ __forceinline__ const char* a_ptr(const Unit& u) const { return A + (size_t)u.pm * 256 * KD * 2; }
    __device__ __forceinline__ const char* b_ptr(const Unit& u) const { return W + ((size_t)u.aux * 1024 + u.pn * 256) * KD * 2; }
};
struct EpiGU {
    static constexpr bool PERM = true;
    bf16* HID;
    __device__ __forceinline__ void operator()(const f32x4 (&acc)[2][2][4][2], const Unit& u, int wr, int wc, int fr, int fq) const {
        EPI_ROWS_BEGIN
#pragma unroll
        for (int ai = 0; ai < 2; ++ai)
#pragma unroll
            for (int m = 0; m < 4; ++m) { const int row = u.pm * 256 + ai * 128 + m * 16 + rbase;
#pragma unroll
                for (int bj = 0; bj < 2; ++bj) { const f32x4 v0 = acc[ai][bj][m][0], v1 = acc[ai][bj][m][1];
                    *(u32x2*)(HID + (size_t)row * EDIM + u.pn * 128 + ((bj * 128 + cbase) >> 1)) =
                        (u32x2){cvt_pk_bf16(siluf_(v0[0]) * v0[1], siluf_(v0[2]) * v0[3]), cvt_pk_bf16(siluf_(v1[0]) * v1[1], siluf_(v1[2]) * v1[3])}; } }
    }
};
struct EpiDown {
    static constexpr bool PERM = true;
    bf16* YS;
    __device__ __forceinline__ void operator()(const f32x4 (&acc)[2][2][4][2], const Unit& u, int wr, int wc, int fr, int fq) const {
        EPI_ROWS_BEGIN
#pragma unroll
        for (int ai = 0; ai < 2; ++ai)
#pragma unroll
            for (int m = 0; m < 4; ++m) { const int row = u.pm * 256 + ai * 128 + m * 16 + rbase;
#pragma unroll
                for (int bj = 0; bj < 2; ++bj) { const f32x4 v0 = acc[ai][bj][m][0], v1 = acc[ai][bj][m][1];
                    *(u32x4*)(YS + (size_t)row * D + u.pn * 256 + bj * 128 + cbase) = (u32x4){cvt_pk_bf16(v0[0], v0[1]), cvt_pk_bf16(v0[2], v0[3]), cvt_pk_bf16(v1[0], v1[1]), cvt_pk_bf16(v1[2], v1[3])}; } }
    }
};

constexpr int PH_PER_LAYER = 11, PH_FINAL = 1 + DEPTH * PH_PER_LAYER, N_PHASES = PH_FINAL + 1;
__global__ void __launch_bounds__(512, 2) fwd_kernel(Args args) {
    extern __shared__ __attribute__((aligned(16))) unsigned char lds[];
    Frame F;
    F.lds = (LAS unsigned char*)lds; F.LCTL = (volatile LAS unsigned*)(F.lds + LDSCTL_OFF);
    F.ws = args.ws; F.tid = threadIdx.x; F.lane = F.tid & 63; F.wave = __builtin_amdgcn_readfirstlane(F.tid >> 6); F.G = gridDim.x; F.bid = blockIdx.x;
    for (int u = F.tid; u < 512; u += 512) F.LCTL[u] = 0u;
    if (F.tid < 25) { const unsigned long long p = (F.tid < 24) ? (unsigned long long)args.in[F.tid] : (unsigned long long)args.out; F.LCTL[512 + 2 * F.tid] = (unsigned)p; F.LCTL[513 + 2 * F.tid] = (unsigned)(p >> 32); }
    __syncthreads();
    XcdBarrier bar; bar.bar = WSP(unsigned, WS_CTL) + CW_BAR; bar.x = 0; bar.st = F.LCTL;
    if (ONE_LAUNCH) bar = xcd_barrier_post(WSP(unsigned, WS_CTL) + CW_BAR, F.LCTL);
    const int lo = args.ph_lo, hi = args.ph_hi;
#define IN(k) (lo <= (k) && (k) < hi)
#define SEAM(k) do { if (IN(k) && IN((k) + 1)) { XcdBarrier b2_ = bar; asm volatile("" : "+s"(b2_.bar)); xcd_barrier(b2_); } } while (0)

    if (PHON(0) && IN(0)) { LAUNDER(F); phase_prologue(F, args); SEAM(0); }

    for (int layer = 0; layer < DEPTH; ++layer) {
        const int pb = 1 + layer * PH_PER_LAYER;
        const char* WL = (const char*)(WSP(bf16, WS_WIN) + (size_t)layer * WIN_ROWS * D);
        if (PHON(1) && IN(pb + 0)) { LAUNDER(F); if (layer == 0) phase_norm<0, false>(F, args, layer); else phase_norm<0, true>(F, args, layer); SEAM(pb + 0); }
        if (PHON(2) && IN(pb + 1)) { LAUNDER(F);
            SchedMain S{(const char*)WSP(bf16, WS_H), WL, F.G, F.bid}; EpiMain E{WSP(bf16, WS_PM), WSP(bf16, WS_UTL), WSP(bf16, WS_UTC)};
            pg8::gemm_phase<EpiMain, SchedMain>(F.lds, D, D, D, S, E);
            SEAM(pb + 1);
        }
        if (PHON(3) && IN(pb + 2)) { LAUNDER(F);
            { SchedDft<1> S{(const char*)WSP(bf16, WS_DFTL), (const char*)WSP(bf16, WS_UTL), F.G, F.bid}; EpiDft<1> E{WSP(bf16, WS_PBUF)};
              pg8::gemm_phase<EpiDft<1>, SchedDft<1>>(F.lds, 4096, 4096, 4096, S, E); }
            { SchedDft<0> S{(const char*)WSP(bf16, WS_DFTC), (const char*)WSP(bf16, WS_UTC), F.G, F.bid}; EpiDft<0> E{WSP(bf16, WS_PBUF)};
              pg8::gemm_phase<EpiDft<0>, SchedDft<0>>(F.lds, 256, 256, 256, S, E); }
            phase_conv(F, args, layer);
            SEAM(pb + 2);
        }
        if (PHON(4) && IN(pb + 3)) { LAUNDER(F);
            if (F.wave < 2) { for (int u = F.bid * 2 + F.wave; u < 512; u += F.G * 2) scan_naive_unit(F, u, (LAS float*)(F.lds + F.wave * 40960)); }
            else moe_weight_convert(F, args, layer, 2, (LAS float*)(F.lds + 81920 + (F.wave - 2) * 8448));
            SEAM(pb + 3);
        }
        if (PHON(5) && IN(pb + 4)) { LAUNDER(F); phase_od(F, args, layer); SEAM(pb + 4); }
        if (PHON(6) && IN(pb + 5)) { LAUNDER(F);
            { SchedRows S{(const char*)WSP(bf16, WS_PBUF), (const char*)(WSP(bf16, WS_WPA) + (size_t)layer * D * D), F.G, F.bid}; EpiGate<0> E{WSP(bf16, WS_OF), WSP(bf16, WS_PM)};
              pg8::gemm_phase<EpiGate<0>, SchedRows>(F.lds, D, D, D, S, E); }
            { SchedRows S{(const char*)WSP(bf16, WS_H), (const char*)(WSP(bf16, WS_WDL) + (size_t)layer * D * D), F.G, F.bid}; EpiGate<1> E{WSP(bf16, WS_OF), WSP(bf16, WS_PM)};
              pg8::gemm_phase<EpiGate<1>, SchedRows>(F.lds, D, D, D, S, E); }
            SEAM(pb + 5);
        }
        if (PHON(7) && IN(pb + 6)) { LAUNDER(F);
            SchedRows S{(const char*)WSP(bf16, WS_OF), (const char*)(WSP(bf16, WS_WOUT) + (size_t)layer * D * D), F.G, F.bid}; EpiResid E{WSP(float, WS_X), WSP(float, WS_MOD) + (size_t)layer * 9 * 6144};
            pg8::gemm_phase<EpiResid, SchedRows>(F.lds, D, D, D, S, E);
            SEAM(pb + 6);
        }
        if (PHON(8) && IN(pb + 7)) { LAUNDER(F); phase_route(F, args, layer); SEAM(pb + 7); }
        if (PHON(9) && IN(pb + 8)) { LAUNDER(F); phase_assign(F, args, layer); SEAM(pb + 8); }
        if (PHON(10) && IN(pb + 9)) { LAUNDER(F);
            build_moe_tables(F, layer);
            SchedMoe<D> S{(const char*)WSP(bf16, WS_XS), (const char*)WSP(bf16, WS_MOEW), F.LCTL, F.G, F.bid, __builtin_amdgcn_readfirstlane((int)(F.LCTL[16 + NEXP] >> 8))}; EpiGU E{WSP(bf16, WS_HID)};
            pg8::gemm_phase<EpiGU, SchedMoe<D>>(F.lds, D, D, D, S, E);
            SEAM(pb + 9);
        }
        if (PHON(11) && IN(pb + 10)) { LAUNDER(F);
            build_moe_tables(F, layer);
            SchedMoe<EDIM> S{(const char*)WSP(bf16, WS_HID), (const char*)WSP(bf16, WS_MOEWD), F.LCTL, F.G, F.bid, __builtin_amdgcn_readfirstlane((int)(F.LCTL[16 + NEXP] >> 8))}; EpiDown E{WSP(bf16, WS_YS)};
            pg8::gemm_phase<EpiDown, SchedMoe<EDIM>>(F.lds, EDIM, EDIM, EDIM, S, E);
            SEAM(pb + 10);
        }
    }
    if (PHON(12) && IN(PH_FINAL)) { LAUNDER(F); } if (PHON(12) && IN(PH_FINAL)) phase_norm<1, true>(F, args, DEPTH);
#undef IN
#undef SEAM
}

extern "C" void kernel_launch(void* const* d_in, const int* in_sizes, int n_in, void* d_out, int out_size, void* d_ws, size_t ws_size, hipStream_t stream) {
    static int grid = 0;
    if (grid == 0) {
        if (n_in != 24 || out_size != NLAT * D || ws_size < WS_END) { fprintf(stderr, "kernel_launch: unexpected problem (n_in %d, out %d, ws %zu < %zu)\n", n_in, out_size, ws_size, (size_t)WS_END); grid = -1; return; }
        int dev = 0, cus = 0, per_cu = 0;
        if (hipGetDevice(&dev) != hipSuccess || hipDeviceGetAttribute(&cus, hipDeviceAttributeMultiprocessorCount, dev) != hipSuccess) { grid = -1; return; }
        if (hipFuncSetAttribute((const void*)fwd_kernel, hipFuncAttributeMaxDynamicSharedMemorySize, LDS_BYTES) != hipSuccess) { fprintf(stderr, "kernel_launch: hipFuncSetAttribute failed\n"); grid = -1; return; }
        if (hipOccupancyMaxActiveBlocksPerMultiprocessor(&per_cu, (const void*)fwd_kernel, 512, LDS_BYTES) != hipSuccess || per_cu < 1) fprintf(stderr, "kernel_launch: occupancy query reports %d\n", per_cu);
        (void)hipGetLastError();
        grid = cus;
    }
    if (grid < 0) return;
    hipMemsetAsync((char*)d_ws + WS_CTL, 0, CTL_ZERO_BYTES, stream);
    Args a{};
    for (int i = 0; i < 24; ++i) a.in[i] = (const float*)d_in[i];
    a.out = (float*)d_out; a.ws = (unsigned char*)d_ws;
#if ONE_LAUNCH
    a.ph_lo = 0; a.ph_hi = N_PHASES;
    hipLaunchKernelGGL(fwd_kernel, dim3(grid), dim3(512), LDS_BYTES, stream, a);
#else
    for (int p = 0; p < N_PHASES; ++p) { a.ph_lo = p; a.ph_hi = p + 1; hipLaunchKernelGGL(fwd_kernel, dim3(grid), dim3(512), LDS_BYTES, stream, a); }
#endif
}
```

```cpp
#include <hip/hip_runtime.h>
#include <cstdio>
#include <cstdint>

#ifndef ONE_LAUNCH
#define ONE_LAUNCH 1
#endif
#ifndef PHMASK
#define PHMASK 0xFFFFu
#endif
#define PHON(k) ((PHMASK >> (k)) & 1u)

#define GAS __attribute__((address_space(1)))
#define LAS __attribute__((address_space(3)))
typedef unsigned short bf16;
typedef short bf16x8 __attribute__((ext_vector_type(8)));
typedef float f32x4 __attribute__((ext_vector_type(4)));
typedef float f32x2 __attribute__((ext_vector_type(2)));
typedef unsigned u32x4 __attribute__((ext_vector_type(4)));
typedef unsigned u32x2 __attribute__((ext_vector_type(2)));

constexpr int D = 1024, NB = 8, SEQ = 4096, DEPTH = 4, CTXL = 256;
constexpr int NCTX = NB * CTXL;
constexpr int NLAT = NB * SEQ;
constexpr int NTOK = NCTX + NLAT;
constexpr int NTILE = NTOK / 256;
constexpr int IN_COLS = 6688, OFF_A = 3072, OFF_Z = 3104, OFF_F = 4128, OFF_G = 4640;
constexpr int PM_LD = 6400;
constexpr int PM_Z = 3072, PM_GA = 4096, PM_GB = 5120, PM_AB = 6144;
constexpr int WIN_ROWS = 6912;
constexpr int NEXP = 32, EDIM = 512, NSLOT = 77824, MAXTILES = 304;
constexpr float EPS = 1e-6f;

constexpr size_t MiB = 1u << 20;
constexpr size_t WS_CTL = 0, CTL_ZERO_BYTES = 1 * MiB;
constexpr size_t WS_MOD = 1 * MiB;
constexpr size_t WS_X = 2 * MiB;
constexpr size_t WS_WIN = WS_X + 136 * MiB;
constexpr size_t WS_WPA = WS_WIN + 54 * MiB;
constexpr size_t WS_WDL = WS_WPA + 8 * MiB;
constexpr size_t WS_WOUT = WS_WDL + 8 * MiB;
constexpr size_t WS_DFTL = WS_WOUT + 8 * MiB;
constexpr size_t WS_DFTC = WS_DFTL + 64 * MiB;
constexpr size_t WS_MOEW = WS_DFTC + 1 * MiB;
constexpr size_t WS_MOEWD = WS_MOEW + 64 * MiB;
constexpr size_t WS_H = WS_MOEW + 96 * MiB;
constexpr size_t WS_PM = WS_H + 68 * MiB;
constexpr size_t WS_XS = WS_PM;
constexpr size_t WS_HID = WS_XS + 152 * MiB;
constexpr size_t WS_YS = WS_HID + 76 * MiB;
constexpr size_t WS_UTL = WS_PM + 425 * MiB;
constexpr size_t WS_UTC = WS_UTL + 32 * MiB;
constexpr size_t WS_PBUF = WS_UTC + 2 * MiB;
constexpr size_t WS_OF = WS_PBUF + 68 * MiB;
constexpr size_t WS_OB = WS_OF + 68 * MiB;
constexpr size_t WS_GB = WS_OB + 68 * MiB;
constexpr size_t WS_ROUTE = WS_GB + 5 * MiB;
constexpr size_t WS_END = WS_ROUTE + 1 * MiB;
static_assert(WS_YS + 152 * MiB <= WS_UTL, "MoE overlay fits inside PM");
static_assert(WS_END <= 1145ull * MiB, "d_ws budget");
constexpr int CW_BAR = 4096;
constexpr int CW_CNT = 16384;
constexpr int CW_CUR = 16384 + 1024;

constexpr int LDS_SCRATCH = 151552;
constexpr int LDSCTL_OFF = LDS_SCRATCH;
constexpr int LDS_BYTES = LDS_SCRATCH + 4096;

#define LDS_WAIT() asm volatile("s_waitcnt lgkmcnt(0)" ::: "memory")
#define VM_WAIT() asm volatile("s_waitcnt vmcnt(0)" ::: "memory")

__device__ __forceinline__ unsigned f2bf(float f) { unsigned u = __builtin_bit_cast(unsigned, f); return (u + 0x7fffu + ((u >> 16) & 1u)) >> 16; }
__device__ __forceinline__ unsigned pk2(float lo, float hi) { return f2bf(lo) | (f2bf(hi) << 16); }
__device__ __forceinline__ float bf_lo(unsigned w) { return __builtin_bit_cast(float, w << 16); }
__device__ __forceinline__ float bf_hi(unsigned w) { return __builtin_bit_cast(float, w & 0xffff0000u); }
__device__ __forceinline__ float bf2f(bf16 b) { return __builtin_bit_cast(float, (unsigned)b << 16); }
__device__ __forceinline__ float sigmoidf_(float x) { return 1.f / (1.f + __expf(-x)); }
__device__ __forceinline__ float siluf_(float x) { return x / (1.f + __expf(-x)); }
__device__ __forceinline__ float wave_sum(float v) {
#pragma unroll
    for (int o = 1; o < 64; o <<= 1) v += __shfl_xor(v, o);
    return v;
}

#define XB_TMO      128
#define XB_XCNT(j)  (256  + 64 * (j))
#define XB_XSUB(j)  (1280 + 64 * (j))
#define XB_XGEN(j)  (2304 + 64 * (j))
#define XB_TOP      3328
#define XB_TOPGEN   3392
#define XCD_BAR_WORDS 3456
#define XB_SPIN_CAP (1u << 18)
__device__ __forceinline__ unsigned xb_ld(unsigned* p)              { return __hip_atomic_load(p, __ATOMIC_RELAXED, __HIP_MEMORY_SCOPE_AGENT); }
__device__ __forceinline__ unsigned xb_add(unsigned* p, unsigned v) { return __hip_atomic_fetch_add(p, v, __ATOMIC_RELAXED, __HIP_MEMORY_SCOPE_AGENT); }
__device__ __forceinline__ unsigned xb_xcc_id() { return (unsigned)__builtin_amdgcn_s_getreg((3 << 11) | 20) & 0xFu; }
#define XB_SPIN(cond, bar) do { unsigned _sp = 0; while (cond) { __builtin_amdgcn_s_sleep(1); \
    if ((++_sp & 255u) == 0u) { if (xb_ld(&(bar)[XB_TMO])) break; if (_sp > XB_SPIN_CAP) { atomicAdd(&(bar)[XB_TMO], 1u); break; } } } } while (0)
struct XcdBarrier { unsigned* bar; unsigned x; volatile LAS unsigned* st; };
__device__ __forceinline__ XcdBarrier xcd_barrier_post(unsigned* bar, volatile LAS unsigned* st) {
    XcdBarrier b; b.bar = bar; b.x = xb_xcc_id(); b.st = st;
    if (threadIdx.x == 0) (void)xb_add(&bar[XB_XCNT(b.x)], 1u);
    return b;
}
__device__ __forceinline__ void xcd_barrier_complete(unsigned* bar, unsigned x, unsigned& nloc, unsigned& nx) {
    const unsigned G = gridDim.x * gridDim.y * gridDim.z;
    unsigned sum, cnt, mine, sp = 0u;
    for (;;) {
        sum = 0u; cnt = 0u; mine = 0u;
#pragma unroll
        for (unsigned j = 0; j < 16; ++j) { const unsigned c = xb_ld(&bar[XB_XCNT(j)]); sum += c; cnt += (c > 0u) ? 1u : 0u; mine = (j == x) ? c : mine; }
        if (sum == G) break;
        __builtin_amdgcn_s_sleep(1);
        if ((++sp & 255u) == 0u) { if (xb_ld(&bar[XB_TMO])) break; if (sp > XB_SPIN_CAP) { atomicAdd(&bar[XB_TMO], 1u); break; } }
    }
    nloc = mine > 0u ? mine : 1u; nx = cnt > 0u ? cnt : 1u;
}
__device__ __forceinline__ void xcd_barrier(const XcdBarrier& b) {
    asm volatile("s_waitcnt vmcnt(0)" ::: "memory");
    __syncthreads();
    if (threadIdx.x == 0) {
        unsigned* bar = b.bar;
        __builtin_amdgcn_s_waitcnt(0);
        unsigned nloc = b.st[0], nx = b.st[1];
        if (nloc == 0u) { xcd_barrier_complete(bar, b.x, nloc, nx); b.st[0] = nloc; b.st[1] = nx; }
        const unsigned old = xb_add(&bar[XB_XSUB(b.x)], 1u);
        const unsigned gen = old / nloc;
        if (old + 1u == (gen + 1u) * nloc) {
            __builtin_amdgcn_fence(__ATOMIC_RELEASE, "agent");
            asm volatile("s_waitcnt vmcnt(0)" ::: "memory");
            const unsigned og = xb_add(&bar[XB_TOP], 1u);
            const unsigned tg = og / nx;
            if (og + 1u == (tg + 1u) * nx) xb_add(&bar[XB_TOPGEN], 1u);
            else XB_SPIN(xb_ld(&bar[XB_TOPGEN]) == tg, bar);
            __builtin_amdgcn_fence(__ATOMIC_ACQUIRE, "agent");
            xb_add(&bar[XB_XGEN(b.x)], 1u);
            asm volatile("s_waitcnt vmcnt(0)" ::: "memory");
        } else {
            XB_SPIN(xb_ld(&bar[XB_XGEN(b.x)]) == gen, bar);
            __builtin_amdgcn_fence(__ATOMIC_ACQUIRE, "agent");
            asm volatile("s_waitcnt vmcnt(0)" ::: "memory");
        }
    }
    __syncthreads();
}

namespace pg8 {
constexpr int BM = 256, BK = 64, HALF = 128, HTB = HALF * BK * 2, STAGE_BYTES = 8 * HTB, NXCD = 8, WGM = 8;
__device__ __forceinline__ int lds_byte(int r, int c) { const int st = (r >> 4) * 2 + (c >> 5), rr = r & 15, cc = c & 31, ob = rr * 64 + cc * 2; return st * 1024 + (ob ^ (((ob >> 9) & 1) << 5)); }
__device__ __forceinline__ void stage_rc(int b, int& R, int& C) { const int st = b / 1024, sb = b % 1024, swz = sb ^ (((sb >> 9) & 1) << 5); R = (st >> 1) * 16 + swz / 64; C = (st & 1) * 32 + (swz % 64) / 2; }
__device__ __forceinline__ int perm32(int rho) { const int n = rho >> 4, i = rho & 15; return 8 * (i >> 2) + 4 * n + (i & 3); }
__device__ __forceinline__ unsigned cvt_pk_bf16(float lo, float hi) { unsigned r; asm volatile("v_cvt_pk_bf16_f32 %0, %1, %2" : "=v"(r) : "v"(lo), "v"(hi)); return r; }

struct Unit { int pm, pn, aux; };

__device__ __forceinline__ void tile_map(int L, int nM, int nN, int& pm, int& pn) {
    const int nwg = nM * nN; int wgid = L;
    { const int q = nwg / NXCD, r = nwg % NXCD, xcd = wgid % NXCD, off = wgid / NXCD; wgid = (xcd < r ? xcd * (q + 1) : r * (q + 1) + (xcd - r) * q) + off; }
    const int nig = WGM * nN, gid = wgid / nig, fm = gid * WGM, gsz = (nM - fm) < WGM ? (nM - fm) : WGM;
    pm = fm + ((wgid % nig) % gsz); pn = (wgid % nig) / gsz;
}

template <class Epi, class Sched>
__device__ __forceinline__ void gemm_phase(LAS unsigned char* lds_v, const int lda, const int ldb, const int K, const Sched& S, const Epi& E) {
    LAS unsigned char* lds = (LAS unsigned char*)(size_t)(unsigned)__builtin_amdgcn_readfirstlane((int)(size_t)lds_v);
    int tid_ = threadIdx.x; asm volatile("" : "+v"(tid_));
    const int tid = tid_, wid = __builtin_amdgcn_readfirstlane(tid >> 6), lane = tid & 63, wr = wid >> 2, wc = wid & 3, fr = lane & 15, fq = lane >> 4;
    const int nt = K / BK;
    unsigned voffA[2], voffB[2];
#pragma unroll
    for (int i = 0; i < 2; ++i) { int R, C; stage_rc(tid * 16 + i * 8192, R, C); const int Rb = Epi::PERM ? ((R & ~31) + perm32(R & 31)) : R;
        voffA[i] = (unsigned)(R * lda + C) * 2u; voffB[i] = (unsigned)(Rb * ldb + C) * 2u; }
    const size_t kstep = (size_t)(BK * 2);
    const unsigned hstepA = (unsigned)(HALF * lda * 2), hstepB = (unsigned)(HALF * ldb * 2);
    const unsigned ldsw = (unsigned)wid * 1024u;
    const int aoff = lds_byte(wr * 64 + fr, fq * 8), boff = lds_byte(wc * 32 + fr, fq * 8);
#define PG8_SA(b, h) (((b) * 2 + (h)) * HTB)
#define PG8_SB(b, h) ((4 + (b) * 2 + (h)) * HTB)
#define PG8_STAGE(bufoff, gbase, voff) do { _Pragma("unroll") for (int _i = 0; _i < 2; ++_i) \
        __builtin_amdgcn_global_load_lds((const unsigned*)((const char*)(gbase) + (voff)[_i]), (LAS unsigned*)(lds + (bufoff) + ldsw + _i * 8192), 16, 0, 0); } while (0)
#define PG8_LDA(dst, b, h) do { _Pragma("unroll") for (int m = 0; m < 4; ++m) _Pragma("unroll") for (int k = 0; k < 2; ++k) dst[m][k] = *(const LAS bf16x8*)(lds + PG8_SA(b, h) + aoff + m * 2048 + k * 1024); } while (0)
#define PG8_LDB(dst, b, h) do { _Pragma("unroll") for (int n = 0; n < 2; ++n) _Pragma("unroll") for (int k = 0; k < 2; ++k) dst[n][k] = *(const LAS bf16x8*)(lds + PG8_SB(b, h) + boff + n * 2048 + k * 1024); } while (0)
#define PG8_MMA(ai, bj, At, Bt) do { __builtin_amdgcn_s_setprio(1); _Pragma("unroll") for (int m = 0; m < 4; ++m) _Pragma("unroll") for (int n = 0; n < 2; ++n) _Pragma("unroll") for (int k = 0; k < 2; ++k) \
        acc[ai][bj][m][n] = __builtin_amdgcn_mfma_f32_16x16x32_bf16(Bt[n][k], At[m][k], acc[ai][bj][m][n], 0, 0, 0); __builtin_amdgcn_s_setprio(0); } while (0)
#define PG8_WAIT_V(n) asm volatile("s_waitcnt vmcnt(" #n ")" ::: "memory")
#define PG8_WAIT_L(n) asm volatile("s_waitcnt lgkmcnt(" #n ")" ::: "memory")
#define PG8_BAR __builtin_amdgcn_s_barrier()
#define PG8_SCHED __builtin_amdgcn_sched_barrier(0)
    Unit cur, nxt; int ui = 0;
    if (!S.next(0, cur)) return;
    f32x4 acc[2][2][4][2];
#pragma unroll
    for (int a = 0; a < 2; ++a)
#pragma unroll
        for (int b = 0; b < 2; ++b)
#pragma unroll
            for (int m = 0; m < 4; ++m)
#pragma unroll
                for (int n = 0; n < 2; ++n) acc[a][b][m][n] = (f32x4){0.f, 0.f, 0.f, 0.f};
    bf16x8 At[4][2], B0[2][2], B1[2][2];
    const char* cA = S.a_ptr(cur); const char* cB = S.b_ptr(cur);
    PG8_STAGE(PG8_SB(0, 0), cB, voffB); PG8_STAGE(PG8_SA(0, 0), cA, voffA); PG8_STAGE(PG8_SB(0, 1), cB + hstepB, voffB); PG8_STAGE(PG8_SA(0, 1), cA + hstepA, voffA);
    if (wr == 1) PG8_BAR;
    PG8_WAIT_V(4); PG8_BAR;
    PG8_STAGE(PG8_SB(1, 0), cB + kstep, voffB); PG8_STAGE(PG8_SA(1, 0), cA + kstep, voffA); PG8_STAGE(PG8_SB(1, 1), cB + hstepB + kstep, voffB);
    PG8_WAIT_V(6); PG8_BAR;
    for (;;) {
        const bool has_next = S.next(ui + 1, nxt);
        const char* nA = has_next ? S.a_ptr(nxt) : cA; const char* nB = has_next ? S.b_ptr(nxt) : cB;
#pragma nounroll
        for (int t = 0; t < nt; t += 2) {
            const bool last = (t == nt - 2);
            const char* a1 = cA + (size_t)(t + 1) * kstep;
            const char* a2 = last ? nA : cA + (size_t)(t + 2) * kstep; const char* b2 = last ? nB : cB + (size_t)(t + 2) * kstep;
            const char* a3 = a2 + kstep; const char* b3 = b2 + kstep;
            PG8_LDB(B0, 0, 0); PG8_SCHED; PG8_LDA(At, 0, 0); PG8_STAGE(PG8_SA(1, 1), a1 + hstepA, voffA);
            PG8_WAIT_L(8); PG8_BAR; PG8_WAIT_L(0); PG8_MMA(0, 0, At, B0); PG8_BAR; PG8_SCHED;
            PG8_LDB(B1, 0, 1); PG8_STAGE(PG8_SB(0, 0), b2, voffB);
            PG8_BAR; PG8_WAIT_L(0); PG8_MMA(0, 1, At, B1); PG8_BAR;
            PG8_LDA(At, 0, 1); PG8_STAGE(PG8_SA(0, 0), a2, voffA);
            PG8_BAR; PG8_WAIT_L(0); PG8_MMA(1, 0, At, B0); PG8_BAR; PG8_SCHED;
            PG8_STAGE(PG8_SB(0, 1), b2 + hstepB, voffB);
            PG8_WAIT_V(6); PG8_BAR; PG8_MMA(1, 1, At, B1); PG8_BAR;
            PG8_LDB(B0, 1, 0); PG8_SCHED; PG8_LDA(At, 1, 0); PG8_STAGE(PG8_SA(0, 1), a2 + hstepA, voffA);
            PG8_WAIT_L(8); PG8_BAR; PG8_WAIT_L(0); PG8_MMA(0, 0, At, B0); PG8_BAR; PG8_SCHED;
            PG8_LDB(B1, 1, 1); PG8_STAGE(PG8_SB(1, 0), b3, voffB);
            PG8_BAR; PG8_WAIT_L(0); PG8_MMA(0, 1, At, B1); PG8_BAR;
            PG8_LDA(At, 1, 1); PG8_STAGE(PG8_SA(1, 0), a3, voffA);
            PG8_BAR; PG8_WAIT_L(0); PG8_MMA(1, 0, At, B0); PG8_BAR; PG8_SCHED;
            PG8_STAGE(PG8_SB(1, 1), b3 + hstepB, voffB);
            PG8_WAIT_V(6); PG8_BAR; PG8_MMA(1, 1, At, B1); PG8_BAR;
        }
        E(acc, cur, wr, wc, fr, fq);
        if (!has_next) break;
#pragma unroll
        for (int a = 0; a < 2; ++a)
#pragma unroll
            for (int b = 0; b < 2; ++b)
#pragma unroll
                for (int m = 0; m < 4; ++m)
#pragma unroll
                    for (int n = 0; n < 2; ++n) acc[a][b][m][n] = (f32x4){0.f, 0.f, 0.f, 0.f};
        cur = nxt; cA = nA; cB = nB; ++ui;
    }
    PG8_WAIT_V(0);
    if (wr == 0) PG8_BAR;
    PG8_BAR;
#undef PG8_SA
#undef PG8_SB
#undef PG8_STAGE
#undef PG8_LDA
#undef PG8_LDB
#undef PG8_MMA
#undef PG8_WAIT_V
#undef PG8_WAIT_L
#undef PG8_BAR
#undef PG8_SCHED
}
}
using pg8::Unit;
using pg8::cvt_pk_bf16;

struct Args { const float* in[24]; float* out; unsigned char* ws; int ph_lo, ph_hi; };
enum { I_X = 0, I_C, I_CTX, I_CCTX, I_WMOD, I_BMOD, I_NMIX, I_NFFN, I_WIN, I_CONVW, I_ALOG, I_DTB, I_ONORM, I_WF, I_WDL, I_WOUT, I_WRG, I_BRG, I_WRE, I_BRE, I_WG, I_WU, I_WD, I_FNORM };

struct Frame {
    LAS unsigned char* lds;
    volatile LAS unsigned* LCTL;
    unsigned char* ws;
    int tid, lane, wave, G, bid;
};
#define WSP(T, off) ((T*)(F.ws + (off)))
__device__ __forceinline__ const float* inp(const Frame& F, int i) {
    const unsigned lo = __builtin_amdgcn_readfirstlane(F.LCTL[512 + 2 * i]), hi = __builtin_amdgcn_readfirstlane(F.LCTL[513 + 2 * i]);
    return (const float*)(((unsigned long long)hi << 32) | lo);
}
#define LAUNDER(F) do { F.tid = threadIdx.x; F.ws = args.ws; F.bid = blockIdx.x; F.G = gridDim.x; F.lds = (LAS unsigned char*)lds; asm volatile("" : "+v"(F.tid), "+s"(F.ws), "+s"(F.bid), "+s"(F.G), "+v"(F.lds)); F.LCTL = (volatile LAS unsigned*)(F.lds + LDSCTL_OFF); F.lane = F.tid & 63; F.wave = __builtin_amdgcn_readfirstlane(F.tid >> 6); } while (0)

__device__ __forceinline__ void transpose_item(const float* W, int ldw, int col0, int K, int N, bf16* WT, int row_off, int row_mul, int row_add, LAS float* scr, int item, int lane) {
    const int nblk = N / 32, kb = item / nblk, nb = item % nblk, k0 = 64 * kb, n0 = 32 * nb;
#pragma unroll 8
    for (int i = 0; i < 32; ++i) { const int kk = 2 * i + (lane >> 5); scr[kk * 33 + (lane & 31)] = W[(size_t)(k0 + kk) * ldw + col0 + n0 + (lane & 31)]; }
    LDS_WAIT(); asm volatile("" ::: "memory");
    const int c = lane & 7;
#pragma unroll
    for (int j = 0; j < 4; ++j) { const int n = (lane >> 3) + 8 * j; const LAS float* s = scr + (8 * c) * 33 + n;
        u32x4 o; o.x = pk2(s[0 * 33], s[1 * 33]); o.y = pk2(s[2 * 33], s[3 * 33]); o.z = pk2(s[4 * 33], s[5 * 33]); o.w = pk2(s[6 * 33], s[7 * 33]);
        *(u32x4*)(WT + (size_t)(row_off + (n0 + n) * row_mul + row_add) * K + k0 + 8 * c) = o; }
    LDS_WAIT(); asm volatile("" ::: "memory");
}

__device__ __forceinline__ void phase_prologue(Frame& F, const Args& a) {
    const int gw = F.bid * 8 + F.wave, NGW = F.G * 8;
    const int gt = F.bid * 512 + F.tid, NGT = F.G * 512;
    LAS float* scr = (LAS float*)(F.lds + F.wave * 8448);
    {
        constexpr int I_QKV = 16 * 96, I_Z = 16 * 32, I_G = 16 * 64, I_AB = 16, I_F = 16 * 16, I_SQ = 16 * 32;
        constexpr int PER_LAYER = I_QKV + I_Z + I_G + I_AB + I_F + 2 * I_SQ;
        for (int it = gw; it < DEPTH * PER_LAYER; it += NGW) {
            const int layer = it / PER_LAYER; int r = it % PER_LAYER;
            const float* win = inp(F, I_WIN) + (size_t)layer * D * IN_COLS;
            bf16* wt = WSP(bf16, WS_WIN) + (size_t)layer * WIN_ROWS * D;
            if (r < I_QKV) { transpose_item(win, IN_COLS, 0, D, 3072, wt, 0, 1, 0, scr, r, F.lane); continue; } r -= I_QKV;
            if (r < I_Z)   { transpose_item(win, IN_COLS, OFF_Z, D, 1024, wt, PM_Z, 1, 0, scr, r, F.lane); continue; } r -= I_Z;
            if (r < I_G)   { transpose_item(win, IN_COLS, OFF_G, D, 2048, wt, PM_GA, 1, 0, scr, r, F.lane); continue; } r -= I_G;
            if (r < I_AB)  { transpose_item(win, IN_COLS, OFF_A, D, 32, wt, PM_AB, 1, 0, scr, r, F.lane); continue; } r -= I_AB;
            if (r < I_F)   { transpose_item(win, IN_COLS, OFF_F, D, 512, wt, PM_LD, 1, 0, scr, r, F.lane); continue; } r -= I_F;
            if (r < I_SQ)  { transpose_item(inp(F, I_WDL) + (size_t)layer * D * D, D, 0, D, D, WSP(bf16, WS_WDL) + (size_t)layer * D * D, 0, 1, 0, scr, r, F.lane); continue; } r -= I_SQ;
            transpose_item(inp(F, I_WOUT) + (size_t)layer * D * D, D, 0, D, D, WSP(bf16, WS_WOUT) + (size_t)layer * D * D, 0, 1, 0, scr, r, F.lane);
        }
        for (int i = gt; i < DEPTH * 224 * (D / 8); i += NGT) { const int layer = i / (224 * 128), rr = i % (224 * 128);
            *(u32x4*)(WSP(bf16, WS_WIN) + ((size_t)layer * WIN_ROWS + 6176) * D + (size_t)rr * 8) = (u32x4){0u, 0u, 0u, 0u}; }
    }
    {
        LAS float* tb = (LAS float*)(F.lds + 8 * 8448);
        if (F.tid < 128) { tb[F.tid] = cospif((float)F.tid / 64.f); tb[128 + F.tid] = -sinpif((float)F.tid / 64.f); }
        __syncthreads();
        for (int it = gw; it < DEPTH * 4 * 2 * 16 * 4; it += NGW) {
            const int cb = it & 3, nb = (it >> 2) & 15, ri = (it >> 6) & 1, g = (it >> 7) & 3, layer = it >> 9;
            const int n = nb * 64 + F.lane;
            const float* wf = inp(F, I_WF) + ((size_t)layer * 512 + g * 128) * D + n;
            float o[32];
#pragma unroll
            for (int q = 0; q < 32; ++q) o[q] = 0.f;
#pragma unroll 4
            for (int cp = 0; cp < 128; ++cp) { const float w = wf[(size_t)cp * D];
#pragma unroll
                for (int q = 0; q < 32; ++q) o[q] += tb[ri * 128 + (((cb * 32 + q) * cp) & 127)] * w; }
            bf16* dst = WSP(bf16, WS_WPA) + ((size_t)layer * D + n) * D + g * 256 + ri * 128 + cb * 32;
#pragma unroll
            for (int q8 = 0; q8 < 4; ++q8) { const float sc_ = 0.08838834764831845f;
                *(u32x4*)(dst + q8 * 8) = (u32x4){pk2(o[q8 * 8] * sc_, o[q8 * 8 + 1] * sc_), pk2(o[q8 * 8 + 2] * sc_, o[q8 * 8 + 3] * sc_), pk2(o[q8 * 8 + 4] * sc_, o[q8 * 8 + 5] * sc_), pk2(o[q8 * 8 + 6] * sc_, o[q8 * 8 + 7] * sc_)}; }
        }
        __syncthreads();
    }
    for (int i = gt; i < 8192 * 512; i += NGT) { const int row = i >> 9, t0 = (i & 511) * 8, ri = row >> 12, tp = row & 4095; float v[8];
#pragma unroll
        for (int q = 0; q < 8; ++q) { const int m = ((t0 + q) * tp) & 4095; const float x = (float)m / 2048.f; v[q] = (ri ? sinpif(x) : cospif(x)) * (1.f / 64.f); }
        *(u32x4*)(WSP(bf16, WS_DFTL) + (size_t)row * 4096 + t0) = (u32x4){pk2(v[0], v[1]), pk2(v[2], v[3]), pk2(v[4], v[5]), pk2(v[6], v[7])}; }
    for (int i = gt; i < 512 * 32; i += NGT) { const int row = i >> 5, t0 = (i & 31) * 8, ri = row >> 8, tp = row & 255; float v[8];
#pragma unroll
        for (int q = 0; q < 8; ++q) { const int m = ((t0 + q) * tp) & 255; const float x = (float)m / 128.f; v[q] = (ri ? sinpif(x) : cospif(x)) * (1.f / 16.f); }
        *(u32x4*)(WSP(bf16, WS_DFTC) + (size_t)row * 256 + t0) = (u32x4){pk2(v[0], v[1]), pk2(v[2], v[3]), pk2(v[4], v[5]), pk2(v[6], v[7])}; }
    { const f32x4* pc_ = (const f32x4*)inp(F, I_CTX); const f32x4* px_ = (const f32x4*)inp(F, I_X);
    for (size_t i = gt; i < (size_t)NTOK * D / 4; i += NGT) {
        const f32x4 v = (i < (size_t)NCTX * D / 4) ? pc_[i] : px_[i - (size_t)NCTX * D / 4];
        WSP(f32x4, WS_X)[i] = v; } }
    {
        LAS float* sc = (LAS float*)(F.lds + 8 * 8448 + 1024);
        { const float* pc_ = inp(F, I_C); const float* pcc_ = inp(F, I_CCTX);
        for (int i = F.tid; i < 9 * 1024; i += 512) { const float v = (i < 8192) ? pc_[i] : pcc_[i - 8192]; sc[i] = siluf_(v); } }
        __syncthreads();
        for (int it = gw; it < DEPTH * 192; it += NGW) {
            const int layer = it / 192, cb = it % 192, col = cb * 32 + (F.lane & 31), kp = F.lane >> 5;
            const float* wm = inp(F, I_WMOD) + (size_t)layer * D * 6144 + col;
            float acc[9];
#pragma unroll
            for (int r = 0; r < 9; ++r) acc[r] = 0.f;
#pragma unroll 4
            for (int k = kp; k < 1024; k += 2) { const float w = wm[(size_t)k * 6144];
#pragma unroll
                for (int r = 0; r < 9; ++r) acc[r] += sc[r * 1024 + k] * w; }
#pragma unroll
            for (int r = 0; r < 9; ++r) acc[r] += __shfl_xor(acc[r], 32);
            if (kp == 0) { const float bm = inp(F, I_BMOD)[layer * 6144 + col];
#pragma unroll
                for (int r = 0; r < 9; ++r) WSP(float, WS_MOD)[((size_t)layer * 9 + r) * 6144 + col] = acc[r] + bm; }
        }
        __syncthreads();
    }
}

__device__ __forceinline__ void moe_weight_convert(Frame& F, const Args& a, int layer, int w0, LAS float* scr) {
    const int nw = 8 - w0, gw = F.bid * nw + (F.wave - w0), NGW = F.G * nw;
    constexpr int PER_E = 768;
    for (int it = gw; it < NEXP * PER_E; it += NGW) {
        const int e = it / PER_E; int r = it % PER_E;
        const size_t eo = ((size_t)layer * NEXP + e) * (size_t)D * EDIM;
        bf16* wgu = WSP(bf16, WS_MOEW) + (size_t)e * 1024 * 1024;
        if (r < 256) { transpose_item(inp(F, I_WG) + eo, EDIM, 0, D, EDIM, wgu, 0, 2, 0, scr, r, F.lane); continue; } r -= 256;
        if (r < 256) { transpose_item(inp(F, I_WU) + eo, EDIM, 0, D, EDIM, wgu, 0, 2, 1, scr, r, F.lane); continue; } r -= 256;
        transpose_item(inp(F, I_WD) + eo, D, 0, EDIM, D, WSP(bf16, WS_MOEWD) + (size_t)e * 1024 * 512, 0, 1, 0, scr, r, F.lane);
    }
}

__device__ __forceinline__ int mod_row(int row) { return row < NCTX ? 8 : ((row - NCTX) >> 12); }

template <int MODE, bool COMBINE>
__device__ __forceinline__ void phase_norm(Frame& F, const Args& a, int layer) {
    const int gw = F.bid * 8 + F.wave, NGW = F.G * 8;
    const f32x4* fwp = (const f32x4*)inp(F, MODE == 1 ? I_FNORM : I_NMIX) + (MODE == 1 ? 0 : layer * 256) + F.lane; f32x4* outp = (f32x4*)inp(F, 24);
    for (int row = gw; row < NTOK; row += NGW) {
        const int mb = mod_row(row);
        f32x4* xr = WSP(f32x4, WS_X) + (size_t)row * 256 + F.lane;
        f32x4 v[4];
#pragma unroll
        for (int j = 0; j < 4; ++j) v[j] = xr[64 * j];
        if (COMBINE) {
            const int* so = WSP(int, WS_ROUTE + 2 * NTOK * 8) + row * 2; const float* cb = WSP(float, WS_ROUTE + NTOK * 8) + row * 2;
            const int s0 = so[0], s1 = so[1]; const float c0 = cb[0], c1 = cb[1];
            const f32x4* g2 = WSP(f32x4, WS_MOD) + ((size_t)(layer - 1) * 9 + mb) * 1536 + 5 * 256 + F.lane;
            const u32x2* y0 = WSP(u32x2, WS_YS) + (size_t)s0 * 256 + F.lane; const u32x2* y1 = WSP(u32x2, WS_YS) + (size_t)s1 * 256 + F.lane;
#pragma unroll
            for (int j = 0; j < 4; ++j) { const u32x2 p = y0[64 * j], q = y1[64 * j]; const f32x4 g = g2[64 * j];
                v[j].x += g.x * (c0 * bf_lo(p.x) + c1 * bf_lo(q.x)); v[j].y += g.y * (c0 * bf_hi(p.x) + c1 * bf_hi(q.x));
                v[j].z += g.z * (c0 * bf_lo(p.y) + c1 * bf_lo(q.y)); v[j].w += g.w * (c0 * bf_hi(p.y) + c1 * bf_hi(q.y));
                if (MODE == 0) xr[64 * j] = v[j]; }
        }
        float ss = 0.f;
#pragma unroll
        for (int j = 0; j < 4; ++j) ss += (v[j].x * v[j].x + v[j].y * v[j].y) + (v[j].z * v[j].z + v[j].w * v[j].w);
        const float r = rsqrtf(wave_sum(ss) * (1.f / 1024.f) + EPS);
        if (MODE == 1) {
            if (row >= NCTX) { const f32x4* fw = fwp; f32x4* o = outp + (size_t)(row - NCTX) * 256 + F.lane;
#pragma unroll
                for (int j = 0; j < 4; ++j) o[64 * j] = v[j] * r * fw[64 * j]; }
        } else {
            const f32x4* nw = fwp;
            const f32x4* sh = WSP(f32x4, WS_MOD) + ((size_t)layer * 9 + mb) * 1536 + 0 * 256 + F.lane;
            const f32x4* sc = WSP(f32x4, WS_MOD) + ((size_t)layer * 9 + mb) * 1536 + 1 * 256 + F.lane;
            u32x2* ho = WSP(u32x2, WS_H) + (size_t)row * 256 + F.lane;
#pragma unroll
            for (int j = 0; j < 4; ++j) { const f32x4 h = v[j] * r * nw[64 * j] * (sc[64 * j] + 1.f) + sh[64 * j];
                ho[64 * j] = (u32x2){pk2(h.x, h.y), pk2(h.z, h.w)}; }
        }
    }
}

__device__ __forceinline__ void ffn_row(Frame& F, const f32x4* nw, int layer, int row, f32x4 (&h)[4]) {
    const int mb = mod_row(row);
    const f32x4* xr = WSP(f32x4, WS_X) + (size_t)row * 256 + F.lane;
    f32x4 v[4]; float ss = 0.f;
#pragma unroll
    for (int j = 0; j < 4; ++j) { v[j] = xr[64 * j]; ss += (v[j].x * v[j].x + v[j].y * v[j].y) + (v[j].z * v[j].z + v[j].w * v[j].w); }
    const float r = rsqrtf(wave_sum(ss) * (1.f / 1024.f) + EPS);
    const f32x4* sh = WSP(f32x4, WS_MOD) + ((size_t)layer * 9 + mb) * 1536 + 3 * 256 + F.lane;
    const f32x4* sc = WSP(f32x4, WS_MOD) + ((size_t)layer * 9 + mb) * 1536 + 4 * 256 + F.lane;
#pragma unroll
    for (int j = 0; j < 4; ++j) h[j] = v[j] * r * nw[64 * j] * (sc[64 * j] + 1.f) + sh[64 * j];
}

__device__ __forceinline__ void phase_route(Frame& F, const Args& a, int layer) {
    const int gw = F.bid * 8 + F.wave, NGW = F.G * 8;
    LAS float* wl = (LAS float*)F.lds;
    volatile LAS unsigned* cl = F.LCTL + 64;
    const float* wrg = inp(F, I_WRG) + (size_t)layer * D * 4; const float* wre = inp(F, I_WRE) + (size_t)layer * D * 32;
    for (int i = F.tid; i < 1024 * 4; i += 512) { const int k = i >> 2, j = i & 3; wl[((k >> 2) * 37 + j) * 4 + (k & 3)] = wrg[i]; }
    for (int i = F.tid; i < 1024 * 32; i += 512) { const int k = i >> 5, j = i & 31; wl[((k >> 2) * 37 + 4 + j) * 4 + (k & 3)] = wre[i]; }
    if (F.tid < 32) cl[F.tid] = 0u;
    __syncthreads();
    const float* brg = inp(F, I_BRG) + layer * 4; const float* bre = inp(F, I_BRE) + layer * 32;
    const f32x4* nwp = (const f32x4*)(inp(F, I_NFFN) + layer * D) + F.lane;
    for (int row = gw; row < NTOK; row += NGW) {
        f32x4 h[4]; ffn_row(F, nwp, layer, row, h);
        float lg[4];
#pragma unroll
        for (int g = 0; g < 4; ++g) { float s = 0.f;
#pragma unroll
            for (int j = 0; j < 4; ++j) { const f32x4 w = *(const LAS f32x4*)(wl + ((F.lane + 64 * j) * 37 + g) * 4); s += (h[j].x * w.x + h[j].y * w.y) + (h[j].z * w.z + h[j].w * w.w); }
            lg[g] = wave_sum(s) + brg[g]; }
        int grp = 0; float mx = lg[0];
#pragma unroll
        for (int g = 1; g < 4; ++g) if (lg[g] > mx) { mx = lg[g]; grp = g; }
        float den = 0.f;
#pragma unroll
        for (int g = 0; g < 4; ++g) den += __expf(lg[g] - mx);
        const float pgrp = 1.f / den;
        float le[8];
#pragma unroll
        for (int e = 0; e < 8; ++e) { float s = 0.f;
#pragma unroll
            for (int j = 0; j < 4; ++j) { const f32x4 w = *(const LAS f32x4*)(wl + ((F.lane + 64 * j) * 37 + 4 + grp * 8 + e) * 4); s += (h[j].x * w.x + h[j].y * w.y) + (h[j].z * w.z + h[j].w * w.w); }
            le[e] = wave_sum(s) + bre[grp * 8 + e]; }
        int i0 = 0; float v0 = le[0];
#pragma unroll
        for (int e = 1; e < 8; ++e) if (le[e] > v0) { v0 = le[e]; i0 = e; }
        int i1 = -1; float v1 = -3.0e38f;
#pragma unroll
        for (int e = 0; e < 8; ++e) if (e != i0 && le[e] > v1) { v1 = le[e]; i1 = e; }
        const float e1 = __expf(v1 - v0), inv = 1.f / (1.f + e1);
        if (F.lane == 0) {
            int* eid = WSP(int, WS_ROUTE) + row * 2; float* cb = WSP(float, WS_ROUTE + NTOK * 8) + row * 2;
            eid[0] = grp * 8 + i0; eid[1] = grp * 8 + i1; cb[0] = pgrp * inv; cb[1] = pgrp * e1 * inv;
            __hip_atomic_fetch_add((LAS unsigned*)(cl + grp * 8 + i0), 1u, __ATOMIC_RELAXED, __HIP_MEMORY_SCOPE_WORKGROUP); __hip_atomic_fetch_add((LAS unsigned*)(cl + grp * 8 + i1), 1u, __ATOMIC_RELAXED, __HIP_MEMORY_SCOPE_WORKGROUP);
        }
    }
    __syncthreads();
    if (F.tid < 32) { const unsigned c = cl[F.tid]; if (c) atomicAdd(WSP(unsigned, WS_CTL) + CW_CNT + layer * 64 + F.tid, c); }
}

__device__ __forceinline__ void build_moe_tables(Frame& F, int layer) {
    if (F.tid == 0) {
        const unsigned* cnt = WSP(unsigned, WS_CTL) + CW_CNT + layer * 64;
        unsigned ps = 0; int tile = 0;
        for (int e = 0; e < NEXP; ++e) { const unsigned c = __hip_atomic_load(cnt + e, __ATOMIC_RELAXED, __HIP_MEMORY_SCOPE_AGENT); const unsigned nt = (c + 255u) >> 8;
            F.LCTL[16 + e] = ps; for (unsigned t = 0; t < nt; ++t) F.LCTL[128 + tile++] = (unsigned)e; ps += nt << 8; }
        F.LCTL[16 + NEXP] = ps;
    }
    __syncthreads();
}

__device__ __forceinline__ void phase_assign(Frame& F, const Args& a, int layer) {
    const int gw = F.bid * 8 + F.wave, NGW = F.G * 8;
    build_moe_tables(F, layer);
    const f32x4* nwp = (const f32x4*)(inp(F, I_NFFN) + layer * D) + F.lane;
    int slot = 0;
    { const int it = F.lane >> 1, row = gw + it * NGW;
      if (F.lane < 36 && row < NTOK) { const int e = WSP(int, WS_ROUTE)[row * 2 + (F.lane & 1)];
          slot = (int)F.LCTL[16 + e] + (int)atomicAdd(WSP(unsigned, WS_CTL) + CW_CUR + layer * 64 + e, 1u);
          WSP(int, WS_ROUTE + 2 * NTOK * 8)[row * 2 + (F.lane & 1)] = slot; } }
    int it = 0;
    for (int row = gw; row < NTOK; row += NGW, ++it) {
        const int s0 = __shfl(slot, 2 * it), s1 = __shfl(slot, 2 * it + 1);
        f32x4 h[4]; ffn_row(F, nwp, layer, row, h);
        u32x2* x0 = WSP(u32x2, WS_XS) + (size_t)s0 * 256 + F.lane; u32x2* x1 = WSP(u32x2, WS_XS) + (size_t)s1 * 256 + F.lane;
#pragma unroll
        for (int j = 0; j < 4; ++j) { const u32x2 p = (u32x2){pk2(h[j].x, h[j].y), pk2(h[j].z, h[j].w)}; x0[64 * j] = p; x1[64 * j] = p; }
    }
}

template <int NBLK>
__device__ __forceinline__ void conv_unit(Frame& F, const float* cw, int tok0, int slab) {
    const int r0 = F.tid >> 3, c0 = slab * 128 + (F.tid & 7) * 16;
    const int sect = slab >> 3;
    float w0[16], w1[16], w2[16];
#pragma unroll
    for (int q = 0; q < 16; ++q) { w0[q] = cw[c0 + q]; w1[q] = cw[3072 + c0 + q]; w2[q] = cw[6144 + c0 + q]; }
    float y[NBLK][16];
    constexpr int T = NBLK * 64;
#pragma unroll
    for (int j = 0; j < NBLK; ++j) {
        const int t = r0 + 64 * j;
        const bf16* p = WSP(bf16, WS_PM) + (size_t)(tok0 + t) * PM_LD + c0;
        u32x4 cu[2], pu[2], nu[2];
        cu[0] = *(const u32x4*)p; cu[1] = *(const u32x4*)(p + 8);
        if (t > 0) { pu[0] = *(const u32x4*)(p - PM_LD); pu[1] = *(const u32x4*)(p - PM_LD + 8); } else { pu[0] = pu[1] = (u32x4){0u, 0u, 0u, 0u}; }
        if (t < T - 1) { nu[0] = *(const u32x4*)(p + PM_LD); nu[1] = *(const u32x4*)(p + PM_LD + 8); } else { nu[0] = nu[1] = (u32x4){0u, 0u, 0u, 0u}; }
        float ss = 0.f;
#pragma unroll
        for (int q = 0; q < 16; ++q) { const unsigned cw_ = cu[q >> 3][(q >> 1) & 3], pw_ = pu[q >> 3][(q >> 1) & 3], nw_ = nu[q >> 3][(q >> 1) & 3];
            const float xc = (q & 1) ? bf_hi(cw_) : bf_lo(cw_), xp = (q & 1) ? bf_hi(pw_) : bf_lo(pw_), xn = (q & 1) ? bf_hi(nw_) : bf_lo(nw_);
            const float s = siluf_(w0[q] * xp + w1[q] * xc + w2[q] * xn); y[j][q] = s; ss += s * s; }
        if (sect < 2) { ss += __shfl_xor(ss, 1); ss += __shfl_xor(ss, 2); ss += __shfl_xor(ss, 4);
            const float sc = rsqrtf(ss + EPS) * (sect == 0 ? 0.08838834764831845f : 1.f);
#pragma unroll
            for (int q = 0; q < 16; ++q) y[j][q] *= sc; }
    }
    __syncthreads();
#pragma unroll
    for (int j = 0; j < NBLK; ++j) {
        bf16* p = WSP(bf16, WS_PM) + (size_t)(tok0 + r0 + 64 * j) * PM_LD + c0;
        *(u32x4*)p = (u32x4){pk2(y[j][0], y[j][1]), pk2(y[j][2], y[j][3]), pk2(y[j][4], y[j][5]), pk2(y[j][6], y[j][7])};
        *(u32x4*)(p + 8) = (u32x4){pk2(y[j][8], y[j][9]), pk2(y[j][10], y[j][11]), pk2(y[j][12], y[j][13]), pk2(y[j][14], y[j][15])};
    }
}
__device__ __forceinline__ void phase_conv(Frame& F, const Args& a, int layer) {
    const float* cw = inp(F, I_CONVW) + (size_t)layer * 3 * 3072;
    for (int u = F.bid; u < 8 * 24; u += F.G) conv_unit<4>(F, cw, (u / 24) * 256, u % 24);
    for (int u = F.bid; u < 512 * 24; u += F.G) conv_unit<1>(F, cw, NCTX + (u / 24) * 64, u % 24);
    const int gt = F.bid * 512 + F.tid, NGT = F.G * 512;
    const float dtb_ = inp(F, I_DTB)[layer * 16 + (gt & 15)], ea_ = __expf(inp(F, I_ALOG)[layer * 16 + (gt & 15)]);
    for (int i = gt; i < NTOK * 16; i += NGT) { const int tok = i >> 4, dh = i & 15;
        const bf16* p = WSP(bf16, WS_PM) + (size_t)tok * PM_LD + PM_AB;
        const float av = bf2f(p[dh]) + dtb_, bv = bf2f(p[16 + dh]);
        const float sp = av > 20.f ? av : log1pf(__expf(av));
        WSP(float, WS_GB)[(size_t)dh * NTOK + tok] = -ea_ * sp;
        WSP(float, WS_GB)[(size_t)(16 + dh) * NTOK + tok] = sigmoidf_(bv); }
}

__device__ __forceinline__ int scan_tok(int b, int dir, int s) { return s < 256 ? (b * 256 + (dir ? 255 - s : s)) : (NCTX + b * 4096 + (dir ? 4095 - (s - 256) : (s - 256))); }
__device__ __forceinline__ void scan_naive_unit(Frame& F, int unit, LAS float* base) {
    const int vq = unit & 3, dir = (unit >> 2) & 1, h = (unit >> 3) & 7, b = unit >> 6, lane = F.lane, kh = lane >> 5, vc = lane & 31;
    float S[64];
#pragma unroll
    for (int i = 0; i < 64; ++i) S[i] = 0.f;
    constexpr int BUFW = 4096 + 512 + 32;
    const float* gp = WSP(float, WS_GB) + (size_t)(dir * 8 + h) * NTOK; const float* bp = WSP(float, WS_GB) + (size_t)(16 + dir * 8 + h) * NTOK;
    const bf16* pm = WSP(bf16, WS_PM);
    bf16* obuf = WSP(bf16, dir ? WS_OB : WS_OF);
    u32x4 pq[8]; bf16 pv[8]; float pg = 0.f, pb = 0.f;
#define SCAN_ISSUE(blk) do { \
        _Pragma("unroll") for (int j = 0; j < 8; ++j) { const int id = j * 64 + lane, r = id >> 5, c = id & 31; const int tok = scan_tok(b, dir, (blk) * 16 + r); \
            pq[j] = *(const u32x4*)(pm + (size_t)tok * PM_LD + (c < 16 ? 0 : 1024) + h * 128 + (c & 15) * 8); } \
        _Pragma("unroll") for (int r = 0; r < 8; ++r) { const int tok = scan_tok(b, dir, (blk) * 16 + kh * 8 + r); pv[r] = pm[(size_t)tok * PM_LD + 2048 + h * 128 + vq * 32 + vc]; } \
        if (lane < 16) { const int tok = scan_tok(b, dir, (blk) * 16 + lane); pg = gp[tok]; pb = bp[tok]; } } while (0)
    SCAN_ISSUE(0);
    for (int blk = 0; blk < 272; ++blk) {
        LAS float* q = base + (blk & 1) * BUFW;
#pragma unroll
        for (int j = 0; j < 8; ++j) { const int id = j * 64 + lane, r = id >> 5, c = id & 31; LAS float* d = q + r * 256 + c * 8;
            *(LAS f32x4*)d = (f32x4){bf_lo(pq[j].x), bf_hi(pq[j].x), bf_lo(pq[j].y), bf_hi(pq[j].y)};
            *(LAS f32x4*)(d + 4) = (f32x4){bf_lo(pq[j].z), bf_hi(pq[j].z), bf_lo(pq[j].w), bf_hi(pq[j].w)}; }
#pragma unroll
        for (int r = 0; r < 8; ++r) q[4096 + (kh * 8 + r) * 32 + vc] = bf2f(pv[r]);
        if (lane < 16) { q[4608 + lane] = __expf(pg); q[4624 + lane] = pb; }
        if (blk + 1 < 272) SCAN_ISSUE(blk + 1);
        asm volatile("" ::: "memory");
#pragma nounroll
        for (int s = 0; s < 16; ++s) {
            const LAS float* qr = q + s * 256 + kh * 64; const LAS float* kr = qr + 128;
            const float eg = q[4608 + s], be = q[4624 + s], vv = q[4096 + s * 32 + vc];
            float ks = 0.f;
#pragma unroll
            for (int i = 0; i < 16; ++i) { const f32x4 k4 = *(const LAS f32x4*)(kr + 4 * i); ks += (k4.x * S[4 * i] + k4.y * S[4 * i + 1]) + (k4.z * S[4 * i + 2] + k4.w * S[4 * i + 3]); }
            ks += __shfl_xor(ks, 32);
            const float dd = be * (vv - eg * ks);
            float o = 0.f;
#pragma unroll
            for (int i = 0; i < 16; ++i) { const f32x4 k4 = *(const LAS f32x4*)(kr + 4 * i); const f32x4 q4 = *(const LAS f32x4*)(qr + 4 * i);
                S[4 * i] = eg * S[4 * i] + k4.x * dd; S[4 * i + 1] = eg * S[4 * i + 1] + k4.y * dd; S[4 * i + 2] = eg * S[4 * i + 2] + k4.z * dd; S[4 * i + 3] = eg * S[4 * i + 3] + k4.w * dd;
                o += (q4.x * S[4 * i] + q4.y * S[4 * i + 1]) + (q4.z * S[4 * i + 2] + q4.w * S[4 * i + 3]);
                if (i == 7) asm volatile("" ::: "memory"); }
            o += __shfl_xor(o, 32);
            if (kh == 0) { const int tok = scan_tok(b, dir, blk * 16 + s); obuf[(size_t)tok * D + h * 128 + vq * 32 + vc] = (bf16)f2bf(o); }
            asm volatile("" ::: "memory");
        }
    }
#undef SCAN_ISSUE
}

__device__ __forceinline__ void phase_od(Frame& F, const Args& a, int layer) {
    const int gw = F.bid * 8 + F.wave, NGW = F.G * 8;
    const f32x4 on = *((const f32x4*)(inp(F, I_ONORM) + layer * 128) + (F.lane & 31));
    for (int row = gw; row < NTOK; row += NGW) {
        const u32x2* of = WSP(u32x2, WS_OF) + (size_t)row * 256 + F.lane; const u32x2* ob = WSP(u32x2, WS_OB) + (size_t)row * 256 + F.lane;
        const bf16* zr = WSP(bf16, WS_PM) + (size_t)row * PM_LD + PM_Z + 4 * F.lane;
        u32x2* od = WSP(u32x2, WS_H) + (size_t)row * 256 + F.lane;
#pragma unroll
        for (int j = 0; j < 4; ++j) { const u32x2 p = of[64 * j], q = ob[64 * j]; const u32x2 z = *(const u32x2*)(zr + 256 * j);
            f32x4 o = (f32x4){bf_lo(p.x) + bf_lo(q.x), bf_hi(p.x) + bf_hi(q.x), bf_lo(p.y) + bf_lo(q.y), bf_hi(p.y) + bf_hi(q.y)};
            float ss = (o.x * o.x + o.y * o.y) + (o.z * o.z + o.w * o.w);
            ss += __shfl_xor(ss, 1); ss += __shfl_xor(ss, 2); ss += __shfl_xor(ss, 4); ss += __shfl_xor(ss, 8); ss += __shfl_xor(ss, 16);
            const float r = rsqrtf(ss * (1.f / 128.f) + EPS);
            o = o * r * on;
            o.x *= siluf_(bf_lo(z.x)); o.y *= siluf_(bf_hi(z.x)); o.z *= siluf_(bf_lo(z.y)); o.w *= siluf_(bf_hi(z.y));
            od[64 * j] = (u32x2){pk2(o.x, o.y), pk2(o.z, o.w)}; }
    }
}

struct SchedMain {
    const char* H; const char* W; int G, c;
    __device__ __forceinline__ bool next(int i, Unit& u) const {
        const int L = i * G + c; constexpr int NM = NTILE * 25;
        if (L >= NM + 2 * NTILE) return false;
        if (L < NM) { int pm, pn; pg8::tile_map(L, NTILE, 25, pm, pn); u.pm = pm; u.pn = pn; u.aux = 0; }
        else { const int f = L - NM; u.pm = f & 1; u.pn = f >> 1; u.aux = 1; }
        return true;
    }
    __device__ __forceinline__ const char* a_ptr(const Unit& u) const { return u.aux ? W + (size_t)(PM_LD + u.pm * 256) * D * 2 : H + (size_t)u.pm * 256 * D * 2; }
    __device__ __forceinline__ const char* b_ptr(const Unit& u) const { return u.aux ? H + (size_t)u.pn * 256 * D * 2 : W + (size_t)u.pn * 256 * D * 2; }
};
#define EPI_LANE_IDX int tz_ = threadIdx.x; asm volatile("" : "+v"(tz_)); const int wr_ = tz_ >> 8, wc_ = (tz_ >> 6) & 3, fr_ = tz_ & 15, fq_ = (tz_ >> 4) & 3; (void)wr; (void)wc; (void)fr; (void)fq;
#define EPI_ROWS_BEGIN EPI_LANE_IDX const int rbase = wr_ * 64 + fr_, cbase = wc_ * 32 + 8 * fq_; (void)rbase; (void)cbase;
struct EpiMain {
    static constexpr bool PERM = true;
    bf16* PM; bf16* UTL; bf16* UTC;
    __device__ __forceinline__ void operator()(const f32x4 (&acc)[2][2][4][2], const Unit& u, int wr, int wc, int fr, int fq) const {
        EPI_ROWS_BEGIN
#pragma unroll
        for (int ai = 0; ai < 2; ++ai)
#pragma unroll
            for (int m = 0; m < 4; ++m) { const int r = ai * 128 + m * 16 + rbase;
                bf16* rowp;
                if (u.aux == 0) rowp = PM + (size_t)(u.pm * 256 + r) * PM_LD + u.pn * 256 + cbase;
                else { const int ch = u.pm * 256 + r;
                    if (u.pn < 8) rowp = UTC + ((size_t)(u.pn * 512 + ch)) * 256 + cbase;
                    else { const int q = u.pn - 8; rowp = UTL + ((size_t)((q >> 4) * 512 + ch)) * 4096 + (q & 15) * 256 + cbase; } }
#pragma unroll
                for (int bj = 0; bj < 2; ++bj) { const f32x4 v0 = acc[ai][bj][m][0], v1 = acc[ai][bj][m][1];
                    *(u32x4*)(rowp + bj * 128) = (u32x4){cvt_pk_bf16(v0[0], v0[1]), cvt_pk_bf16(v0[2], v0[3]), cvt_pk_bf16(v1[0], v1[1]), cvt_pk_bf16(v1[2], v1[3])}; } }
    }
};
template <int LAT> struct SchedDft {
    const char* A; const char* B; int G, c;
    __device__ __forceinline__ bool next(int i, Unit& u) const {
        const int L = i * G + c;
        if (LAT) { if (L >= 512) return false; u.aux = L >> 6; u.pm = (L & 63) >> 1; u.pn = L & 1; }
        else { if (L >= 32) return false; u.aux = L >> 2; u.pm = (L >> 1) & 1; u.pn = L & 1; }
        return true;
    }
    __device__ __forceinline__ const char* a_ptr(const Unit& u) const { return A + (size_t)u.pm * 256 * (LAT ? 4096 : 256) * 2; }
    __device__ __forceinline__ const char* b_ptr(const Unit& u) const { return B + ((size_t)u.aux * 512 + u.pn * 256) * (LAT ? 4096 : 256) * 2; }
};
template <int LAT> struct EpiDft {
    static constexpr bool PERM = true;
    bf16* PBUF;
    __device__ __forceinline__ void operator()(const f32x4 (&acc)[2][2][4][2], const Unit& u, int wr, int wc, int fr, int fq) const {
        EPI_ROWS_BEGIN
        const int ri = LAT ? (u.pm >> 4) : u.pm;
        const int tokb = LAT ? (NCTX + u.aux * 4096 + (u.pm & 15) * 256) : (u.aux * 256);
#pragma unroll
        for (int ai = 0; ai < 2; ++ai)
#pragma unroll
            for (int m = 0; m < 4; ++m) { const int r = ai * 128 + m * 16 + rbase;
#pragma unroll
                for (int bj = 0; bj < 2; ++bj) { const int ch = u.pn * 256 + bj * 128 + cbase; const f32x4 v0 = acc[ai][bj][m][0], v1 = acc[ai][bj][m][1];
                    *(u32x4*)(PBUF + (size_t)(tokb + r) * D + (ch >> 7) * 256 + ri * 128 + (ch & 127)) =
                        (u32x4){cvt_pk_bf16(v0[0], v0[1]), cvt_pk_bf16(v0[2], v0[3]), cvt_pk_bf16(v1[0], v1[1]), cvt_pk_bf16(v1[2], v1[3])}; } }
    }
};
struct SchedRows {
    const char* A; const char* B; int G, c;
    __device__ __forceinline__ bool next(int i, Unit& u) const {
        const int L = i * G + c; if (L >= NTILE * 4) return false;
        int pm, pn; pg8::tile_map(L, NTILE, 4, pm, pn); u.pm = pm; u.pn = pn; u.aux = 0; return true;
    }
    __device__ __forceinline__ const char* a_ptr(const Unit& u) const { return A + (size_t)u.pm * 256 * D * 2; }
    __device__ __forceinline__ const char* b_ptr(const Unit& u) const { return B + (size_t)u.pn * 256 * D * 2; }
};
template <int MODE> struct EpiGate {
    static constexpr bool PERM = true;
    bf16* M; const bf16* PM;
    __device__ __forceinline__ void operator()(const f32x4 (&acc)[2][2][4][2], const Unit& u, int wr, int wc, int fr, int fq) const {
        EPI_ROWS_BEGIN
#pragma unroll
        for (int ai = 0; ai < 2; ++ai)
#pragma unroll
            for (int m = 0; m < 4; ++m) { const int row = u.pm * 256 + ai * 128 + m * 16 + rbase;
#pragma unroll
                for (int bj = 0; bj < 2; ++bj) { const int col = u.pn * 256 + bj * 128 + cbase; const f32x4 v0 = acc[ai][bj][m][0], v1 = acc[ai][bj][m][1];
                    const u32x4 g = *(const u32x4*)(PM + (size_t)row * PM_LD + (MODE == 0 ? PM_GA : PM_GB) + col);
                    float o[8] = {v0[0] * sigmoidf_(bf_lo(g.x)), v0[1] * sigmoidf_(bf_hi(g.x)), v0[2] * sigmoidf_(bf_lo(g.y)), v0[3] * sigmoidf_(bf_hi(g.y)),
                                  v1[0] * sigmoidf_(bf_lo(g.z)), v1[1] * sigmoidf_(bf_hi(g.z)), v1[2] * sigmoidf_(bf_lo(g.w)), v1[3] * sigmoidf_(bf_hi(g.w))};
                    u32x4* mp = (u32x4*)(M + (size_t)row * D + col);
                    if (MODE == 1) { const u32x4 p = *mp; o[0] += bf_lo(p.x); o[1] += bf_hi(p.x); o[2] += bf_lo(p.y); o[3] += bf_hi(p.y); o[4] += bf_lo(p.z); o[5] += bf_hi(p.z); o[6] += bf_lo(p.w); o[7] += bf_hi(p.w); }
                    *mp = (u32x4){cvt_pk_bf16(o[0], o[1]), cvt_pk_bf16(o[2], o[3]), cvt_pk_bf16(o[4], o[5]), cvt_pk_bf16(o[6], o[7])}; } }
    }
};
struct EpiResid {
    static constexpr bool PERM = false;
    float* X; const float* MODL;
    __device__ __forceinline__ void operator()(const f32x4 (&acc)[2][2][4][2], const Unit& u, int wr, int wc, int fr, int fq) const {
        EPI_LANE_IDX
        const int rbase = wr_ * 64 + fr_, cb = u.pn * 256 + wc_ * 32 + 4 * fq_;
        const int mb = mod_row(u.pm * 256);
        f32x4 gv[2][2];
#pragma unroll
        for (int bj = 0; bj < 2; ++bj)
#pragma unroll
            for (int n = 0; n < 2; ++n) gv[bj][n] = *(const f32x4*)(MODL + (size_t)mb * 6144 + 2048 + cb + bj * 128 + n * 16);
#pragma unroll
        for (int ai = 0; ai < 2; ++ai)
#pragma unroll
            for (int m = 0; m < 4; ++m) { float* rowp = X + (size_t)(u.pm * 256 + ai * 128 + m * 16 + rbase) * D + cb;
#pragma unroll
                for (int bj = 0; bj < 2; ++bj)
#pragma unroll
                    for (int n = 0; n < 2; ++n) { f32x4* p = (f32x4*)(rowp + bj * 128 + n * 16); *p = *p + gv[bj][n] * acc[ai][bj][m][n]; } }
    }
};
template <int KD> struct SchedMoe {
    const char* A; const char* W; volatile LAS unsigned* LCTL; int G, c, ntile;
    __device__ __forceinline__ bool next(int i, Unit& u) const {
        const int L = i * G + c;
        if (L >= ntile * 4) return false;
        u.pm = L >> 2; u.pn = L & 3; u.aux = __builtin_amdgcn_readfirstlane((int)LCTL[128 + (L >> 2)]); return true;
    }
    __device__ __forceinline__ const char* a_ptr(const Unit& u) const { return A + (size_t)u.pm * 256 * KD * 2; }
    __device__ __forceinline__ const char* b_ptr(const Unit& u) const { return W + ((size_t)u.aux * 1024 + u.pn * 256) * KD * 2; }
};
struct EpiGU {
    static constexpr bool PERM = true;
    bf16* HID;
    __device__ __forceinline__ void operator()(const f32x4 (&acc)[2][2][4][2], const Unit& u, int wr, int wc, int fr, int fq) const {
        EPI_ROWS_BEGIN
#pragma unroll
        for (int ai = 0; ai < 2; ++ai)
#pragma unroll
            for (int m = 0; m < 4; ++m) { const int row = u.pm * 256 + ai * 128 + m * 16 + rbase;
#pragma unroll
                for (int bj = 0; bj < 2; ++bj) { const f32x4 v0 = acc[ai][bj][m][0], v1 = acc[ai][bj][m][1];
                    *(u32x2*)(HID + (size_t)row * EDIM + u.pn * 128 + ((bj * 128 + cbase) >> 1)) =
                        (u32x2){cvt_pk_bf16(siluf_(v0[0]) * v0[1], siluf_(v0[2]) * v0[3]), cvt_pk_bf16(siluf_(v1[0]) * v1[1], siluf_(v1[2]) * v1[3])}; } }
    }
};
struct EpiDown {
    static constexpr bool PERM = true;
    bf16* YS;
    __device__ __forceinline__ void operator()(const f32x4 (&acc)[2][2][4][2], const Unit& u, int wr, int wc, int fr, int fq) const {
        EPI_ROWS_BEGIN
#pragma unroll
        for (int ai = 0; ai < 2; ++ai)
#pragma unroll
            for (int m = 0; m < 4; ++m) { const int row = u.pm * 256 + ai * 128 + m * 16 + rbase;
#pragma unroll
                for (int bj = 0; bj < 2; ++bj) { const f32x4 v0 = acc[ai][bj][m][0], v1 = acc[ai][bj][m][1];
                    *(u32x4*)(YS + (size_t)row * D + u.pn * 256 + bj * 128 + cbase) = (u32x4){cvt_pk_bf16(v0[0], v0[1]), cvt_pk_bf16(v0[2], v0[3]), cvt_pk_bf16(v1[0], v1[1]), cvt_pk_bf16(v1[2], v1[3])}; } }
    }
};

constexpr int PH_PER_LAYER = 11, PH_FINAL = 1 + DEPTH * PH_PER_LAYER, N_PHASES = PH_FINAL + 1;
__global__ void __launch_bounds__(512, 2) fwd_kernel(Args args) {
    extern __shared__ __attribute__((aligned(16))) unsigned char lds[];
    Frame F;
    F.lds = (LAS unsigned char*)lds; F.LCTL = (volatile LAS unsigned*)(F.lds + LDSCTL_OFF);
    F.ws = args.ws; F.tid = threadIdx.x; F.lane = F.tid & 63; F.wave = __builtin_amdgcn_readfirstlane(F.tid >> 6); F.G = gridDim.x; F.bid = blockIdx.x;
    for (int u = F.tid; u < 512; u += 512) F.LCTL[u] = 0u;
    if (F.tid < 25) { const unsigned long long p = (F.tid < 24) ? (unsigned long long)args.in[F.tid] : (unsigned long long)args.out; F.LCTL[512 + 2 * F.tid] = (unsigned)p; F.LCTL[513 + 2 * F.tid] = (unsigned)(p >> 32); }
    __syncthreads();
    XcdBarrier bar; bar.bar = WSP(unsigned, WS_CTL) + CW_BAR; bar.x = 0; bar.st = F.LCTL;
    if (ONE_LAUNCH) bar = xcd_barrier_post(WSP(unsigned, WS_CTL) + CW_BAR, F.LCTL);
    const int lo = args.ph_lo, hi = args.ph_hi;
#define IN(k) (lo <= (k) && (k) < hi)
#define SEAM(k) do { if (IN(k) && IN((k) + 1)) { XcdBarrier b2_ = bar; asm volatile("" : "+s"(b2_.bar)); xcd_barrier(b2_); } } while (0)

    if (PHON(0) && IN(0)) { LAUNDER(F); phase_prologue(F, args); SEAM(0); }

    for (int layer = 0; layer < DEPTH; ++layer) {
        const int pb = 1 + layer * PH_PER_LAYER;
        const char* WL = (const char*)(WSP(bf16, WS_WIN) + (size_t)layer * WIN_ROWS * D);
        if (PHON(1) && IN(pb + 0)) { LAUNDER(F); if (layer == 0) phase_norm<0, false>(F, args, layer); else phase_norm<0, true>(F, args, layer); SEAM(pb + 0); }
        if (PHON(2) && IN(pb + 1)) { LAUNDER(F);
            SchedMain S{(const char*)WSP(bf16, WS_H), WL, F.G, F.bid}; EpiMain E{WSP(bf16, WS_PM), WSP(bf16, WS_UTL), WSP(bf16, WS_UTC)};
            pg8::gemm_phase<EpiMain, SchedMain>(F.lds, D, D, D, S, E);
            SEAM(pb + 1);
        }
        if (PHON(3) && IN(pb + 2)) { LAUNDER(F);
            { SchedDft<1> S{(const char*)WSP(bf16, WS_DFTL), (const char*)WSP(bf16, WS_UTL), F.G, F.bid}; EpiDft<1> E{WSP(bf16, WS_PBUF)};
              pg8::gemm_phase<EpiDft<1>, SchedDft<1>>(F.lds, 4096, 4096, 4096, S, E); }
            { SchedDft<0> S{(const char*)WSP(bf16, WS_DFTC), (const char*)WSP(bf16, WS_UTC), F.G, F.bid}; EpiDft<0> E{WSP(bf16, WS_PBUF)};
              pg8::gemm_phase<EpiDft<0>, SchedDft<0>>(F.lds, 256, 256, 256, S, E); }
            phase_conv(F, args, layer);
            SEAM(pb + 2);
        }
        if (PHON(4) && IN(pb + 3)) { LAUNDER(F);
            if (F.wave < 2) { for (int u = F.bid * 2 + F.wave; u < 512; u += F.G * 2) scan_naive_unit(F, u, (LAS float*)(F.lds + F.wave * 40960)); }
            else moe_weight_convert(F, args, layer, 2, (LAS float*)(F.lds + 81920 + (F.wave - 2) * 8448));
            SEAM(pb + 3);
        }
        if (PHON(5) && IN(pb + 4)) { LAUNDER(F); phase_od(F, args, layer); SEAM(pb + 4); }
        if (PHON(6) && IN(pb + 5)) { LAUNDER(F);
            { SchedRows S{(const char*)WSP(bf16, WS_PBUF), (const char*)(WSP(bf16, WS_WPA) + (size_t)layer * D * D), F.G, F.bid}; EpiGate<0> E{WSP(bf16, WS_OF), WSP(bf16, WS_PM)};
              pg8::gemm_phase<EpiGate<0>, SchedRows>(F.lds, D, D, D, S, E); }
            { SchedRows S{(const char*)WSP(bf16, WS_H), (const char*)(WSP(bf16, WS_WDL) + (size_t)layer * D * D), F.G, F.bid}; EpiGate<1> E{WSP(bf16, WS_OF), WSP(bf16, WS_PM)};
              pg8::gemm_phase<EpiGate<1>, SchedRows>(F.lds, D, D, D, S, E); }
            SEAM(pb + 5);
        }
        if (PHON(7) && IN(pb + 6)) { LAUNDER(F);
            SchedRows S{(const char*)WSP(bf16, WS_OF), (const char*)(WSP(bf16, WS_WOUT) + (size_t)layer * D * D), F.G, F.bid}; EpiResid E{WSP(float, WS_X), WSP(float, WS_MOD) + (size_t)layer * 9 * 6144};
            pg8::gemm_phase<EpiResid, SchedRows>(F.lds, D, D, D, S, E);
            SEAM(pb + 6);
        }
        if (PHON(8) && IN(pb + 7)) { LAUNDER(F); phase_route(F, args, layer); SEAM(pb + 7); }
        if (PHON(9) && IN(pb + 8)) { LAUNDER(F); phase_assign(F, args, layer); SEAM(pb + 8); }
        if (PHON(10) && IN(pb + 9)) { LAUNDER(F);
            build_moe_tables(F, layer);
            SchedMoe<D> S{(const char*)WSP(bf16, WS_XS), (const char*)WSP(bf16, WS_MOEW), F.LCTL, F.G, F.bid, __builtin_amdgcn_readfirstlane((int)(F.LCTL[16 + NEXP] >> 8))}; EpiGU E{WSP(bf16, WS_HID)};
            pg8::gemm_phase<EpiGU, SchedMoe<D>>(F.lds, D, D, D, S, E);
            SEAM(pb + 9);
        }
        if (PHON(11) && IN(pb + 10)) { LAUNDER(F);
            build_moe_tables(F, layer);
            SchedMoe<EDIM> S{(const char*)WSP(bf16, WS_HID), (const char*)WSP(bf16, WS_MOEWD), F.LCTL, F.G, F.bid, __builtin_amdgcn_readfirstlane((int)(F.LCTL[16 + NEXP] >> 8))}; EpiDown E{WSP(bf16, WS_YS)};
            pg8::gemm_phase<EpiDown, SchedMoe<EDIM>>(F.lds, EDIM, EDIM, EDIM, S, E);
            SEAM(pb + 10);
        }
    }
    if (PHON(12) && IN(PH_FINAL)) { LAUNDER(F); } if (PHON(12) && IN(PH_FINAL)) phase_norm<1, true>(F, args, DEPTH);
#undef IN
#undef SEAM
}

extern "C" void kernel_launch(void* const* d_in, const int* in_sizes, int n_in, void* d_out, int out_size, void* d_ws, size_t ws_size, hipStream_t stream) {
    static int grid = 0;
    if (grid == 0) {
        if (n_in != 24 || out_size != NLAT * D || ws_size < WS_END) { fprintf(stderr, "kernel_launch: unexpected problem (n_in %d, out %d, ws %zu < %zu)\n", n_in, out_size, ws_size, (size_t)WS_END); grid = -1; return; }
        int dev = 0, cus = 0, per_cu = 0;
        if (hipGetDevice(&dev) != hipSuccess || hipDeviceGetAttribute(&cus, hipDeviceAttributeMultiprocessorCount, dev) != hipSuccess) { grid = -1; return; }
        if (hipFuncSetAttribute((const void*)fwd_kernel, hipFuncAttributeMaxDynamicSharedMemorySize, LDS_BYTES) != hipSuccess) { fprintf(stderr, "kernel_launch: hipFuncSetAttribute failed\n"); grid = -1; return; }
        if (hipOccupancyMaxActiveBlocksPerMultiprocessor(&per_cu, (const void*)fwd_kernel, 512, LDS_BYTES) != hipSuccess || per_cu < 1) fprintf(stderr, "kernel_launch: occupancy query reports %d\n", per_cu);
        (void)hipGetLastError();
        grid = cus;
    }
    if (grid < 0) return;
    hipMemsetAsync((char*)d_ws + WS_CTL, 0, CTL_ZERO_BYTES, stream);
    Args a{};
    for (int i = 0; i < 24; ++i) a.in[i] = (const float*)d_in[i];
    a.out = (float*)d_out; a.ws = (unsigned char*)d_ws;
#if ONE_LAUNCH
    a.ph_lo = 0; a.ph_hi = N_PHASES;
    hipLaunchKernelGGL(fwd_kernel, dim3(grid), dim3(512), LDS_BYTES, stream, a);
#else
    for (int p = 0; p < N_PHASES; ++p) { a.ph_lo = p; a.ph_hi = p + 1; hipLaunchKernelGGL(fwd_kernel, dim3(grid), dim3(512), LDS_BYTES, stream, a); }
#endif
}
```

```cpp
#include <hip/hip_runtime.h>
#include <cstdio>
#include <cstdint>

#ifndef ONE_LAUNCH
#define ONE_LAUNCH 1
#endif
#ifndef PHMASK
#define PHMASK 0xFFFFu
#endif
#define PHON(k) ((PHMASK >> (k)) & 1u)

#define GAS __attribute__((address_space(1)))
#define LAS __attribute__((address_space(3)))
typedef unsigned short bf16;
typedef short bf16x8 __attribute__((ext_vector_type(8)));
typedef float f32x4 __attribute__((ext_vector_type(4)));
typedef float f32x2 __attribute__((ext_vector_type(2)));
typedef unsigned u32x4 __attribute__((ext_vector_type(4)));
typedef unsigned u32x2 __attribute__((ext_vector_type(2)));

constexpr int D = 1024, NB = 8, SEQ = 4096, DEPTH = 4, CTXL = 256;
constexpr int NCTX = NB * CTXL;
constexpr int NLAT = NB * SEQ;
constexpr int NTOK = NCTX + NLAT;
constexpr int NTILE = NTOK / 256;
constexpr int IN_COLS = 6688, OFF_A = 3072, OFF_Z = 3104, OFF_F = 4128, OFF_G = 4640;
constexpr int PM_LD = 6400;
constexpr int PM_Z = 3072, PM_GA = 4096, PM_GB = 5120, PM_AB = 6144;
constexpr int WIN_ROWS = 6912;
constexpr int NEXP = 32, EDIM = 512, NSLOT = 77824, MAXTILES = 304;
constexpr float EPS = 1e-6f;

constexpr size_t MiB = 1u << 20;
constexpr size_t WS_CTL = 0, CTL_ZERO_BYTES = 1 * MiB;
constexpr size_t WS_MOD = 1 * MiB;
constexpr size_t WS_X = 2 * MiB;
constexpr size_t WS_WIN = WS_X + 136 * MiB;
constexpr size_t WS_WPA = WS_WIN + 54 * MiB;
constexpr size_t WS_WDL = WS_WPA + 8 * MiB;
constexpr size_t WS_WOUT = WS_WDL + 8 * MiB;
constexpr size_t WS_DFTL = WS_WOUT + 8 * MiB;
constexpr size_t WS_DFTC = WS_DFTL + 64 * MiB;
constexpr size_t WS_MOEW = WS_DFTC + 1 * MiB;
constexpr size_t WS_MOEWD = WS_MOEW + 64 * MiB;
constexpr size_t WS_KT = WS_MOEW;
constexpr size_t WS_H = WS_MOEW + 96 * MiB;
constexpr size_t WS_TB = WS_H;
constexpr size_t WS_PM = WS_H + 68 * MiB;
constexpr size_t WS_XS = WS_PM;
constexpr size_t WS_HID = WS_XS + 152 * MiB;
constexpr size_t WS_YS = WS_HID + 76 * MiB;
constexpr size_t WS_UTL = WS_PM + 425 * MiB;
constexpr size_t WS_UTC = WS_UTL + 32 * MiB;
constexpr size_t WS_PBUF = WS_UTC + 2 * MiB;
constexpr size_t WS_OF = WS_PBUF + 68 * MiB;
constexpr size_t WS_OB = WS_OF + 68 * MiB;
constexpr size_t WS_GB = WS_OB + 68 * MiB;
constexpr size_t WS_ROUTE = WS_GB + 5 * MiB;
constexpr size_t WS_END = WS_ROUTE + 1 * MiB;
static_assert(WS_YS + 152 * MiB <= WS_UTL, "MoE overlay fits inside PM");
static_assert(WS_END <= 1145ull * MiB, "d_ws budget");
constexpr int CW_BAR = 4096;
constexpr int CW_CNT = 16384;
constexpr int CW_CUR = 16384 + 1024;

constexpr int LDS_SCRATCH = 151552;
constexpr int LDSCTL_OFF = LDS_SCRATCH;
constexpr int LDS_BYTES = LDS_SCRATCH + 4096;

#define LDS_WAIT() asm volatile("s_waitcnt lgkmcnt(0)" ::: "memory")
#define VM_WAIT() asm volatile("s_waitcnt vmcnt(0)" ::: "memory")

__device__ __forceinline__ unsigned f2bf(float f) { unsigned u = __builtin_bit_cast(unsigned, f); return (u + 0x7fffu + ((u >> 16) & 1u)) >> 16; }
__device__ __forceinline__ unsigned pk2(float lo, float hi) { return f2bf(lo) | (f2bf(hi) << 16); }
__device__ __forceinline__ float bf_lo(unsigned w) { return __builtin_bit_cast(float, w << 16); }
__device__ __forceinline__ float bf_hi(unsigned w) { return __builtin_bit_cast(float, w & 0xffff0000u); }
__device__ __forceinline__ float bf2f(bf16 b) { return __builtin_bit_cast(float, (unsigned)b << 16); }
__device__ __forceinline__ float sigmoidf_(float x) { return 1.f / (1.f + __expf(-x)); }
__device__ __forceinline__ float siluf_(float x) { return x / (1.f + __expf(-x)); }
__device__ __forceinline__ float wave_sum(float v) {
#pragma unroll
    for (int o = 1; o < 64; o <<= 1) v += __shfl_xor(v, o);
    return v;
}

#define XB_TMO      128
#define XB_XCNT(j)  (256  + 64 * (j))
#define XB_XSUB(j)  (1280 + 64 * (j))
#define XB_XGEN(j)  (2304 + 64 * (j))
#define XB_TOP      3328
#define XB_TOPGEN   3392
#define XCD_BAR_WORDS 3456
#define XB_SPIN_CAP (1u << 18)
__device__ __forceinline__ unsigned xb_ld(unsigned* p)              { return __hip_atomic_load(p, __ATOMIC_RELAXED, __HIP_MEMORY_SCOPE_AGENT); }
__device__ __forceinline__ unsigned xb_add(unsigned* p, unsigned v) { return __hip_atomic_fetch_add(p, v, __ATOMIC_RELAXED, __HIP_MEMORY_SCOPE_AGENT); }
__device__ __forceinline__ unsigned xb_xcc_id() { return (unsigned)__builtin_amdgcn_s_getreg((3 << 11) | 20) & 0xFu; }
#define XB_SPIN(cond, bar) do { unsigned _sp = 0; while (cond) { __builtin_amdgcn_s_sleep(1); \
    if ((++_sp & 255u) == 0u) { if (xb_ld(&(bar)[XB_TMO])) break; if (_sp > XB_SPIN_CAP) { atomicAdd(&(bar)[XB_TMO], 1u); break; } } } } while (0)
struct XcdBarrier { unsigned* bar; unsigned x; volatile LAS unsigned* st; };
__device__ __forceinline__ XcdBarrier xcd_barrier_post(unsigned* bar, volatile LAS unsigned* st) {
    XcdBarrier b; b.bar = bar; b.x = xb_xcc_id(); b.st = st;
    if (threadIdx.x == 0) (void)xb_add(&bar[XB_XCNT(b.x)], 1u);
    return b;
}
__device__ __forceinline__ void xcd_barrier_complete(unsigned* bar, unsigned x, unsigned& nloc, unsigned& nx) {
    const unsigned G = gridDim.x * gridDim.y * gridDim.z;
    unsigned sum, cnt, mine, sp = 0u;
    for (;;) {
        sum = 0u; cnt = 0u; mine = 0u;
#pragma unroll
        for (unsigned j = 0; j < 16; ++j) { const unsigned c = xb_ld(&bar[XB_XCNT(j)]); sum += c; cnt += (c > 0u) ? 1u : 0u; mine = (j == x) ? c : mine; }
        if (sum == G) break;
        __builtin_amdgcn_s_sleep(1);
        if ((++sp & 255u) == 0u) { if (xb_ld(&bar[XB_TMO])) break; if (sp > XB_SPIN_CAP) { atomicAdd(&bar[XB_TMO], 1u); break; } }
    }
    nloc = mine > 0u ? mine : 1u; nx = cnt > 0u ? cnt : 1u;
}
__device__ __forceinline__ void xcd_barrier(const XcdBarrier& b) {
    asm volatile("s_waitcnt vmcnt(0)" ::: "memory");
    __syncthreads();
    if (threadIdx.x == 0) {
        unsigned* bar = b.bar;
        __builtin_amdgcn_s_waitcnt(0);
        unsigned nloc = b.st[0], nx = b.st[1];
        if (nloc == 0u) { xcd_barrier_complete(bar, b.x, nloc, nx); b.st[0] = nloc; b.st[1] = nx; }
        const unsigned old = xb_add(&bar[XB_XSUB(b.x)], 1u);
        const unsigned gen = old / nloc;
        if (old + 1u == (gen + 1u) * nloc) {
            __builtin_amdgcn_fence(__ATOMIC_RELEASE, "agent");
            asm volatile("s_waitcnt vmcnt(0)" ::: "memory");
            const unsigned og = xb_add(&bar[XB_TOP], 1u);
            const unsigned tg = og / nx;
            if (og + 1u == (tg + 1u) * nx) xb_add(&bar[XB_TOPGEN], 1u);
            else XB_SPIN(xb_ld(&bar[XB_TOPGEN]) == tg, bar);
            __builtin_amdgcn_fence(__ATOMIC_ACQUIRE, "agent");
            xb_add(&bar[XB_XGEN(b.x)], 1u);
            asm volatile("s_waitcnt vmcnt(0)" ::: "memory");
        } else {
            XB_SPIN(xb_ld(&bar[XB_XGEN(b.x)]) == gen, bar);
            __builtin_amdgcn_fence(__ATOMIC_ACQUIRE, "agent");
            asm volatile("s_waitcnt vmcnt(0)" ::: "memory");
        }
    }
    __syncthreads();
}

namespace pg8 {
constexpr int BM = 256, BK = 64, HALF = 128, HTB = HALF * BK * 2, STAGE_BYTES = 8 * HTB, NXCD = 8, WGM = 8;
__device__ __forceinline__ int lds_byte(int r, int c) { const int st = (r >> 4) * 2 + (c >> 5), rr = r & 15, cc = c & 31, ob = rr * 64 + cc * 2; return st * 1024 + (ob ^ (((ob >> 9) & 1) << 5)); }
__device__ __forceinline__ void stage_rc(int b, int& R, int& C) { const int st = b / 1024, sb = b % 1024, swz = sb ^ (((sb >> 9) & 1) << 5); R = (st >> 1) * 16 + swz / 64; C = (st & 1) * 32 + (swz % 64) / 2; }
__device__ __forceinline__ int perm32(int rho) { const int n = rho >> 4, i = rho & 15; return 8 * (i >> 2) + 4 * n + (i & 3); }
__device__ __forceinline__ unsigned cvt_pk_bf16(float lo, float hi) { unsigned r; asm volatile("v_cvt_pk_bf16_f32 %0, %1, %2" : "=v"(r) : "v"(lo), "v"(hi)); return r; }

struct Unit { int pm, pn, aux; };

__device__ __forceinline__ void tile_map(int L, int nM, int nN, int& pm, int& pn) {
    const int nwg = nM * nN; int wgid = L;
    { const int q = nwg / NXCD, r = nwg % NXCD, xcd = wgid % NXCD, off = wgid / NXCD; wgid = (xcd < r ? xcd * (q + 1) : r * (q + 1) + (xcd - r) * q) + off; }
    const int nig = WGM * nN, gid = wgid / nig, fm = gid * WGM, gsz = (nM - fm) < WGM ? (nM - fm) : WGM;
    pm = fm + ((wgid % nig) % gsz); pn = (wgid % nig) / gsz;
}

template <class Epi, class Sched>
__device__ __forceinline__ void gemm_phase(LAS unsigned char* lds_v, const int lda, const int ldb, const int K, const Sched& S, const Epi& E) {
    LAS unsigned char* lds = (LAS unsigned char*)(size_t)(unsigned)__builtin_amdgcn_readfirstlane((int)(size_t)lds_v);
    int tid_ = threadIdx.x; asm volatile("" : "+v"(tid_));
    const int tid = tid_, wid = __builtin_amdgcn_readfirstlane(tid >> 6), lane = tid & 63, wr = wid >> 2, wc = wid & 3, fr = lane & 15, fq = lane >> 4;
    const int nt = K / BK;
    unsigned voffA[2], voffB[2];
#pragma unroll
    for (int i = 0; i < 2; ++i) { int R, C; stage_rc(tid * 16 + i * 8192, R, C); const int Rb = Epi::PERM ? ((R & ~31) + perm32(R & 31)) : R;
        voffA[i] = (unsigned)(R * lda + C) * 2u; voffB[i] = (unsigned)(Rb * ldb + C) * 2u; }
    const size_t kstep = (size_t)(BK * 2);
    const unsigned hstepA = (unsigned)(HALF * lda * 2), hstepB = (unsigned)(HALF * ldb * 2);
    const unsigned ldsw = (unsigned)wid * 1024u;
    const int aoff = lds_byte(wr * 64 + fr, fq * 8), boff = lds_byte(wc * 32 + fr, fq * 8);
#define PG8_SA(b, h) (((b) * 2 + (h)) * HTB)
#define PG8_SB(b, h) ((4 + (b) * 2 + (h)) * HTB)
#define PG8_STAGE(bufoff, gbase, voff) do { _Pragma("unroll") for (int _i = 0; _i < 2; ++_i) \
        __builtin_amdgcn_global_load_lds((const unsigned*)((const char*)(gbase) + (voff)[_i]), (LAS unsigned*)(lds + (bufoff) + ldsw + _i * 8192), 16, 0, 0); } while (0)
#define PG8_LDA(dst, b, h) do { _Pragma("unroll") for (int m = 0; m < 4; ++m) _Pragma("unroll") for (int k = 0; k < 2; ++k) dst[m][k] = *(const LAS bf16x8*)(lds + PG8_SA(b, h) + aoff + m * 2048 + k * 1024); } while (0)
#define PG8_LDB(dst, b, h) do { _Pragma("unroll") for (int n = 0; n < 2; ++n) _Pragma("unroll") for (int k = 0; k < 2; ++k) dst[n][k] = *(const LAS bf16x8*)(lds + PG8_SB(b, h) + boff + n * 2048 + k * 1024); } while (0)
#define PG8_MMA(ai, bj, At, Bt) do { __builtin_amdgcn_s_setprio(1); _Pragma("unroll") for (int m = 0; m < 4; ++m) _Pragma("unroll") for (int n = 0; n < 2; ++n) _Pragma("unroll") for (int k = 0; k < 2; ++k) \
        acc[ai][bj][m][n] = __builtin_amdgcn_mfma_f32_16x16x32_bf16(Bt[n][k], At[m][k], acc[ai][bj][m][n], 0, 0, 0); __builtin_amdgcn_s_setprio(0); } while (0)
#define PG8_WAIT_V(n) asm volatile("s_waitcnt vmcnt(" #n ")" ::: "memory")
#define PG8_WAIT_L(n) asm volatile("s_waitcnt lgkmcnt(" #n ")" ::: "memory")
#define PG8_BAR __builtin_amdgcn_s_barrier()
#define PG8_SCHED __builtin_amdgcn_sched_barrier(0)
    Unit cur, nxt; int ui = 0;
    if (!S.next(0, cur)) return;
    f32x4 acc[2][2][4][2];
#pragma unroll
    for (int a = 0; a < 2; ++a)
#pragma unroll
        for (int b = 0; b < 2; ++b)
#pragma unroll
            for (int m = 0; m < 4; ++m)
#pragma unroll
                for (int n = 0; n < 2; ++n) acc[a][b][m][n] = (f32x4){0.f, 0.f, 0.f, 0.f};
    bf16x8 At[4][2], B0[2][2], B1[2][2];
    const char* cA = S.a_ptr(cur); const char* cB = S.b_ptr(cur);
    PG8_STAGE(PG8_SB(0, 0), cB, voffB); PG8_STAGE(PG8_SA(0, 0), cA, voffA); PG8_STAGE(PG8_SB(0, 1), cB + hstepB, voffB); PG8_STAGE(PG8_SA(0, 1), cA + hstepA, voffA);
    if (wr == 1) PG8_BAR;
    PG8_WAIT_V(4); PG8_BAR;
    PG8_STAGE(PG8_SB(1, 0), cB + kstep, voffB); PG8_STAGE(PG8_SA(1, 0), cA + kstep, voffA); PG8_STAGE(PG8_SB(1, 1), cB + hstepB + kstep, voffB);
    PG8_WAIT_V(6); PG8_BAR;
    for (;;) {
        const bool has_next = S.next(ui + 1, nxt);
        const char* nA = has_next ? S.a_ptr(nxt) : cA; const char* nB = has_next ? S.b_ptr(nxt) : cB;
#pragma nounroll
        for (int t = 0; t < nt; t += 2) {
            const bool last = (t == nt - 2);
            const char* a1 = cA + (size_t)(t + 1) * kstep;
            const char* a2 = last ? nA : cA + (size_t)(t + 2) * kstep; const char* b2 = last ? nB : cB + (size_t)(t + 2) * kstep;
            const char* a3 = a2 + kstep; const char* b3 = b2 + kstep;
            PG8_LDB(B0, 0, 0); PG8_SCHED; PG8_LDA(At, 0, 0); PG8_STAGE(PG8_SA(1, 1), a1 + hstepA, voffA);
            PG8_WAIT_L(8); PG8_BAR; PG8_WAIT_L(0); PG8_MMA(0, 0, At, B0); PG8_BAR; PG8_SCHED;
            PG8_LDB(B1, 0, 1); PG8_STAGE(PG8_SB(0, 0), b2, voffB);
            PG8_BAR; PG8_WAIT_L(0); PG8_MMA(0, 1, At, B1); PG8_BAR;
            PG8_LDA(At, 0, 1); PG8_STAGE(PG8_SA(0, 0), a2, voffA);
            PG8_BAR; PG8_WAIT_L(0); PG8_MMA(1, 0, At, B0); PG8_BAR; PG8_SCHED;
            PG8_STAGE(PG8_SB(0, 1), b2 + hstepB, voffB);
            PG8_WAIT_V(6); PG8_BAR; PG8_MMA(1, 1, At, B1); PG8_BAR;
            PG8_LDB(B0, 1, 0); PG8_SCHED; PG8_LDA(At, 1, 0); PG8_STAGE(PG8_SA(0, 1), a2 + hstepA, voffA);
            PG8_WAIT_L(8); PG8_BAR; PG8_WAIT_L(0); PG8_MMA(0, 0, At, B0); PG8_BAR; PG8_SCHED;
            PG8_LDB(B1, 1, 1); PG8_STAGE(PG8_SB(1, 0), b3, voffB);
            PG8_BAR; PG8_WAIT_L(0); PG8_MMA(0, 1, At, B1); PG8_BAR;
            PG8_LDA(At, 1, 1); PG8_STAGE(PG8_SA(1, 0), a3, voffA);
            PG8_BAR; PG8_WAIT_L(0); PG8_MMA(1, 0, At, B0); PG8_BAR; PG8_SCHED;
            PG8_STAGE(PG8_SB(1, 1), b3 + hstepB, voffB);
            PG8_WAIT_V(6); PG8_BAR; PG8_MMA(1, 1, At, B1); PG8_BAR;
        }
        E(acc, cur, wr, wc, fr, fq);
        if (!has_next) break;
#pragma unroll
        for (int a = 0; a < 2; ++a)
#pragma unroll
            for (int b = 0; b < 2; ++b)
#pragma unroll
                for (int m = 0; m < 4; ++m)
#pragma unroll
                    for (int n = 0; n < 2; ++n) acc[a][b][m][n] = (f32x4){0.f, 0.f, 0.f, 0.f};
        cur = nxt; cA = nA; cB = nB; ++ui;
    }
    PG8_WAIT_V(0);
    if (wr == 0) PG8_BAR;
    PG8_BAR;
#undef PG8_SA
#undef PG8_SB
#undef PG8_STAGE
#undef PG8_LDA
#undef PG8_LDB
#undef PG8_MMA
#undef PG8_WAIT_V
#undef PG8_WAIT_L
#undef PG8_BAR
#undef PG8_SCHED
}
}
using pg8::Unit;
using pg8::cvt_pk_bf16;

struct Args { const float* in[24]; float* out; unsigned char* ws; int ph_lo, ph_hi; };
enum { I_X = 0, I_C, I_CTX, I_CCTX, I_WMOD, I_BMOD, I_NMIX, I_NFFN, I_WIN, I_CONVW, I_ALOG, I_DTB, I_ONORM, I_WF, I_WDL, I_WOUT, I_WRG, I_BRG, I_WRE, I_BRE, I_WG, I_WU, I_WD, I_FNORM };

struct Frame {
    LAS unsigned char* lds;
    volatile LAS unsigned* LCTL;
    unsigned char* ws;
    int tid, lane, wave, G, bid;
};
#define WSP(T, off) ((T*)(F.ws + (off)))
__device__ __forceinline__ const float* inp(const Frame& F, int i) {
    const unsigned lo = __builtin_amdgcn_readfirstlane(F.LCTL[512 + 2 * i]), hi = __builtin_amdgcn_readfirstlane(F.LCTL[513 + 2 * i]);
    return (const float*)(((unsigned long long)hi << 32) | lo);
}
#define LAUNDER(F) do { F.tid = threadIdx.x; F.ws = args.ws; F.bid = blockIdx.x; F.G = gridDim.x; F.lds = (LAS unsigned char*)lds; asm volatile("" : "+v"(F.tid), "+s"(F.ws), "+s"(F.bid), "+s"(F.G), "+v"(F.lds)); F.LCTL = (volatile LAS unsigned*)(F.lds + LDSCTL_OFF); F.lane = F.tid & 63; F.wave = __builtin_amdgcn_readfirstlane(F.tid >> 6); } while (0)

__device__ __forceinline__ void transpose_item(const float* W, int ldw, int col0, int K, int N, bf16* WT, int row_off, int row_mul, int row_add, LAS float* scr, int item, int lane) {
    const int nblk = N / 32, kb = item / nblk, nb = item % nblk, k0 = 64 * kb, n0 = 32 * nb;
#pragma unroll 8
    for (int i = 0; i < 32; ++i) { const int kk = 2 * i + (lane >> 5); scr[kk * 33 + (lane & 31)] = W[(size_t)(k0 + kk) * ldw + col0 + n0 + (lane & 31)]; }
    LDS_WAIT(); asm volatile("" ::: "memory");
    const int c = lane & 7;
#pragma unroll
    for (int j = 0; j < 4; ++j) { const int n = (lane >> 3) + 8 * j; const LAS float* s = scr + (8 * c) * 33 + n;
        u32x4 o; o.x = pk2(s[0 * 33], s[1 * 33]); o.y = pk2(s[2 * 33], s[3 * 33]); o.z = pk2(s[4 * 33], s[5 * 33]); o.w = pk2(s[6 * 33], s[7 * 33]);
        *(u32x4*)(WT + (size_t)(row_off + (n0 + n) * row_mul + row_add) * K + k0 + 8 * c) = o; }
    LDS_WAIT(); asm volatile("" ::: "memory");
}

__device__ __forceinline__ void phase_prologue(Frame& F, const Args& a) {
    const int gw = F.bid * 8 + F.wave, NGW = F.G * 8;
    const int gt = F.bid * 512 + F.tid, NGT = F.G * 512;
    LAS float* scr = (LAS float*)(F.lds + F.wave * 8448);
    {
        constexpr int I_QKV = 16 * 96, I_Z = 16 * 32, I_G = 16 * 64, I_AB = 16, I_F = 16 * 16, I_SQ = 16 * 32;
        constexpr int PER_LAYER = I_QKV + I_Z + I_G + I_AB + I_F + 2 * I_SQ;
        for (int it = gw; it < DEPTH * PER_LAYER; it += NGW) {
            const int layer = it / PER_LAYER; int r = it % PER_LAYER;
            const float* win = inp(F, I_WIN) + (size_t)layer * D * IN_COLS;
            bf16* wt = WSP(bf16, WS_WIN) + (size_t)layer * WIN_ROWS * D;
            if (r < I_QKV) { transpose_item(win, IN_COLS, 0, D, 3072, wt, 0, 1, 0, scr, r, F.lane); continue; } r -= I_QKV;
            if (r < I_Z)   { transpose_item(win, IN_COLS, OFF_Z, D, 1024, wt, PM_Z, 1, 0, scr, r, F.lane); continue; } r -= I_Z;
            if (r < I_G)   { transpose_item(win, IN_COLS, OFF_G, D, 2048, wt, PM_GA, 1, 0, scr, r, F.lane); continue; } r -= I_G;
            if (r < I_AB)  { transpose_item(win, IN_COLS, OFF_A, D, 32, wt, PM_AB, 1, 0, scr, r, F.lane); continue; } r -= I_AB;
            if (r < I_F)   { transpose_item(win, IN_COLS, OFF_F, D, 512, wt, PM_LD, 1, 0, scr, r, F.lane); continue; } r -= I_F;
            if (r < I_SQ)  { transpose_item(inp(F, I_WDL) + (size_t)layer * D * D, D, 0, D, D, WSP(bf16, WS_WDL) + (size_t)layer * D * D, 0, 1, 0, scr, r, F.lane); continue; } r -= I_SQ;
            transpose_item(inp(F, I_WOUT) + (size_t)layer * D * D, D, 0, D, D, WSP(bf16, WS_WOUT) + (size_t)layer * D * D, 0, 1, 0, scr, r, F.lane);
        }
        for (int i = gt; i < DEPTH * 224 * (D / 8); i += NGT) { const int layer = i / (224 * 128), rr = i % (224 * 128);
            *(u32x4*)(WSP(bf16, WS_WIN) + ((size_t)layer * WIN_ROWS + 6176) * D + (size_t)rr * 8) = (u32x4){0u, 0u, 0u, 0u}; }
    }
    {
        LAS float* tb = (LAS float*)(F.lds + 8 * 8448);
        if (F.tid < 128) { tb[F.tid] = cospif((float)F.tid / 64.f); tb[128 + F.tid] = -sinpif((float)F.tid / 64.f); }
        __syncthreads();
        for (int it = gw; it < DEPTH * 4 * 2 * 16 * 4; it += NGW) {
            const int cb = it & 3, nb = (it >> 2) & 15, ri = (it >> 6) & 1, g = (it >> 7) & 3, layer = it >> 9;
            const int n = nb * 64 + F.lane;
            const float* wf = inp(F, I_WF) + ((size_t)layer * 512 + g * 128) * D + n;
            float o[32];
#pragma unroll
            for (int q = 0; q < 32; ++q) o[q] = 0.f;
#pragma unroll 4
            for (int cp = 0; cp < 128; ++cp) { const float w = wf[(size_t)cp * D];
#pragma unroll
                for (int q = 0; q < 32; ++q) o[q] += tb[ri * 128 + (((cb * 32 + q) * cp) & 127)] * w; }
            bf16* dst = WSP(bf16, WS_WPA) + ((size_t)layer * D + n) * D + g * 256 + ri * 128 + cb * 32;
#pragma unroll
            for (int q8 = 0; q8 < 4; ++q8) { const float sc_ = 0.08838834764831845f;
                *(u32x4*)(dst + q8 * 8) = (u32x4){pk2(o[q8 * 8] * sc_, o[q8 * 8 + 1] * sc_), pk2(o[q8 * 8 + 2] * sc_, o[q8 * 8 + 3] * sc_), pk2(o[q8 * 8 + 4] * sc_, o[q8 * 8 + 5] * sc_), pk2(o[q8 * 8 + 6] * sc_, o[q8 * 8 + 7] * sc_)}; }
        }
        __syncthreads();
    }
    for (int i = gt; i < 8192 * 512; i += NGT) { const int row = i >> 9, t0 = (i & 511) * 8, ri = row >> 12, tp = row & 4095; float v[8];
#pragma unroll
        for (int q = 0; q < 8; ++q) { const int m = ((t0 + q) * tp) & 4095; const float x = (float)m / 2048.f; v[q] = (ri ? sinpif(x) : cospif(x)) * (1.f / 64.f); }
        *(u32x4*)(WSP(bf16, WS_DFTL) + (size_t)row * 4096 + t0) = (u32x4){pk2(v[0], v[1]), pk2(v[2], v[3]), pk2(v[4], v[5]), pk2(v[6], v[7])}; }
    for (int i = gt; i < 512 * 32; i += NGT) { const int row = i >> 5, t0 = (i & 31) * 8, ri = row >> 8, tp = row & 255; float v[8];
#pragma unroll
        for (int q = 0; q < 8; ++q) { const int m = ((t0 + q) * tp) & 255; const float x = (float)m / 128.f; v[q] = (ri ? sinpif(x) : cospif(x)) * (1.f / 16.f); }
        *(u32x4*)(WSP(bf16, WS_DFTC) + (size_t)row * 256 + t0) = (u32x4){pk2(v[0], v[1]), pk2(v[2], v[3]), pk2(v[4], v[5]), pk2(v[6], v[7])}; }
    { const f32x4* pc_ = (const f32x4*)inp(F, I_CTX); const f32x4* px_ = (const f32x4*)inp(F, I_X);
    for (size_t i = gt; i < (size_t)NTOK * D / 4; i += NGT) {
        const f32x4 v = (i < (size_t)NCTX * D / 4) ? pc_[i] : px_[i - (size_t)NCTX * D / 4];
        WSP(f32x4, WS_X)[i] = v; } }
    {
        LAS float* sc = (LAS float*)(F.lds + 8 * 8448 + 1024);
        { const float* pc_ = inp(F, I_C); const float* pcc_ = inp(F, I_CCTX);
        for (int i = F.tid; i < 9 * 1024; i += 512) { const float v = (i < 8192) ? pc_[i] : pcc_[i - 8192]; sc[i] = siluf_(v); } }
        __syncthreads();
        for (int it = gw; it < DEPTH * 192; it += NGW) {
            const int layer = it / 192, cb = it % 192, col = cb * 32 + (F.lane & 31), kp = F.lane >> 5;
            const float* wm = inp(F, I_WMOD) + (size_t)layer * D * 6144 + col;
            float acc[9];
#pragma unroll
            for (int r = 0; r < 9; ++r) acc[r] = 0.f;
#pragma unroll 4
            for (int k = kp; k < 1024; k += 2) { const float w = wm[(size_t)k * 6144];
#pragma unroll
                for (int r = 0; r < 9; ++r) acc[r] += sc[r * 1024 + k] * w; }
#pragma unroll
            for (int r = 0; r < 9; ++r) acc[r] += __shfl_xor(acc[r], 32);
            if (kp == 0) { const float bm = inp(F, I_BMOD)[layer * 6144 + col];
#pragma unroll
                for (int r = 0; r < 9; ++r) WSP(float, WS_MOD)[((size_t)layer * 9 + r) * 6144 + col] = acc[r] + bm; }
        }
        __syncthreads();
    }
}

__device__ __forceinline__ void moe_weight_convert(Frame& F, const Args& a, int layer, int w0, LAS float* scr) {
    const int nw = 8 - w0, gw = F.bid * nw + (F.wave - w0), NGW = F.G * nw;
    constexpr int PER_E = 768;
    for (int it = gw; it < NEXP * PER_E; it += NGW) {
        const int e = it / PER_E; int r = it % PER_E;
        const size_t eo = ((size_t)layer * NEXP + e) * (size_t)D * EDIM;
        bf16* wgu = WSP(bf16, WS_MOEW) + (size_t)e * 1024 * 1024;
        if (r < 256) { transpose_item(inp(F, I_WG) + eo, EDIM, 0, D, EDIM, wgu, 0, 2, 0, scr, r, F.lane); continue; } r -= 256;
        if (r < 256) { transpose_item(inp(F, I_WU) + eo, EDIM, 0, D, EDIM, wgu, 0, 2, 1, scr, r, F.lane); continue; } r -= 256;
        transpose_item(inp(F, I_WD) + eo, D, 0, EDIM, D, WSP(bf16, WS_MOEWD) + (size_t)e * 1024 * 512, 0, 1, 0, scr, r, F.lane);
    }
}

__device__ __forceinline__ int mod_row(int row) { return row < NCTX ? 8 : ((row - NCTX) >> 12); }

template <int MODE, bool COMBINE>
__device__ __forceinline__ void phase_norm(Frame& F, const Args& a, int layer) {
    const int gw = F.bid * 8 + F.wave, NGW = F.G * 8;
    const f32x4* fwp = (const f32x4*)inp(F, MODE == 1 ? I_FNORM : I_NMIX) + (MODE == 1 ? 0 : layer * 256) + F.lane; f32x4* outp = (f32x4*)inp(F, 24);
    for (int row = gw; row < NTOK; row += NGW) {
        const int mb = mod_row(row);
        f32x4* xr = WSP(f32x4, WS_X) + (size_t)row * 256 + F.lane;
        f32x4 v[4];
#pragma unroll
        for (int j = 0; j < 4; ++j) v[j] = xr[64 * j];
        if (COMBINE) {
            const int* so = WSP(int, WS_ROUTE + 2 * NTOK * 8) + row * 2; const float* cb = WSP(float, WS_ROUTE + NTOK * 8) + row * 2;
            const int s0 = so[0], s1 = so[1]; const float c0 = cb[0], c1 = cb[1];
            const f32x4* g2 = WSP(f32x4, WS_MOD) + ((size_t)(layer - 1) * 9 + mb) * 1536 + 5 * 256 + F.lane;
            const u32x2* y0 = WSP(u32x2, WS_YS) + (size_t)s0 * 256 + F.lane; const u32x2* y1 = WSP(u32x2, WS_YS) + (size_t)s1 * 256 + F.lane;
#pragma unroll
            for (int j = 0; j < 4; ++j) { const u32x2 p = y0[64 * j], q = y1[64 * j]; const f32x4 g = g2[64 * j];
                v[j].x += g.x * (c0 * bf_lo(p.x) + c1 * bf_lo(q.x)); v[j].y += g.y * (c0 * bf_hi(p.x) + c1 * bf_hi(q.x));
                v[j].z += g.z * (c0 * bf_lo(p.y) + c1 * bf_lo(q.y)); v[j].w += g.w * (c0 * bf_hi(p.y) + c1 * bf_hi(q.y));
                if (MODE == 0) xr[64 * j] = v[j]; }
        }
        float ss = 0.f;
#pragma unroll
        for (int j = 0; j < 4; ++j) ss += (v[j].x * v[j].x + v[j].y * v[j].y) + (v[j].z * v[j].z + v[j].w * v[j].w);
        const float r = rsqrtf(wave_sum(ss) * (1.f / 1024.f) + EPS);
        if (MODE == 1) {
            if (row >= NCTX) { const f32x4* fw = fwp; f32x4* o = outp + (size_t)(row - NCTX) * 256 + F.lane;
#pragma unroll
                for (int j = 0; j < 4; ++j) o[64 * j] = v[j] * r * fw[64 * j]; }
        } else {
            const f32x4* nw = fwp;
            const f32x4* sh = WSP(f32x4, WS_MOD) + ((size_t)layer * 9 + mb) * 1536 + 0 * 256 + F.lane;
            const f32x4* sc = WSP(f32x4, WS_MOD) + ((size_t)layer * 9 + mb) * 1536 + 1 * 256 + F.lane;
            u32x2* ho = WSP(u32x2, WS_H) + (size_t)row * 256 + F.lane;
#pragma unroll
            for (int j = 0; j < 4; ++j) { const f32x4 h = v[j] * r * nw[64 * j] * (sc[64 * j] + 1.f) + sh[64 * j];
                ho[64 * j] = (u32x2){pk2(h.x, h.y), pk2(h.z, h.w)}; }
        }
    }
}

__device__ __forceinline__ void ffn_row(Frame& F, const f32x4* nw, int layer, int row, f32x4 (&h)[4]) {
    const int mb = mod_row(row);
    const f32x4* xr = WSP(f32x4, WS_X) + (size_t)row * 256 + F.lane;
    f32x4 v[4]; float ss = 0.f;
#pragma unroll
    for (int j = 0; j < 4; ++j) { v[j] = xr[64 * j]; ss += (v[j].x * v[j].x + v[j].y * v[j].y) + (v[j].z * v[j].z + v[j].w * v[j].w); }
    const float r = rsqrtf(wave_sum(ss) * (1.f / 1024.f) + EPS);
    const f32x4* sh = WSP(f32x4, WS_MOD) + ((size_t)layer * 9 + mb) * 1536 + 3 * 256 + F.lane;
    const f32x4* sc = WSP(f32x4, WS_MOD) + ((size_t)layer * 9 + mb) * 1536 + 4 * 256 + F.lane;
#pragma unroll
    for (int j = 0; j < 4; ++j) h[j] = v[j] * r * nw[64 * j] * (sc[64 * j] + 1.f) + sh[64 * j];
}

__device__ __forceinline__ void phase_route(Frame& F, const Args& a, int layer) {
    const int gw = F.bid * 8 + F.wave, NGW = F.G * 8;
    LAS float* wl = (LAS float*)F.lds;
    volatile LAS unsigned* cl = F.LCTL + 64;
    const float* wrg = inp(F, I_WRG) + (size_t)layer * D * 4; const float* wre = inp(F, I_WRE) + (size_t)layer * D * 32;
    for (int i = F.tid; i < 1024 * 4; i += 512) { const int k = i >> 2, j = i & 3; wl[((k >> 2) * 37 + j) * 4 + (k & 3)] = wrg[i]; }
    for (int i = F.tid; i < 1024 * 32; i += 512) { const int k = i >> 5, j = i & 31; wl[((k >> 2) * 37 + 4 + j) * 4 + (k & 3)] = wre[i]; }
    if (F.tid < 32) cl[F.tid] = 0u;
    __syncthreads();
    const float* brg = inp(F, I_BRG) + layer * 4; const float* bre = inp(F, I_BRE) + layer * 32;
    const f32x4* nwp = (const f32x4*)(inp(F, I_NFFN) + layer * D) + F.lane;
    for (int row = gw; row < NTOK; row += NGW) {
        f32x4 h[4]; ffn_row(F, nwp, layer, row, h);
        float lg[4];
#pragma unroll
        for (int g = 0; g < 4; ++g) { float s = 0.f;
#pragma unroll
            for (int j = 0; j < 4; ++j) { const f32x4 w = *(const LAS f32x4*)(wl + ((F.lane + 64 * j) * 37 + g) * 4); s += (h[j].x * w.x + h[j].y * w.y) + (h[j].z * w.z + h[j].w * w.w); }
            lg[g] = wave_sum(s) + brg[g]; }
        int grp = 0; float mx = lg[0];
#pragma unroll
        for (int g = 1; g < 4; ++g) if (lg[g] > mx) { mx = lg[g]; grp = g; }
        float den = 0.f;
#pragma unroll
        for (int g = 0; g < 4; ++g) den += __expf(lg[g] - mx);
        const float pgrp = 1.f / den;
        float le[8];
#pragma unroll
        for (int e = 0; e < 8; ++e) { float s = 0.f;
#pragma unroll
            for (int j = 0; j < 4; ++j) { const f32x4 w = *(const LAS f32x4*)(wl + ((F.lane + 64 * j) * 37 + 4 + grp * 8 + e) * 4); s += (h[j].x * w.x + h[j].y * w.y) + (h[j].z * w.z + h[j].w * w.w); }
            le[e] = wave_sum(s) + bre[grp * 8 + e]; }
        int i0 = 0; float v0 = le[0];
#pragma unroll
        for (int e = 1; e < 8; ++e) if (le[e] > v0) { v0 = le[e]; i0 = e; }
        int i1 = -1; float v1 = -3.0e38f;
#pragma unroll
        for (int e = 0; e < 8; ++e) if (e != i0 && le[e] > v1) { v1 = le[e]; i1 = e; }
        const float e1 = __expf(v1 - v0), inv = 1.f / (1.f + e1);
        if (F.lane == 0) {
            int* eid = WSP(int, WS_ROUTE) + row * 2; float* cb = WSP(float, WS_ROUTE + NTOK * 8) + row * 2;
            eid[0] = grp * 8 + i0; eid[1] = grp * 8 + i1; cb[0] = pgrp * inv; cb[1] = pgrp * e1 * inv;
            __hip_atomic_fetch_add((LAS unsigned*)(cl + grp * 8 + i0), 1u, __ATOMIC_RELAXED, __HIP_MEMORY_SCOPE_WORKGROUP); __hip_atomic_fetch_add((LAS unsigned*)(cl + grp * 8 + i1), 1u, __ATOMIC_RELAXED, __HIP_MEMORY_SCOPE_WORKGROUP);
        }
    }
    __syncthreads();
    if (F.tid < 32) { const unsigned c = cl[F.tid]; if (c) atomicAdd(WSP(unsigned, WS_CTL) + CW_CNT + layer * 64 + F.tid, c); }
}

__device__ __forceinline__ void build_moe_tables(Frame& F, int layer) {
    if (F.tid == 0) {
        const unsigned* cnt = WSP(unsigned, WS_CTL) + CW_CNT + layer * 64;
        unsigned ps = 0; int tile = 0;
        for (int e = 0; e < NEXP; ++e) { const unsigned c = __hip_atomic_load(cnt + e, __ATOMIC_RELAXED, __HIP_MEMORY_SCOPE_AGENT); const unsigned nt = (c + 255u) >> 8;
            F.LCTL[16 + e] = ps; for (unsigned t = 0; t < nt; ++t) F.LCTL[128 + tile++] = (unsigned)e; ps += nt << 8; }
        F.LCTL[16 + NEXP] = ps;
    }
    __syncthreads();
}

__device__ __forceinline__ void phase_assign(Frame& F, const Args& a, int layer) {
    const int gw = F.bid * 8 + F.wave, NGW = F.G * 8;
    build_moe_tables(F, layer);
    const f32x4* nwp = (const f32x4*)(inp(F, I_NFFN) + layer * D) + F.lane;
    int slot = 0;
    { const int it = F.lane >> 1, row = gw + it * NGW;
      if (F.lane < 36 && row < NTOK) { const int e = WSP(int, WS_ROUTE)[row * 2 + (F.lane & 1)];
          slot = (int)F.LCTL[16 + e] + (int)atomicAdd(WSP(unsigned, WS_CTL) + CW_CUR + layer * 64 + e, 1u);
          WSP(int, WS_ROUTE + 2 * NTOK * 8)[row * 2 + (F.lane & 1)] = slot; } }
    int it = 0;
    for (int row = gw; row < NTOK; row += NGW, ++it) {
        const int s0 = __shfl(slot, 2 * it), s1 = __shfl(slot, 2 * it + 1);
        f32x4 h[4]; ffn_row(F, nwp, layer, row, h);
        u32x2* x0 = WSP(u32x2, WS_XS) + (size_t)s0 * 256 + F.lane; u32x2* x1 = WSP(u32x2, WS_XS) + (size_t)s1 * 256 + F.lane;
#pragma unroll
        for (int j = 0; j < 4; ++j) { const u32x2 p = (u32x2){pk2(h[j].x, h[j].y), pk2(h[j].z, h[j].w)}; x0[64 * j] = p; x1[64 * j] = p; }
    }
}

template <int NBLK>
__device__ __forceinline__ void conv_unit(Frame& F, const float* cw, int tok0, int slab) {
    const int r0 = F.tid >> 3, c0l = (F.tid & 7) * 16, c0 = slab * 128 + c0l;
    const int sect = slab >> 3, head = slab & 7;
    float w0[16], w1[16], w2[16];
#pragma unroll
    for (int q = 0; q < 16; ++q) { w0[q] = cw[c0 + q]; w1[q] = cw[3072 + c0 + q]; w2[q] = cw[6144 + c0 + q]; }
    float y[NBLK][16];
    constexpr int T = NBLK * 64;
#pragma unroll
    for (int j = 0; j < NBLK; ++j) {
        const int t = r0 + 64 * j;
        const bf16* p = WSP(bf16, WS_PM) + (size_t)(tok0 + t) * PM_LD + c0;
        u32x4 cu[2], pu[2], nu[2];
        cu[0] = *(const u32x4*)p; cu[1] = *(const u32x4*)(p + 8);
        if (t > 0) { pu[0] = *(const u32x4*)(p - PM_LD); pu[1] = *(const u32x4*)(p - PM_LD + 8); } else { pu[0] = pu[1] = (u32x4){0u, 0u, 0u, 0u}; }
        if (t < T - 1) { nu[0] = *(const u32x4*)(p + PM_LD); nu[1] = *(const u32x4*)(p + PM_LD + 8); } else { nu[0] = nu[1] = (u32x4){0u, 0u, 0u, 0u}; }
        float ss = 0.f;
#pragma unroll
        for (int q = 0; q < 16; ++q) { const unsigned cw_ = cu[q >> 3][(q >> 1) & 3], pw_ = pu[q >> 3][(q >> 1) & 3], nw_ = nu[q >> 3][(q >> 1) & 3];
            const float xc = (q & 1) ? bf_hi(cw_) : bf_lo(cw_), xp = (q & 1) ? bf_hi(pw_) : bf_lo(pw_), xn = (q & 1) ? bf_hi(nw_) : bf_lo(nw_);
            const float s = siluf_(w0[q] * xp + w1[q] * xc + w2[q] * xn); y[j][q] = s; ss += s * s; }
        if (sect < 2) { ss += __shfl_xor(ss, 1); ss += __shfl_xor(ss, 2); ss += __shfl_xor(ss, 4);
            const float sc = rsqrtf(ss + EPS) * (sect == 0 ? 0.08838834764831845f : 1.f);
#pragma unroll
            for (int q = 0; q < 16; ++q) y[j][q] *= sc; }
    }
    LAS unsigned* tl = (LAS unsigned*)F.lds;
    if (sect > 0) {
#pragma unroll
        for (int j = 0; j < NBLK; ++j) { LAS unsigned* row = tl + (r0 + 64 * j) * 65 + (c0l >> 1);
#pragma unroll
            for (int q = 0; q < 8; ++q) row[q] = pk2(y[j][2 * q], y[j][2 * q + 1]); }
    }
    __syncthreads();
    if (sect < 2) {
#pragma unroll
        for (int j = 0; j < NBLK; ++j) {
            bf16* p = WSP(bf16, WS_PM) + (size_t)(tok0 + r0 + 64 * j) * PM_LD + c0;
            *(u32x4*)p = (u32x4){pk2(y[j][0], y[j][1]), pk2(y[j][2], y[j][3]), pk2(y[j][4], y[j][5]), pk2(y[j][6], y[j][7])};
            *(u32x4*)(p + 8) = (u32x4){pk2(y[j][8], y[j][9]), pk2(y[j][10], y[j][11]), pk2(y[j][12], y[j][13]), pk2(y[j][14], y[j][15])};
        }
    }
    if (sect > 0) {
        const LAS bf16* th = (const LAS bf16*)tl;
#pragma unroll
        for (int it = 0; it < 2 * NBLK; ++it) { const int id = it * 512 + F.tid, tg = id & 7, fc = id >> 3, f = fc & 127, cu_ = fc >> 7;
            unsigned short e[8];
#pragma unroll
            for (int i = 0; i < 8; ++i) e[i] = th[(cu_ * 64 + tg * 8 + i) * 130 + f];
            const u32x4 o = (u32x4){(unsigned)e[0] | ((unsigned)e[1] << 16), (unsigned)e[2] | ((unsigned)e[3] << 16), (unsigned)e[4] | ((unsigned)e[5] << 16), (unsigned)e[6] | ((unsigned)e[7] << 16)};
            const int chunk = (tok0 >> 6) + cu_;
            if (sect == 1) *(u32x4*)(WSP(bf16, WS_KT) + ((size_t)(chunk * 8 + head) * 128 + f) * 64 + tg * 8) = o;
            else *(u32x4*)(WSP(bf16, WS_PM) + (size_t)(chunk * 64 + (f >> 1)) * PM_LD + 2048 + head * 128 + (f & 1) * 64 + tg * 8) = o; }
        __syncthreads();
    }
}
__device__ __forceinline__ void phase_conv(Frame& F, const Args& a, int layer) {
    const float* cw = inp(F, I_CONVW) + (size_t)layer * 3 * 3072;
    for (int u = F.bid; u < 8 * 24; u += F.G) conv_unit<4>(F, cw, (u / 24) * 256, u % 24);
    for (int u = F.bid; u < 512 * 24; u += F.G) conv_unit<1>(F, cw, NCTX + (u / 24) * 64, u % 24);
    const int gt = F.bid * 512 + F.tid, NGT = F.G * 512;
    const float dtb_ = inp(F, I_DTB)[layer * 16 + (gt & 15)], ea_ = __expf(inp(F, I_ALOG)[layer * 16 + (gt & 15)]);
    for (int i = gt; i < NTOK * 16; i += NGT) { const int tok = i >> 4, dh = i & 15;
        const bf16* p = WSP(bf16, WS_PM) + (size_t)tok * PM_LD + PM_AB;
        const float av = bf2f(p[dh]) + dtb_, bv = bf2f(p[16 + dh]);
        const float sp = av > 20.f ? av : log1pf(__expf(av));
        WSP(float, WS_GB)[(size_t)dh * NTOK + tok] = -ea_ * sp;
        WSP(float, WS_GB)[(size_t)(16 + dh) * NTOK + tok] = sigmoidf_(bv); }
}

typedef float f32x16 __attribute__((ext_vector_type(16)));
typedef __bf16 bfx2_t __attribute__((ext_vector_type(2)));
#define MFMA32(a, b, c) __builtin_amdgcn_mfma_f32_32x32x16_bf16((a), (b), (c), 0, 0, 0)
__device__ __forceinline__ unsigned pkbf(float a, float b) { const f32x2 v = {a, b}; const bfx2_t r = __builtin_convertvector(v, bfx2_t); return __builtin_bit_cast(unsigned, r); }
__device__ __forceinline__ bf16x8 pack_step(const f32x16& x, int s) {
    const u32x4 p = {pkbf(x[8 * s], x[8 * s + 1]), pkbf(x[8 * s + 2], x[8 * s + 3]), pkbf(x[8 * s + 4], x[8 * s + 5]), pkbf(x[8 * s + 6], x[8 * s + 7])};
    return __builtin_bit_cast(bf16x8, p);
}
__device__ __forceinline__ int crow(int reg, int h) { return (reg & 3) + 8 * (reg >> 2) + 4 * h; }
__device__ __forceinline__ bf16x8 scale8(const u32x4 t, const f32x4 s0, const f32x4 s1) {
    const u32x4 p = {pkbf(bf_lo(t.x) * s0.x, bf_hi(t.x) * s0.y), pkbf(bf_lo(t.y) * s0.z, bf_hi(t.y) * s0.w), pkbf(bf_lo(t.z) * s1.x, bf_hi(t.z) * s1.y), pkbf(bf_lo(t.w) * s1.z, bf_hi(t.w) * s1.w)};
    return __builtin_bit_cast(bf16x8, p);
}

template <int DIR>
__device__ __forceinline__ void prep_unit(Frame& F, int unit, LAS float* wl) {
    const int h = (unit >> 1) & 7, c = unit >> 4, tok0 = c * 64, lane = F.lane, r = lane & 31, hh = lane >> 5;
    float* gptr = WSP(float, WS_GB) + (size_t)(DIR * 8 + h) * NTOK + tok0; const float* bptr = WSP(float, WS_GB) + (size_t)(16 + DIR * 8 + h) * NTOK + tok0;
    float gc = gptr[lane]; const float be = bptr[lane];
#pragma unroll
    for (int o = 1; o < 64; o <<= 1) { const int src = DIR ? lane + o : lane - o; const float t = __shfl(gc, src & 63); if (src >= 0 && src < 64) gc += t; }
    gptr[lane] = gc;
    LAS float* lgc = wl + 4096; LAS float* lbe = wl + 4160;
    lgc[lane] = gc; lbe[lane] = be;
    const bf16* kp = WSP(bf16, WS_PM) + (size_t)tok0 * PM_LD + 1024 + h * 128;
    {
        bf16x8 KF[2][8];
#pragma unroll
        for (int blk = 0; blk < 2; ++blk)
#pragma unroll
            for (int s = 0; s < 8; ++s) KF[blk][s] = *(const bf16x8*)(kp + (size_t)(32 * blk + r) * PM_LD + 16 * s + 8 * hh);
        LAS float* wrow = wl + (4 * hh) * 64 + r;
#pragma unroll
        for (int ib = 0; ib < 2; ++ib)
#pragma unroll
            for (int jb = 0; jb < 2; ++jb) { f32x16 acc;
#pragma unroll
                for (int i = 0; i < 16; ++i) acc[i] = 0.f;
#pragma unroll
                for (int s = 0; s < 8; ++s) acc = MFMA32(KF[ib][s], KF[jb][s], acc);
#pragma unroll
                for (int i = 0; i < 16; ++i) wrow[(32 * ib + crow(i, 0)) * 64 + 32 * jb] = acc[i]; }
    }
    asm volatile("" ::: "memory");
#pragma unroll 4
    for (int ti = 0; ti < 64; ++ti) { const float x = wl[ti * 64 + lane]; const bool before = DIR ? (lane > ti) : (lane < ti);
        wl[ti * 64 + lane] = before ? lbe[ti] * x * __expf(fminf(lgc[ti] - gc, 0.f)) : 0.f; }
    asm volatile("" ::: "memory");
    float Tc[64]; const float lanef = (float)lane;
#pragma unroll
    for (int i = 0; i < 64; ++i) Tc[i] = 0.f;
    LAS float* wlr = wl;
#pragma unroll
    for (int pi = 0; pi < 64; ++pi) {
        constexpr int dummy = 0; (void)dummy;
        const int ti = DIR ? 63 - pi : pi;
        float sacc = fmaxf(0.f, 1.f - fabsf(lanef - (float)pi));
        if (pi >= 2) asm volatile("" : "+v"(wlr) : "v"(Tc[pi - 2]));
#pragma unroll
        for (int q = 0; q < (pi + 3) / 4; ++q) { const f32x4 l4 = *(const LAS f32x4*)(wlr + ti * 64 + (DIR ? 60 - 4 * q : 4 * q));
            if (DIR) { sacc -= l4.w * Tc[4 * q]; sacc -= l4.z * Tc[4 * q + 1]; sacc -= l4.y * Tc[4 * q + 2]; sacc -= l4.x * Tc[4 * q + 3]; }
            else { sacc -= l4.x * Tc[4 * q]; sacc -= l4.y * Tc[4 * q + 1]; sacc -= l4.z * Tc[4 * q + 2]; sacc -= l4.w * Tc[4 * q + 3]; } }
        Tc[pi] = sacc;
    }
    bf16* tb = WSP(bf16, WS_TB) + ((size_t)(DIR * 544 + c) * 8 + h) * 4096 + (DIR ? 63 - lane : lane);
#pragma unroll
    for (int pi = 0; pi < 64; ++pi) tb[(DIR ? 63 - pi : pi) * 64] = (bf16)f2bf(Tc[pi]);
}
__device__ __forceinline__ void phase_prep(Frame& F) {
    const int gw = F.bid * 8 + F.wave, NGW = F.G * 8;
    LAS float* wl = (LAS float*)(F.lds + F.wave * 17408);
    if (gw & 1) { for (int u = gw; u < 544 * 16; u += NGW) prep_unit<1>(F, u, wl); }
    else { for (int u = gw; u < 544 * 16; u += NGW) prep_unit<0>(F, u, wl); }
}

constexpr int SC_WF = 0, SC_QF = 16384, SC_KF = 32768, SC_AF = 49152, SC_TUF = 57344, SC_EGL = 65536, SC_BUF = 65600, SC_VEC = 2 * SC_BUF;
__device__ __forceinline__ int scan_chunk(int b, int d, int n) { return n < 4 ? (b * 4 + (d ? 3 - n : n)) : (32 + b * 64 + (d ? 67 - n : n - 4)); }
__device__ __forceinline__ void scan_produce(Frame& F, int b, int h, int d, int chunk, LAS unsigned char* buf, int hw) {
    const int lane = F.lane, r = lane & 31, hh = lane >> 5, tok0 = chunk * 64;
    LAS float* vec = (LAS float*)(F.lds + SC_VEC + hw * 1280);
    { const float gc = WSP(float, WS_GB)[(size_t)(d * 8 + h) * NTOK + tok0 + lane], be = WSP(float, WS_GB)[(size_t)(16 + d * 8 + h) * NTOK + tok0 + lane];
      const float gl = __shfl(gc, d ? 0 : 63), eg = __expf(gc);
      vec[lane] = gc; vec[64 + lane] = eg; vec[128 + lane] = be * eg; vec[192 + lane] = be; vec[256 + lane] = __expf(gl - gc);
      if (hw == 0 && lane == 0) *(LAS float*)(buf + SC_EGL) = __expf(gl); }
    const bf16* tb = WSP(bf16, WS_TB) + ((size_t)(d * 544 + chunk) * 8 + h) * 4096;
    const bf16* kt = WSP(bf16, WS_KT) + (size_t)(chunk * 8 + h) * 8192;
    const bf16* qp = WSP(bf16, WS_PM) + (size_t)tok0 * PM_LD + h * 128;
    {
        const int d4 = hw;
        bf16x8 KA[4];
#pragma unroll
        for (int s4 = 0; s4 < 4; ++s4) KA[s4] = *(const bf16x8*)(kt + (32 * d4 + r) * 64 + 16 * s4 + 8 * hh);
#pragma unroll
        for (int tb_ = 0; tb_ < 2; ++tb_) {
            f32x16 acc;
#pragma unroll
            for (int i = 0; i < 16; ++i) acc[i] = 0.f;
#pragma unroll
            for (int s4 = 0; s4 < 4; ++s4) { const u32x4 t8 = *(const u32x4*)(tb + (32 * tb_ + r) * 64 + 16 * s4 + 8 * hh);
                const f32x4 s0 = *(const LAS f32x4*)(vec + 128 + 16 * s4 + 8 * hh), s1 = *(const LAS f32x4*)(vec + 128 + 16 * s4 + 8 * hh + 4);
                acc = MFMA32(KA[s4], scale8(t8, s0, s1), acc); }
#pragma unroll
            for (int i = 0; i < 16; ++i) acc[i] = -acc[i];
#pragma unroll
            for (int s = 0; s < 2; ++s) *(LAS bf16x8*)(buf + SC_WF + ((tb_ * 4 + d4) * 2 + s) * 1024 + lane * 16) = pack_step(acc, s);
        }
    }
#pragma unroll
    for (int q = 0; q < 2; ++q) { const int tb_ = hw >> 1, s4 = 2 * (hw & 1) + q;
        const u32x4 t8 = *(const u32x4*)(tb + (32 * tb_ + r) * 64 + 16 * s4 + 8 * hh);
        const f32x4 s0 = *(const LAS f32x4*)(vec + 192 + 16 * s4 + 8 * hh), s1 = *(const LAS f32x4*)(vec + 192 + 16 * s4 + 8 * hh + 4);
        *(LAS bf16x8*)(buf + SC_TUF + (tb_ * 4 + s4) * 1024 + lane * 16) = scale8(t8, s0, s1); }
    {
        const int jb = hw >> 1, ib = hw & 1;
        f32x16 acc;
#pragma unroll
        for (int i = 0; i < 16; ++i) acc[i] = 0.f;
#pragma unroll
        for (int s8 = 0; s8 < 8; ++s8) { const bf16x8 ka = *(const bf16x8*)(qp + (size_t)(32 * jb + r) * PM_LD + 1024 + 16 * s8 + 8 * hh);
            const bf16x8 qb = *(const bf16x8*)(qp + (size_t)(32 * ib + r) * PM_LD + 16 * s8 + 8 * hh);
            acc = MFMA32(ka, qb, acc); }
        const int ti = 32 * ib + r; const float gci = vec[ti];
#pragma unroll
        for (int i = 0; i < 16; ++i) { const int tj = 32 * jb + crow(i, hh); const float msk = fminf(fmaxf((float)((d ? tj - ti : ti - tj) + 1), 0.f), 1.f);
            acc[i] = msk * acc[i] * __expf(fminf(gci - vec[tj], 0.f)); }
#pragma unroll
        for (int s = 0; s < 2; ++s) *(LAS bf16x8*)(buf + SC_AF + ((ib * 2 + jb) * 2 + s) * 1024 + lane * 16) = pack_step(acc, s);
    }
    {
        const int d4 = hw;
#pragma unroll
        for (int tb_ = 0; tb_ < 2; ++tb_) { const float eq = vec[64 + 32 * tb_ + r];
#pragma unroll
            for (int s = 0; s < 2; ++s) {
                const bf16* q0 = qp + (size_t)(32 * tb_ + r) * PM_LD + 32 * d4 + 16 * s + 4 * hh;
                const u32x2 lo = *(const u32x2*)q0, hi = *(const u32x2*)(q0 + 8);
                const u32x4 qv = {pkbf(bf_lo(lo.x) * eq, bf_hi(lo.x) * eq), pkbf(bf_lo(lo.y) * eq, bf_hi(lo.y) * eq), pkbf(bf_lo(hi.x) * eq, bf_hi(hi.x) * eq), pkbf(bf_lo(hi.y) * eq, bf_hi(hi.y) * eq)};
                *(LAS u32x4*)(buf + SC_QF + ((tb_ * 4 + d4) * 2 + s) * 1024 + lane * 16) = qv;
                const bf16* k0 = kt + (32 * d4 + r) * 64 + 32 * tb_ + 16 * s + 4 * hh;
                const u32x2 kl = *(const u32x2*)k0, kh = *(const u32x2*)(k0 + 8);
                const f32x4 e0 = *(const LAS f32x4*)(vec + 256 + 32 * tb_ + 16 * s + 4 * hh), e1 = *(const LAS f32x4*)(vec + 256 + 32 * tb_ + 16 * s + 8 + 4 * hh);
                const u32x4 kv = {pkbf(bf_lo(kl.x) * e0.x, bf_hi(kl.x) * e0.y), pkbf(bf_lo(kl.y) * e0.z, bf_hi(kl.y) * e0.w), pkbf(bf_lo(kh.x) * e1.x, bf_hi(kh.x) * e1.y), pkbf(bf_lo(kh.y) * e1.z, bf_hi(kh.y) * e1.w)};
                *(LAS u32x4*)(buf + SC_KF + ((d4 * 2 + tb_) * 2 + s) * 1024 + lane * 16) = kv;
            } }
    }
}
__device__ __forceinline__ void phase_scan(Frame& F) {
    if (F.bid >= 128) return;
    const int b = F.bid >> 4, h = (F.bid >> 1) & 7, d = F.bid & 1, lane = F.lane, r = lane & 31, hh = lane >> 5;
    const int sl = F.wave & 3;
    if (F.wave >= 4) {
        scan_produce(F, b, h, d, scan_chunk(b, d, 0), F.lds, sl);
        __syncthreads();
        for (int n = 0; n < 68; ++n) {
            if (n + 1 < 68) scan_produce(F, b, h, d, scan_chunk(b, d, n + 1), F.lds + ((n + 1) & 1) * SC_BUF, sl);
            __syncthreads();
        }
        return;
    }
    f32x16 S[4]; bf16x8 vtf[4];
#pragma unroll
    for (int d4 = 0; d4 < 4; ++d4)
#pragma unroll
        for (int i = 0; i < 16; ++i) S[d4][i] = 0.f;
    const int dv = 32 * sl + r;
#define SCAN_VT(chunk_) do { const bf16* vp = WSP(bf16, WS_PM) + (size_t)((chunk_) * 64 + (dv >> 1)) * PM_LD + 2048 + h * 128 + (dv & 1) * 64 + 8 * hh; \
        _Pragma("unroll") for (int s4 = 0; s4 < 4; ++s4) vtf[s4] = *(const bf16x8*)(vp + 16 * s4); } while (0)
#define SCAN_FR(off, idx) (*(const LAS bf16x8*)(buf + (off) + (idx) * 1024 + lane * 16))
    SCAN_VT(scan_chunk(b, d, 0));
    __syncthreads();
    for (int n = 0; n < 68; ++n) {
        LAS unsigned char* buf = F.lds + (n & 1) * SC_BUF;
        const int chunk = scan_chunk(b, d, n);
        f32x16 vn[2], o[2];
#pragma unroll
        for (int tb_ = 0; tb_ < 2; ++tb_) {
#pragma unroll
            for (int i = 0; i < 16; ++i) { vn[tb_][i] = 0.f; o[tb_][i] = 0.f; }
#pragma unroll
            for (int s4 = 0; s4 < 4; ++s4) vn[tb_] = MFMA32(SCAN_FR(SC_TUF, tb_ * 4 + s4), vtf[s4], vn[tb_]);
        }
        asm volatile("" ::: "memory");
        if (n + 1 < 68) SCAN_VT(scan_chunk(b, d, n + 1));
#pragma unroll
        for (int d4 = 0; d4 < 4; ++d4) {
#pragma unroll
            for (int s = 0; s < 2; ++s) { const bf16x8 sf = pack_step(S[d4], s);
#pragma unroll
                for (int tb_ = 0; tb_ < 2; ++tb_) {
                    vn[tb_] = MFMA32(SCAN_FR(SC_WF, (tb_ * 4 + d4) * 2 + s), sf, vn[tb_]);
                    o[tb_] = MFMA32(SCAN_FR(SC_QF, (tb_ * 4 + d4) * 2 + s), sf, o[tb_]); } }
            asm volatile("" ::: "memory");
        }
        bf16x8 vf[2][2];
#pragma unroll
        for (int tb_ = 0; tb_ < 2; ++tb_)
#pragma unroll
            for (int s = 0; s < 2; ++s) vf[tb_][s] = pack_step(vn[tb_], s);
        bf16* op = WSP(bf16, d ? WS_OB : WS_OF) + (size_t)(chunk * 64) * D + h * 128 + dv;
#pragma unroll
        for (int ib = 0; ib < 2; ++ib) {
#pragma unroll
            for (int jb = 0; jb < 2; ++jb)
#pragma unroll
                for (int s = 0; s < 2; ++s) o[ib] = MFMA32(SCAN_FR(SC_AF, (ib * 2 + jb) * 2 + s), vf[jb][s], o[ib]);
#pragma unroll
            for (int i = 0; i < 16; ++i) op[(size_t)(32 * ib + crow(i, hh)) * D] = (bf16)f2bf(o[ib][i]);
        }
        asm volatile("" ::: "memory");
        const float egl = *(const LAS float*)(buf + SC_EGL);
#pragma unroll
        for (int d4 = 0; d4 < 4; ++d4) {
#pragma unroll
            for (int i = 0; i < 16; ++i) S[d4][i] *= egl;
#pragma unroll
            for (int tb_ = 0; tb_ < 2; ++tb_)
#pragma unroll
                for (int s = 0; s < 2; ++s) S[d4] = MFMA32(SCAN_FR(SC_KF, (d4 * 2 + tb_) * 2 + s), vf[tb_][s], S[d4]);
        }
        __syncthreads();
    }
#undef SCAN_VT
#undef SCAN_FR
}

__device__ __forceinline__ void phase_od(Frame& F, const Args& a, int layer) {
    const int gw = F.bid * 8 + F.wave, NGW = F.G * 8;
    const f32x4 on = *((const f32x4*)(inp(F, I_ONORM) + layer * 128) + (F.lane & 31));
    for (int row = gw; row < NTOK; row += NGW) {
        const u32x2* of = WSP(u32x2, WS_OF) + (size_t)row * 256 + F.lane; const u32x2* ob = WSP(u32x2, WS_OB) + (size_t)row * 256 + F.lane;
        const bf16* zr = WSP(bf16, WS_PM) + (size_t)row * PM_LD + PM_Z + 4 * F.lane;
        u32x2* od = WSP(u32x2, WS_H) + (size_t)row * 256 + F.lane;
#pragma unroll
        for (int j = 0; j < 4; ++j) { const u32x2 p = of[64 * j], q = ob[64 * j]; const u32x2 z = *(const u32x2*)(zr + 256 * j);
            f32x4 o = (f32x4){bf_lo(p.x) + bf_lo(q.x), bf_hi(p.x) + bf_hi(q.x), bf_lo(p.y) + bf_lo(q.y), bf_hi(p.y) + bf_hi(q.y)};
            float ss = (o.x * o.x + o.y * o.y) + (o.z * o.z + o.w * o.w);
            ss += __shfl_xor(ss, 1); ss += __shfl_xor(ss, 2); ss += __shfl_xor(ss, 4); ss += __shfl_xor(ss, 8); ss += __shfl_xor(ss, 16);
            const float r = rsqrtf(ss * (1.f / 128.f) + EPS);
            o = o * r * on;
            o.x *= siluf_(bf_lo(z.x)); o.y *= siluf_(bf_hi(z.x)); o.z *= siluf_(bf_lo(z.y)); o.w *= siluf_(bf_hi(z.y));
            od[64 * j] = (u32x2){pk2(o.x, o.y), pk2(o.z, o.w)}; }
    }
}

struct SchedMain {
    const char* H; const char* W; int G, c;
    __device__ __forceinline__ bool next(int i, Unit& u) const {
        const int L = i * G + c; constexpr int NM = NTILE * 25;
        if (L >= NM + 2 * NTILE) return false;
        if (L < NM) { int pm, pn; pg8::tile_map(L, NTILE, 25, pm, pn); u.pm = pm; u.pn = pn; u.aux = 0; }
        else { const int f = L - NM; u.pm = f & 1; u.pn = f >> 1; u.aux = 1; }
        return true;
    }
    __device__ __forceinline__ const char* a_ptr(const Unit& u) const { return u.aux ? W + (size_t)(PM_LD + u.pm * 256) * D * 2 : H + (size_t)u.pm * 256 * D * 2; }
    __device__ __forceinline__ const char* b_ptr(const Unit& u) const { return u.aux ? H + (size_t)u.pn * 256 * D * 2 : W + (size_t)u.pn * 256 * D * 2; }
};
#define EPI_LANE_IDX int tz_ = threadIdx.x; asm volatile("" : "+v"(tz_)); const int wr_ = tz_ >> 8, wc_ = (tz_ >> 6) & 3, fr_ = tz_ & 15, fq_ = (tz_ >> 4) & 3; (void)wr; (void)wc; (void)fr; (void)fq;
#define EPI_ROWS_BEGIN EPI_LANE_IDX const int rbase = wr_ * 64 + fr_, cbase = wc_ * 32 + 8 * fq_; (void)rbase; (void)cbase;
struct EpiMain {
    static constexpr bool PERM = true;
    bf16* PM; bf16* UTL; bf16* UTC;
    __device__ __forceinline__ void operator()(const f32x4 (&acc)[2][2][4][2], const Unit& u, int wr, int wc, int fr, int fq) const {
        EPI_ROWS_BEGIN
#pragma unroll
        for (int ai = 0; ai < 2; ++ai)
#pragma unroll
            for (int m = 0; m < 4; ++m) { const int r = ai * 128 + m * 16 + rbase;
                bf16* rowp;
                if (u.aux == 0) rowp = PM + (size_t)(u.pm * 256 + r) * PM_LD + u.pn * 256 + cbase;
                else { const int ch = u.pm * 256 + r;
                    if (u.pn < 8) rowp = UTC + ((size_t)(u.pn * 512 + ch)) * 256 + cbase;
                    else { const int q = u.pn - 8; rowp = UTL + ((size_t)((q >> 4) * 512 + ch)) * 4096 + (q & 15) * 256 + cbase; } }
#pragma unroll
                for (int bj = 0; bj < 2; ++bj) { const f32x4 v0 = acc[ai][bj][m][0], v1 = acc[ai][bj][m][1];
                    *(u32x4*)(rowp + bj * 128) = (u32x4){cvt_pk_bf16(v0[0], v0[1]), cvt_pk_bf16(v0[2], v0[3]), cvt_pk_bf16(v1[0], v1[1]), cvt_pk_bf16(v1[2], v1[3])}; } }
    }
};
template <int LAT> struct SchedDft {
    const char* A; const char* B; int G, c;
    __device__ __forceinline__ bool next(int i, Unit& u) const {
        const int L = i * G + c;
        if (LAT) { if (L >= 512) return false; u.aux = L >> 6; u.pm = (L & 63) >> 1; u.pn = L & 1; }
        else { if (L >= 32) return false; u.aux = L >> 2; u.pm = (L >> 1) & 1; u.pn = L & 1; }
        return true;
    }
    __device__ __forceinline__ const char* a_ptr(const Unit& u) const { return A + (size_t)u.pm * 256 * (LAT ? 4096 : 256) * 2; }
    __device__ __forceinline__ const char* b_ptr(const Unit& u) const { return B + ((size_t)u.aux * 512 + u.pn * 256) * (LAT ? 4096 : 256) * 2; }
};
template <int LAT> struct EpiDft {
    static constexpr bool PERM = true;
    bf16* PBUF;
    __device__ __forceinline__ void operator()(const f32x4 (&acc)[2][2][4][2], const Unit& u, int wr, int wc, int fr, int fq) const {
        EPI_ROWS_BEGIN
        const int ri = LAT ? (u.pm >> 4) : u.pm;
        const int tokb = LAT ? (NCTX + u.aux * 4096 + (u.pm & 15) * 256) : (u.aux * 256);
#pragma unroll
        for (int ai = 0; ai < 2; ++ai)
#pragma unroll
            for (int m = 0; m < 4; ++m) { const int r = ai * 128 + m * 16 + rbase;
#pragma unroll
                for (int bj = 0; bj < 2; ++bj) { const int ch = u.pn * 256 + bj * 128 + cbase; const f32x4 v0 = acc[ai][bj][m][0], v1 = acc[ai][bj][m][1];
                    *(u32x4*)(PBUF + (size_t)(tokb + r) * D + (ch >> 7) * 256 + ri * 128 + (ch & 127)) =
                        (u32x4){cvt_pk_bf16(v0[0], v0[1]), cvt_pk_bf16(v0[2], v0[3]), cvt_pk_bf16(v1[0], v1[1]), cvt_pk_bf16(v1[2], v1[3])}; } }
    }
};
struct SchedRows {
    const char* A; const char* B; int G, c;
    __device__ __forceinline__ bool next(int i, Unit& u) const {
        const int L = i * G + c; if (L >= NTILE * 4) return false;
        int pm, pn; pg8::tile_map(L, NTILE, 4, pm, pn); u.pm = pm; u.pn = pn; u.aux = 0; return true;
    }
    __device__ __forceinline__ const char* a_ptr(const Unit& u) const { return A + (size_t)u.pm * 256 * D * 2; }
    __device__ __forceinline__ const char* b_ptr(const Unit& u) const { return B + (size_t)u.pn * 256 * D * 2; }
};
template <int MODE> struct EpiGate {
    static constexpr bool PERM = true;
    bf16* M; const bf16* PM;
    __device__ __forceinline__ void operator()(const f32x4 (&acc)[2][2][4][2], const Unit& u, int wr, int wc, int fr, int fq) const {
        EPI_ROWS_BEGIN
#pragma unroll
        for (int ai = 0; ai < 2; ++ai)
#pragma unroll
            for (int m = 0; m < 4; ++m) { const int row = u.pm * 256 + ai * 128 + m * 16 + rbase;
#pragma unroll
                for (int bj = 0; bj < 2; ++bj) { const int col = u.pn * 256 + bj * 128 + cbase; const f32x4 v0 = acc[ai][bj][m][0], v1 = acc[ai][bj][m][1];
                    const u32x4 g = *(const u32x4*)(PM + (size_t)row * PM_LD + (MODE == 0 ? PM_GA : PM_GB) + col);
                    float o[8] = {v0[0] * sigmoidf_(bf_lo(g.x)), v0[1] * sigmoidf_(bf_hi(g.x)), v0[2] * sigmoidf_(bf_lo(g.y)), v0[3] * sigmoidf_(bf_hi(g.y)),
                                  v1[0] * sigmoidf_(bf_lo(g.z)), v1[1] * sigmoidf_(bf_hi(g.z)), v1[2] * sigmoidf_(bf_lo(g.w)), v1[3] * sigmoidf_(bf_hi(g.w))};
                    u32x4* mp = (u32x4*)(M + (size_t)row * D + col);
                    if (MODE == 1) { const u32x4 p = *mp; o[0] += bf_lo(p.x); o[1] += bf_hi(p.x); o[2] += bf_lo(p.y); o[3] += bf_hi(p.y); o[4] += bf_lo(p.z); o[5] += bf_hi(p.z); o[6] += bf_lo(p.w); o[7] += bf_hi(p.w); }
                    *mp = (u32x4){cvt_pk_bf16(o[0], o[1]), cvt_pk_bf16(o[2], o[3]), cvt_pk_bf16(o[4], o[5]), cvt_pk_bf16(o[6], o[7])}; } }
    }
};
struct EpiResid {
    static constexpr bool PERM = false;
    float* X; const float* MODL;
    __device__ __forceinline__ void operator()(const f32x4 (&acc)[2][2][4][2], const Unit& u, int wr, int wc, int fr, int fq) const {
        EPI_LANE_IDX
        const int rbase = wr_ * 64 + fr_, cb = u.pn * 256 + wc_ * 32 + 4 * fq_;
        const int mb = mod_row(u.pm * 256);
        f32x4 gv[2][2];
#pragma unroll
        for (int bj = 0; bj < 2; ++bj)
#pragma unroll
            for (int n = 0; n < 2; ++n) gv[bj][n] = *(const f32x4*)(MODL + (size_t)mb * 6144 + 2048 + cb + bj * 128 + n * 16);
#pragma unroll
        for (int ai = 0; ai < 2; ++ai)
#pragma unroll
            for (int m = 0; m < 4; ++m) { float* rowp = X + (size_t)(u.pm * 256 + ai * 128 + m * 16 + rbase) * D + cb;
#pragma unroll
                for (int bj = 0; bj < 2; ++bj)
#pragma unroll
                    for (int n = 0; n < 2; ++n) { f32x4* p = (f32x4*)(rowp + bj * 128 + n * 16); *p = *p + gv[bj][n] * acc[ai][bj][m][n]; } }
    }
};
template <int KD> struct SchedMoe {
    const char* A; const char* W; volatile LAS unsigned* LCTL; int G, c, ntile;
    __device__ __forceinline__ bool next(int i, Unit& u) const {
        const int L = i * G + c;
        if (L >= ntile * 4) return false;
        u.pm = L >> 2; u.pn = L & 3; u.aux = __builtin_amdgcn_readfirstlane((int)LCTL[128 + (L >> 2)]); return true;
    }
    __device__ __forceinline__ const char* a_ptr(const Unit& u) const { return A + (size_t)u.pm * 256 * KD * 2; }
    __device__ __forceinline__ const char* b_ptr(const Unit& u) const { return W + ((size_t)u.aux * 1024 + u.pn * 256) * KD * 2; }
};
struct EpiGU {
    static constexpr bool PERM = true;
    bf16* HID;
    __device__ __forceinline__ void operator()(const f32x4 (&acc)[2][2][4][2], const Unit& u, int wr, int wc, int fr, int fq) const {
        EPI_ROWS_BEGIN
#pragma unroll
        for (int ai = 0; ai < 2; ++ai)
#pragma unroll
            for (int m = 0; m < 4; ++m) { const int row = u.pm * 256 + ai * 128 + m * 16 + rbase;
#pragma unroll
                for (int bj = 0; bj < 2; ++bj) { const f32x4 v0 = acc[ai][bj][m][0], v1 = acc[ai][bj][m][1];
                    *(u32x2*)(HID + (size_t)row * EDIM + u.pn * 128 + ((bj * 128 + cbase) >> 1)) =
                        (u32x2){cvt_pk_bf16(siluf_(v0[0]) * v0[1], siluf_(v0[2]) * v0[3]), cvt_pk_bf16(siluf_(v1[0]) * v1[1], siluf_(v1[2]) * v1[3])}; } }
    }
};
struct EpiDown {
    static constexpr bool PERM = true;
    bf16* YS;
    __device__ __forceinline__ void operator()(const f32x4 (&acc)[2][2][4][2], const Unit& u, int wr, int wc, int fr, int fq) const {
        EPI_ROWS_BEGIN
#pragma unroll
        for (int ai = 0; ai < 2; ++ai)
#pragma unroll
            for (int m = 0; m < 4; ++m) { const int row = u.pm * 256 + ai * 128 + m * 16 + rbase;
#pragma unroll
                for (int bj = 0; bj < 2; ++bj) { const f32x4 v0 = acc[ai][bj][m][0], v1 = acc[ai][bj][m][1];
                    *(u32x4*)(YS + (size_t)row * D + u.pn * 256 + bj * 128 + cbase) = (u32x4){cvt_pk_bf16(v0[0], v0[1]), cvt_pk_bf16(v0[2], v0[3]), cvt_pk_bf16(v1[0], v1[1]), cvt_pk_bf16(v1[2], v1[3])}; } }
    }
};

constexpr int PH_PER_LAYER = 12, PH_FINAL = 1 + DEPTH * PH_PER_LAYER, N_PHASES = PH_FINAL + 1;
__global__ void __launch_bounds__(512, 2) fwd_kernel(Args args) {
    extern __shared__ __attribute__((aligned(16))) unsigned char lds[];
    Frame F;
    F.lds = (LAS unsigned char*)lds; F.LCTL = (volatile LAS unsigned*)(F.lds + LDSCTL_OFF);
    F.ws = args.ws; F.tid = threadIdx.x; F.lane = F.tid & 63; F.wave = __builtin_amdgcn_readfirstlane(F.tid >> 6); F.G = gridDim.x; F.bid = blockIdx.x;
    for (int u = F.tid; u < 512; u += 512) F.LCTL[u] = 0u;
    if (F.tid < 25) { const unsigned long long p = (F.tid < 24) ? (unsigned long long)args.in[F.tid] : (unsigned long long)args.out; F.LCTL[512 + 2 * F.tid] = (unsigned)p; F.LCTL[513 + 2 * F.tid] = (unsigned)(p >> 32); }
    __syncthreads();
    XcdBarrier bar; bar.bar = WSP(unsigned, WS_CTL) + CW_BAR; bar.x = 0; bar.st = F.LCTL;
    if (ONE_LAUNCH) bar = xcd_barrier_post(WSP(unsigned, WS_CTL) + CW_BAR, F.LCTL);
    const int lo = args.ph_lo, hi = args.ph_hi;
#define IN(k) (lo <= (k) && (k) < hi)
#define SEAM(k) do { if (IN(k) && IN((k) + 1)) { XcdBarrier b2_ = bar; asm volatile("" : "+s"(b2_.bar)); xcd_barrier(b2_); } } while (0)

    if (PHON(0) && IN(0)) { LAUNDER(F); phase_prologue(F, args); SEAM(0); }

    for (int layer = 0; layer < DEPTH; ++layer) {
        const int pb = 1 + layer * PH_PER_LAYER;
        const char* WL = (const char*)(WSP(bf16, WS_WIN) + (size_t)layer * WIN_ROWS * D);
        if (PHON(1) && IN(pb + 0)) { LAUNDER(F); if (layer == 0) phase_norm<0, false>(F, args, layer); else phase_norm<0, true>(F, args, layer); SEAM(pb + 0); }
        if (PHON(2) && IN(pb + 1)) { LAUNDER(F);
            SchedMain S{(const char*)WSP(bf16, WS_H), WL, F.G, F.bid}; EpiMain E{WSP(bf16, WS_PM), WSP(bf16, WS_UTL), WSP(bf16, WS_UTC)};
            pg8::gemm_phase<EpiMain, SchedMain>(F.lds, D, D, D, S, E);
            SEAM(pb + 1);
        }
        if (PHON(3) && IN(pb + 2)) { LAUNDER(F);
            { SchedDft<1> S{(const char*)WSP(bf16, WS_DFTL), (const char*)WSP(bf16, WS_UTL), F.G, F.bid}; EpiDft<1> E{WSP(bf16, WS_PBUF)};
              pg8::gemm_phase<EpiDft<1>, SchedDft<1>>(F.lds, 4096, 4096, 4096, S, E); }
            { SchedDft<0> S{(const char*)WSP(bf16, WS_DFTC), (const char*)WSP(bf16, WS_UTC), F.G, F.bid}; EpiDft<0> E{WSP(bf16, WS_PBUF)};
              pg8::gemm_phase<EpiDft<0>, SchedDft<0>>(F.lds, 256, 256, 256, S, E); }
            phase_conv(F, args, layer);
            SEAM(pb + 2);
        }
        if (PHON(4) && IN(pb + 3)) { LAUNDER(F); phase_prep(F); SEAM(pb + 3); }
        if (PHON(13) && IN(pb + 4)) { LAUNDER(F); phase_scan(F); SEAM(pb + 4); }
        if (PHON(5) && IN(pb + 5)) { LAUNDER(F); phase_od(F, args, layer); moe_weight_convert(F, args, layer, 0, (LAS float*)(F.lds + F.wave * 8448)); SEAM(pb + 5); }
        if (PHON(6) && IN(pb + 6)) { LAUNDER(F);
            { SchedRows S{(const char*)WSP(bf16, WS_PBUF), (const char*)(WSP(bf16, WS_WPA) + (size_t)layer * D * D), F.G, F.bid}; EpiGate<0> E{WSP(bf16, WS_OF), WSP(bf16, WS_PM)};
              pg8::gemm_phase<EpiGate<0>, SchedRows>(F.lds, D, D, D, S, E); }
            { SchedRows S{(const char*)WSP(bf16, WS_H), (const char*)(WSP(bf16, WS_WDL) + (size_t)layer * D * D), F.G, F.bid}; EpiGate<1> E{WSP(bf16, WS_OF), WSP(bf16, WS_PM)};
              pg8::gemm_phase<EpiGate<1>, SchedRows>(F.lds, D, D, D, S, E); }
            SEAM(pb + 6);
        }
        if (PHON(7) && IN(pb + 7)) { LAUNDER(F);
            SchedRows S{(const char*)WSP(bf16, WS_OF), (const char*)(WSP(bf16, WS_WOUT) + (size_t)layer * D * D), F.G, F.bid}; EpiResid E{WSP(float, WS_X), WSP(float, WS_MOD) + (size_t)layer * 9 * 6144};
            pg8::gemm_phase<EpiResid, SchedRows>(F.lds, D, D, D, S, E);
            SEAM(pb + 7);
        }
        if (PHON(8) && IN(pb + 8)) { LAUNDER(F); phase_route(F, args, layer); SEAM(pb + 8); }
        if (PHON(9) && IN(pb + 9)) { LAUNDER(F); phase_assign(F, args, layer); SEAM(pb + 9); }
        if (PHON(10) && IN(pb + 10)) { LAUNDER(F);
            build_moe_tables(F, layer);
            SchedMoe<D> S{(const char*)WSP(bf16, WS_XS), (const char*)WSP(bf16, WS_MOEW), F.LCTL, F.G, F.bid, __builtin_amdgcn_readfirstlane((int)(F.LCTL[16 + NEXP] >> 8))}; EpiGU E{WSP(bf16, WS_HID)};
            pg8::gemm_phase<EpiGU, SchedMoe<D>>(F.lds, D, D, D, S, E);
            SEAM(pb + 10);
        }
        if (PHON(11) && IN(pb + 11)) { LAUNDER(F);
            build_moe_tables(F, layer);
            SchedMoe<EDIM> S{(const char*)WSP(bf16, WS_HID), (const char*)WSP(bf16, WS_MOEWD), F.LCTL, F.G, F.bid, __builtin_amdgcn_readfirstlane((int)(F.LCTL[16 + NEXP] >> 8))}; EpiDown E{WSP(bf16, WS_YS)};
            pg8::gemm_phase<EpiDown, SchedMoe<EDIM>>(F.lds, EDIM, EDIM, EDIM, S, E);
            SEAM(pb + 11);
        }
    }
    if (PHON(12) && IN(PH_FINAL)) { LAUNDER(F); } if (PHON(12) && IN(PH_FINAL)) phase_norm<1, true>(F, args, DEPTH);
#undef IN
#undef SEAM
}

extern "C" void kernel_launch(void* const* d_in, const int* in_sizes, int n_in, void* d_out, int out_size, void* d_ws, size_t ws_size, hipStream_t stream) {
    static int grid = 0;
    if (grid == 0) {
        if (n_in != 24 || out_size != NLAT * D || ws_size < WS_END) { fprintf(stderr, "kernel_launch: unexpected problem (n_in %d, out %d, ws %zu < %zu)\n", n_in, out_size, ws_size, (size_t)WS_END); grid = -1; return; }
        int dev = 0, cus = 0, per_cu = 0;
        if (hipGetDevice(&dev) != hipSuccess || hipDeviceGetAttribute(&cus, hipDeviceAttributeMultiprocessorCount, dev) != hipSuccess) { grid = -1; return; }
        if (hipFuncSetAttribute((const void*)fwd_kernel, hipFuncAttributeMaxDynamicSharedMemorySize, LDS_BYTES) != hipSuccess) { fprintf(stderr, "kernel_launch: hipFuncSetAttribute failed\n"); grid = -1; return; }
        if (hipOccupancyMaxActiveBlocksPerMultiprocessor(&per_cu, (const void*)fwd_kernel, 512, LDS_BYTES) != hipSuccess || per_cu < 1) fprintf(stderr, "kernel_launch: occupancy query reports %d\n", per_cu);
        (void)hipGetLastError();
        grid = cus;
    }
    if (grid < 0) return;
    hipMemsetAsync((char*)d_ws + WS_CTL, 0, CTL_ZERO_BYTES, stream);
    Args a{};
    for (int i = 0; i < 24; ++i) a.in[i] = (const float*)d_in[i];
    a.out = (float*)d_out; a.ws = (unsigned char*)d_ws;
#if ONE_LAUNCH
    a.ph_lo = 0; a.ph_hi = N_PHASES;
    hipLaunchKernelGGL(fwd_kernel, dim3(grid), dim3(512), LDS_BYTES, stream, a);
#else
    for (int p = 0; p < N_PHASES; ++p) { a.ph_lo = p; a.ph_hi = p + 1; hipLaunchKernelGGL(fwd_kernel, dim3(grid), dim3(512), LDS_BYTES, stream, a); }
#endif
}
```

```cpp
#include <hip/hip_runtime.h>
#include <cstdio>
#include <cstdint>

#ifndef ONE_LAUNCH
#define ONE_LAUNCH 1
#endif
#ifndef PHMASK
#define PHMASK 0xFFFFu
#endif
#define PHON(k) ((PHMASK >> (k)) & 1u)
#ifndef REPEAT_MASK
#define REPEAT_MASK 0
#endif
#define REPS(k) (1 + ((REPEAT_MASK >> (k)) & 1))

#define GAS __attribute__((address_space(1)))
#define LAS __attribute__((address_space(3)))
typedef unsigned short bf16;
typedef short bf16x8 __attribute__((ext_vector_type(8)));
typedef float f32x4 __attribute__((ext_vector_type(4)));
typedef float f32x2 __attribute__((ext_vector_type(2)));
typedef unsigned u32x4 __attribute__((ext_vector_type(4)));
typedef unsigned u32x2 __attribute__((ext_vector_type(2)));

constexpr int D = 1024, NB = 8, SEQ = 4096, DEPTH = 4, CTXL = 256;
constexpr int NCTX = NB * CTXL;
constexpr int NLAT = NB * SEQ;
constexpr int NTOK = NCTX + NLAT;
constexpr int NTILE = NTOK / 256;
constexpr int IN_COLS = 6688, OFF_A = 3072, OFF_Z = 3104, OFF_F = 4128, OFF_G = 4640;
constexpr int PM_LD = 6400;
constexpr int PM_Z = 3072, PM_GA = 4096, PM_GB = 5120, PM_AB = 6144;
constexpr int WIN_ROWS = 6912;
constexpr int NEXP = 32, EDIM = 512, NSLOT = 77824, MAXTILES = 304;
constexpr float EPS = 1e-6f;

constexpr size_t MiB = 1u << 20;
constexpr size_t WS_CTL = 0, CTL_ZERO_BYTES = 1 * MiB;
constexpr size_t WS_MOD = 1 * MiB;
constexpr size_t WS_X = 2 * MiB;
constexpr size_t WS_WIN = WS_X + 136 * MiB;
constexpr size_t WS_WPA = WS_WIN + 54 * MiB;
constexpr size_t WS_WDL = WS_WPA + 8 * MiB;
constexpr size_t WS_WOUT = WS_WDL + 8 * MiB;
constexpr size_t WS_DFTL = WS_WOUT + 8 * MiB;
constexpr size_t WS_DFTC = WS_DFTL + 64 * MiB;
constexpr size_t WS_MOEW = WS_DFTC + 1 * MiB;
constexpr size_t WS_MOEWD = WS_MOEW + 64 * MiB;
constexpr size_t WS_KT = WS_MOEW + 28 * MiB;
constexpr size_t WS_H = WS_MOEW + 96 * MiB;
constexpr size_t WS_TB = WS_H;
constexpr size_t WS_PM = WS_H + 68 * MiB;
constexpr size_t WS_XS = WS_PM;
constexpr size_t WS_TOKOF = WS_XS + 1 * MiB;
constexpr size_t WS_HID = WS_XS + 152 * MiB;
constexpr size_t WS_YS = WS_HID + 76 * MiB;
constexpr size_t WS_UTL = WS_PM + 425 * MiB;
constexpr size_t WS_UTC = WS_UTL + 32 * MiB;
constexpr size_t WS_PBUF = WS_UTC + 2 * MiB;
constexpr size_t WS_OF = WS_PBUF + 68 * MiB;
constexpr size_t WS_OB = WS_OF + 68 * MiB;
constexpr size_t WS_GB = WS_OB + 68 * MiB;
constexpr size_t WS_ROUTE = WS_GB + 5 * MiB;
constexpr size_t WS_MA0 = WS_DFTL + 32 * MiB;
constexpr size_t WS_MA1 = WS_PM + 425 * MiB;
constexpr size_t WS_MA2 = WS_ROUTE + 1 * MiB;
constexpr size_t WS_MAC = WS_MA2 + 8 * MiB;
constexpr size_t WS_END = WS_MAC + 4 * MiB;
static_assert(WS_YS + 152 * MiB <= WS_UTL, "MoE overlay fits inside PM");
static_assert(WS_END <= 1145ull * MiB, "d_ws budget");
constexpr int CW_BAR = 4096;
constexpr int CW_CNT = 16384;
constexpr int CW_CUR = 16384 + 1024;
constexpr int CW_SUB = 16384 + 2048;

constexpr int LDS_SCRATCH = 151552;
constexpr int LDSCTL_OFF = LDS_SCRATCH;
constexpr int LDS_BYTES = LDS_SCRATCH + 4096;

#define LDS_WAIT() asm volatile("s_waitcnt lgkmcnt(0)" ::: "memory")
#define LDS_BARRIER() do { asm volatile("s_waitcnt lgkmcnt(0)" ::: "memory"); __builtin_amdgcn_s_barrier(); asm volatile("" ::: "memory"); } while (0)
#define VM_WAIT() asm volatile("s_waitcnt vmcnt(0)" ::: "memory")

typedef __bf16 bfx2_t __attribute__((ext_vector_type(2)));
__device__ __forceinline__ unsigned pk2(float lo, float hi) { const f32x2 v = {lo, hi}; const bfx2_t r = __builtin_convertvector(v, bfx2_t); return __builtin_bit_cast(unsigned, r); }
__device__ __forceinline__ unsigned f2bf(float f) { return pk2(f, 0.f) & 0xffffu; }
__device__ __forceinline__ float bf_lo(unsigned w) { return __builtin_bit_cast(float, w << 16); }
__device__ __forceinline__ float bf_hi(unsigned w) { return __builtin_bit_cast(float, w & 0xffff0000u); }
__device__ __forceinline__ float bf2f(bf16 b) { return __builtin_bit_cast(float, (unsigned)b << 16); }
__device__ __forceinline__ float sigmoidf_(float x) { return __builtin_amdgcn_rcpf(1.f + __expf(-x)); }
__device__ __forceinline__ float siluf_(float x) { return x * __builtin_amdgcn_rcpf(1.f + __expf(-x)); }
template <int CTRL> __device__ __forceinline__ float dpp_add(float v) { return v + __builtin_bit_cast(float, __builtin_amdgcn_update_dpp(0, __builtin_bit_cast(int, v), CTRL, 0xf, 0xf, true)); }
__device__ __forceinline__ float sum8(float v) { v = dpp_add<0xB1>(v); v = dpp_add<0x4E>(v); return dpp_add<0x141>(v); }
__device__ __forceinline__ float sum16(float v) { return dpp_add<0x140>(sum8(v)); }
__device__ __forceinline__ float wave_sum(float v) {
    const int r = __builtin_bit_cast(int, sum16(v));
    return (__builtin_bit_cast(float, __builtin_amdgcn_readlane(r, 0)) + __builtin_bit_cast(float, __builtin_amdgcn_readlane(r, 16))) +
           (__builtin_bit_cast(float, __builtin_amdgcn_readlane(r, 32)) + __builtin_bit_cast(float, __builtin_amdgcn_readlane(r, 48)));
}
__device__ __forceinline__ float sum32(float v, int lane) {
    const int r = __builtin_bit_cast(int, sum16(v));
    const float a = __builtin_bit_cast(float, __builtin_amdgcn_readlane(r, 0)) + __builtin_bit_cast(float, __builtin_amdgcn_readlane(r, 16));
    const float b = __builtin_bit_cast(float, __builtin_amdgcn_readlane(r, 32)) + __builtin_bit_cast(float, __builtin_amdgcn_readlane(r, 48));
    return lane < 32 ? a : b;
}
#define XB_TMO      128
#define XB_XCNT(j)  (256  + 64 * (j))
#define XB_XSUB(j)  (1280 + 64 * (j))
#define XB_XGEN(j)  (2304 + 64 * (j))
#define XB_TOP      3328
#define XB_TOPGEN   3392
#define XCD_BAR_WORDS 3456
#define XB_SPIN_CAP (1u << 18)
__device__ __forceinline__ unsigned xb_ld(unsigned* p)              { return __hip_atomic_load(p, __ATOMIC_RELAXED, __HIP_MEMORY_SCOPE_AGENT); }
__device__ __forceinline__ unsigned xb_add(unsigned* p, unsigned v) { return __hip_atomic_fetch_add(p, v, __ATOMIC_RELAXED, __HIP_MEMORY_SCOPE_AGENT); }
__device__ __forceinline__ unsigned xb_xcc_id() { return (unsigned)__builtin_amdgcn_s_getreg((3 << 11) | 20) & 0xFu; }
#define XB_SPIN(cond, bar) do { unsigned _sp = 0; while (cond) { __builtin_amdgcn_s_sleep(1); \
    if ((++_sp & 255u) == 0u) { if (xb_ld(&(bar)[XB_TMO])) break; if (_sp > XB_SPIN_CAP) { atomicAdd(&(bar)[XB_TMO], 1u); break; } } } } while (0)
struct XcdBarrier { unsigned* bar; unsigned x; volatile LAS unsigned* st; };
__device__ __forceinline__ XcdBarrier xcd_barrier_post(unsigned* bar, volatile LAS unsigned* st) {
    XcdBarrier b; b.bar = bar; b.x = xb_xcc_id(); b.st = st;
    if (threadIdx.x == 0) (void)xb_add(&bar[XB_XCNT(b.x)], 1u);
    return b;
}
__device__ __forceinline__ void xcd_barrier_complete(unsigned* bar, unsigned x, unsigned& nloc, unsigned& nx) {
    const unsigned G = gridDim.x * gridDim.y * gridDim.z;
    unsigned sum, cnt, mine, sp = 0u;
    for (;;) {
        sum = 0u; cnt = 0u; mine = 0u;
#pragma unroll
        for (unsigned j = 0; j < 16; ++j) { const unsigned c = xb_ld(&bar[XB_XCNT(j)]); sum += c; cnt += (c > 0u) ? 1u : 0u; mine = (j == x) ? c : mine; }
        if (sum == G) break;
        __builtin_amdgcn_s_sleep(1);
        if ((++sp & 255u) == 0u) { if (xb_ld(&bar[XB_TMO])) break; if (sp > XB_SPIN_CAP) { atomicAdd(&bar[XB_TMO], 1u); break; } }
    }
    nloc = mine > 0u ? mine : 1u; nx = cnt > 0u ? cnt : 1u;
}
__device__ __forceinline__ void xcd_barrier(const XcdBarrier& b) {
    asm volatile("s_waitcnt vmcnt(0)" ::: "memory");
    __syncthreads();
    if (threadIdx.x == 0) {
        unsigned* bar = b.bar;
        __builtin_amdgcn_s_waitcnt(0);
        unsigned nloc = b.st[0], nx = b.st[1];
        if (nloc == 0u) { xcd_barrier_complete(bar, b.x, nloc, nx); b.st[0] = nloc; b.st[1] = nx; }
        const unsigned old = xb_add(&bar[XB_XSUB(b.x)], 1u);
        const unsigned gen = old / nloc;
        if (old + 1u == (gen + 1u) * nloc) {
            __builtin_amdgcn_fence(__ATOMIC_RELEASE, "agent");
            asm volatile("s_waitcnt vmcnt(0)" ::: "memory");
            const unsigned og = xb_add(&bar[XB_TOP], 1u);
            const unsigned tg = og / nx;
            if (og + 1u == (tg + 1u) * nx) xb_add(&bar[XB_TOPGEN], 1u);
            else XB_SPIN(xb_ld(&bar[XB_TOPGEN]) == tg, bar);
            __builtin_amdgcn_fence(__ATOMIC_ACQUIRE, "agent");
            xb_add(&bar[XB_XGEN(b.x)], 1u);
            asm volatile("s_waitcnt vmcnt(0)" ::: "memory");
        } else {
            XB_SPIN(xb_ld(&bar[XB_XGEN(b.x)]) == gen, bar);
            __builtin_amdgcn_fence(__ATOMIC_ACQUIRE, "agent");
            asm volatile("s_waitcnt vmcnt(0)" ::: "memory");
        }
    }
    __syncthreads();
}

namespace pg8 {
constexpr int BM = 256, BK = 64, HALF = 128, HTB = HALF * BK * 2, STAGE_BYTES = 8 * HTB, NXCD = 8, WGM = 8;
__device__ __forceinline__ int lds_byte(int r, int c) { const int st = (r >> 4) * 2 + (c >> 5), rr = r & 15, cc = c & 31, ob = rr * 64 + cc * 2; return st * 1024 + (ob ^ (((ob >> 9) & 1) << 5)); }
__device__ __forceinline__ void stage_rc(int b, int& R, int& C) { const int st = b / 1024, sb = b % 1024, swz = sb ^ (((sb >> 9) & 1) << 5); R = (st >> 1) * 16 + swz / 64; C = (st & 1) * 32 + (swz % 64) / 2; }
__device__ __forceinline__ int perm32(int rho) { const int n = rho >> 4, i = rho & 15; return 8 * (i >> 2) + 4 * n + (i & 3); }
__device__ __forceinline__ unsigned cvt_pk_bf16(float lo, float hi) { unsigned r; asm volatile("v_cvt_pk_bf16_f32 %0, %1, %2" : "=v"(r) : "v"(lo), "v"(hi)); return r; }

struct Unit { int pm, pn, aux; };

__device__ __forceinline__ void tile_map(int L, int nM, int nN, int& pm, int& pn) {
    const int nwg = nM * nN; int wgid = L;
    { const int q = nwg / NXCD, r = nwg % NXCD, xcd = wgid % NXCD, off = wgid / NXCD; wgid = (xcd < r ? xcd * (q + 1) : r * (q + 1) + (xcd - r) * q) + off; }
    const int nig = WGM * nN, gid = wgid / nig, fm = gid * WGM, gsz = (nM - fm) < WGM ? (nM - fm) : WGM;
    pm = fm + ((wgid % nig) % gsz); pn = (wgid % nig) / gsz;
}

template <class Epi, class Sched, bool GATHER = false>
__device__ __forceinline__ void gemm_phase(LAS unsigned char* lds_v, const int lda, const int ldb, const int K, const Sched& S, const Epi& E, const LAS unsigned* gidx = nullptr) {
    LAS unsigned char* lds = (LAS unsigned char*)(size_t)(unsigned)__builtin_amdgcn_readfirstlane((int)(size_t)lds_v);
    int tid_ = threadIdx.x; asm volatile("" : "+v"(tid_));
    const int tid = tid_, wid = __builtin_amdgcn_readfirstlane(tid >> 6), lane = tid & 63, wr = wid >> 2, wc = wid & 3, fr = lane & 15, fq = lane >> 4;
    const int nt = K / BK;
    unsigned voffA[2], voffB[2], voffG[2][2]; int gR[2];
#pragma unroll
    for (int i = 0; i < 2; ++i) { int R, C; stage_rc(tid * 16 + i * 8192, R, C); const int Rb = Epi::PERM ? ((R & ~31) + perm32(R & 31)) : R;
        voffA[i] = GATHER ? (unsigned)C * 2u : (unsigned)(R * lda + C) * 2u; voffB[i] = (unsigned)(Rb * ldb + C) * 2u; gR[i] = R; }
#define PG8_GLOAD(u_) do { if constexpr (GATHER) { _Pragma("unroll") for (int h_ = 0; h_ < 2; ++h_) _Pragma("unroll") for (int p_ = 0; p_ < 2; ++p_) voffG[h_][p_] = gidx[(u_) * 256 + h_ * 128 + gR[p_]] + voffA[p_]; } } while (0)
    const size_t kstep = (size_t)(BK * 2);
    const unsigned hstepA = (unsigned)(HALF * lda * 2), hstepB = (unsigned)(HALF * ldb * 2);
    const unsigned ldsw = (unsigned)wid * 1024u;
    const int aoff = lds_byte(wr * 64 + fr, fq * 8), boff = lds_byte(wc * 32 + fr, fq * 8);
#define PG8_SA(b, h) (((b) * 2 + (h)) * HTB)
#define PG8_SB(b, h) ((4 + (b) * 2 + (h)) * HTB)
#define PG8_STAGE(bufoff, gbase, voff) do { _Pragma("unroll") for (int _i = 0; _i < 2; ++_i) \
        __builtin_amdgcn_global_load_lds((const unsigned*)((const char*)(gbase) + (voff)[_i]), (LAS unsigned*)(lds + (bufoff) + ldsw + _i * 8192), 16, 0, 0); } while (0)
#define PG8_STAGEA(bufoff, ptr, h, koff) do { if constexpr (GATHER) { _Pragma("unroll") for (int _i = 0; _i < 2; ++_i) \
        __builtin_amdgcn_global_load_lds((const unsigned*)(gA + (koff) + voffG[h][_i]), (LAS unsigned*)(lds + (bufoff) + ldsw + _i * 8192), 16, 0, 0); } else { PG8_STAGE(bufoff, ptr, voffA); } } while (0)
#define PG8_LDA(dst, b, h) do { _Pragma("unroll") for (int m = 0; m < 4; ++m) _Pragma("unroll") for (int k = 0; k < 2; ++k) dst[m][k] = *(const LAS bf16x8*)(lds + PG8_SA(b, h) + aoff + m * 2048 + k * 1024); } while (0)
#define PG8_LDB(dst, b, h) do { _Pragma("unroll") for (int n = 0; n < 2; ++n) _Pragma("unroll") for (int k = 0; k < 2; ++k) dst[n][k] = *(const LAS bf16x8*)(lds + PG8_SB(b, h) + boff + n * 2048 + k * 1024); } while (0)
#define PG8_MMA(ai, bj, At, Bt) do { __builtin_amdgcn_s_setprio(1); _Pragma("unroll") for (int m = 0; m < 4; ++m) _Pragma("unroll") for (int n = 0; n < 2; ++n) _Pragma("unroll") for (int k = 0; k < 2; ++k) \
        acc[ai][bj][m][n] = __builtin_amdgcn_mfma_f32_16x16x32_bf16(Bt[n][k], At[m][k], acc[ai][bj][m][n], 0, 0, 0); __builtin_amdgcn_s_setprio(0); } while (0)
#define PG8_WAIT_V(n) asm volatile("s_waitcnt vmcnt(" #n ")" ::: "memory")
#define PG8_WAIT_L(n) asm volatile("s_waitcnt lgkmcnt(" #n ")" ::: "memory")
#define PG8_BAR __builtin_amdgcn_s_barrier()
#define PG8_SCHED __builtin_amdgcn_sched_barrier(0)
    Unit cur, nxt; int ui = 0;
    if (!S.next(0, cur)) return;
    f32x4 acc[2][2][4][2];
#pragma unroll
    for (int a = 0; a < 2; ++a)
#pragma unroll
        for (int b = 0; b < 2; ++b)
#pragma unroll
            for (int m = 0; m < 4; ++m)
#pragma unroll
                for (int n = 0; n < 2; ++n) acc[a][b][m][n] = (f32x4){0.f, 0.f, 0.f, 0.f};
    bf16x8 At[4][2], B0[2][2], B1[2][2];
    const char* cA = GATHER ? nullptr : S.a_ptr(cur); const char* cB = S.b_ptr(cur); const char* gA = GATHER ? S.a_ptr(cur) : nullptr;
    PG8_GLOAD(0);
    PG8_STAGE(PG8_SB(0, 0), cB, voffB); PG8_STAGE(PG8_SB(0, 1), cB + hstepB, voffB); PG8_STAGEA(PG8_SA(0, 0), cA, 0, 0); PG8_STAGEA(PG8_SA(0, 1), cA + hstepA, 1, 0);
    if (wr == 1) PG8_BAR;
    PG8_WAIT_V(2); PG8_BAR;
    PG8_STAGE(PG8_SB(1, 0), cB + kstep, voffB); PG8_STAGEA(PG8_SA(1, 0), cA + kstep, 0, kstep); PG8_STAGE(PG8_SB(1, 1), cB + hstepB + kstep, voffB);
    PG8_WAIT_V(6); PG8_BAR;
    for (;;) {
        const bool has_next = S.next(ui + 1, nxt);
        const char* nA = GATHER ? nullptr : (has_next ? S.a_ptr(nxt) : cA); const char* nB = has_next ? S.b_ptr(nxt) : cB;
#pragma nounroll
        for (int t = 0; t < nt; t += 2) {
            const bool last = (t == nt - 2);
            const char* a1 = cA + (size_t)(t + 1) * kstep;
            const char* a2 = last ? nA : cA + (size_t)(t + 2) * kstep; const char* b2 = last ? nB : cB + (size_t)(t + 2) * kstep;
            const char* a3 = a2 + kstep; const char* b3 = b2 + kstep;
            const size_t k1 = (size_t)(t + 1) * kstep, k2 = last ? 0 : (size_t)(t + 2) * kstep, k3 = k2 + kstep;
            PG8_LDB(B0, 0, 0); PG8_LDB(B1, 0, 1); PG8_SCHED; PG8_LDA(At, 0, 0); PG8_STAGEA(PG8_SA(1, 1), a1 + hstepA, 1, k1);
            if (last && has_next) PG8_GLOAD(ui + 1);
            PG8_WAIT_V(8); PG8_WAIT_L(0); PG8_BAR; PG8_MMA(0, 0, At, B0); PG8_MMA(0, 1, At, B1); PG8_BAR; PG8_SCHED;
            PG8_LDA(At, 0, 1); PG8_STAGE(PG8_SB(0, 0), b2, voffB); PG8_STAGE(PG8_SB(0, 1), b2 + hstepB, voffB); PG8_STAGEA(PG8_SA(0, 0), a2, 0, k2);
            PG8_WAIT_V(8); PG8_WAIT_L(0); PG8_BAR; PG8_MMA(1, 0, At, B0); PG8_MMA(1, 1, At, B1); PG8_BAR; PG8_SCHED;
            PG8_LDB(B0, 1, 0); PG8_LDB(B1, 1, 1); PG8_SCHED; PG8_LDA(At, 1, 0); PG8_STAGEA(PG8_SA(0, 1), a2 + hstepA, 1, k2);
            PG8_WAIT_V(8); PG8_WAIT_L(0); PG8_BAR; PG8_MMA(0, 0, At, B0); PG8_MMA(0, 1, At, B1); PG8_BAR; PG8_SCHED;
            PG8_LDA(At, 1, 1); PG8_STAGE(PG8_SB(1, 0), b3, voffB); PG8_STAGE(PG8_SB(1, 1), b3 + hstepB, voffB); PG8_STAGEA(PG8_SA(1, 0), a3, 0, k3);
            PG8_WAIT_V(8); PG8_WAIT_L(0); PG8_BAR; PG8_MMA(1, 0, At, B0); PG8_MMA(1, 1, At, B1); PG8_BAR; PG8_SCHED;
        }
        if (wr == 0) PG8_BAR;
        E(acc, cur, wr, wc, fr, fq);
        if (!has_next) break;
#pragma unroll
        for (int a = 0; a < 2; ++a)
#pragma unroll
            for (int b = 0; b < 2; ++b)
#pragma unroll
                for (int m = 0; m < 4; ++m)
#pragma unroll
                    for (int n = 0; n < 2; ++n) acc[a][b][m][n] = (f32x4){0.f, 0.f, 0.f, 0.f};
        cur = nxt; cA = nA; cB = nB; ++ui;
        if (wr == 1) PG8_BAR;
    }
    PG8_WAIT_V(0);
    PG8_BAR;
#undef PG8_SA
#undef PG8_SB
#undef PG8_STAGE
#undef PG8_STAGEA
#undef PG8_GLOAD
#undef PG8_LDA
#undef PG8_LDB
#undef PG8_MMA
#undef PG8_WAIT_V
#undef PG8_WAIT_L
#undef PG8_BAR
#undef PG8_SCHED
}
}
using pg8::Unit;
using pg8::cvt_pk_bf16;

struct Args { const float* in[24]; float* out; unsigned char* ws; int ph_lo, ph_hi; };
enum { I_X = 0, I_C, I_CTX, I_CCTX, I_WMOD, I_BMOD, I_NMIX, I_NFFN, I_WIN, I_CONVW, I_ALOG, I_DTB, I_ONORM, I_WF, I_WDL, I_WOUT, I_WRG, I_BRG, I_WRE, I_BRE, I_WG, I_WU, I_WD, I_FNORM };

struct Frame {
    LAS unsigned char* lds;
    volatile LAS unsigned* LCTL;
    GAS unsigned char* ws;
    int tid, lane, wave, G, bid;
};
#define WSP(T, off) ((T*)(GAS T*)(F.ws + (off)))
#define WSG(T, off) ((GAS T*)(F.ws + (off)))
__device__ __forceinline__ const float* inp(const Frame& F, int i) {
    const unsigned lo = __builtin_amdgcn_readfirstlane(F.LCTL[512 + 2 * i]), hi = __builtin_amdgcn_readfirstlane(F.LCTL[513 + 2 * i]);
    const float* p = (const float*)(GAS const float*)(((unsigned long long)hi << 32) | lo);
    return p;
}
#define LAUNDER(F) do { int t_ = threadIdx.x; LAS unsigned char* l_ = (LAS unsigned char*)lds; \
    unsigned wl_ = __builtin_amdgcn_readfirstlane((unsigned)(unsigned long long)args.ws), wh_ = __builtin_amdgcn_readfirstlane((unsigned)((unsigned long long)args.ws >> 32)); \
    int b_ = __builtin_amdgcn_readfirstlane((int)blockIdx.x), g_ = __builtin_amdgcn_readfirstlane((int)gridDim.x); \
    asm volatile("" : "+v"(t_), "+s"(wl_), "+s"(wh_), "+s"(b_), "+s"(g_), "+v"(l_)); \
    F.tid = t_; F.ws = (GAS unsigned char*)(((unsigned long long)wh_ << 32) | wl_); F.bid = b_; F.G = g_; F.lds = l_; F.LCTL = (volatile LAS unsigned*)(F.lds + LDSCTL_OFF); \
    F.lane = F.tid & 63; F.wave = __builtin_amdgcn_readfirstlane(F.tid >> 6); } while (0)

__device__ __forceinline__ void transpose_item(const float* W, int ldw, int col0, int K, int N, bf16* WT, int row_off, int row_mul, int row_add, LAS float* scr, int item, int lane) {
    const int nblk = N / 32, kb = item / nblk, nb = item % nblk, k0 = 64 * kb, n0 = 32 * nb;
#pragma unroll 8
    for (int i = 0; i < 32; ++i) { const int kk = 2 * i + (lane >> 5); scr[kk * 33 + (lane & 31)] = W[(size_t)(k0 + kk) * ldw + col0 + n0 + (lane & 31)]; }
    LDS_WAIT(); asm volatile("" ::: "memory");
    const int c = lane & 7;
#pragma unroll
    for (int j = 0; j < 4; ++j) { const int n = (lane >> 3) + 8 * j; const LAS float* s = scr + (8 * c) * 33 + n;
        u32x4 o; o.x = pk2(s[0 * 33], s[1 * 33]); o.y = pk2(s[2 * 33], s[3 * 33]); o.z = pk2(s[4 * 33], s[5 * 33]); o.w = pk2(s[6 * 33], s[7 * 33]);
        *(u32x4*)(WT + (size_t)(row_off + (n0 + n) * row_mul + row_add) * K + k0 + 8 * c) = o; }
    LDS_WAIT(); asm volatile("" ::: "memory");
}

__device__ __forceinline__ void transpose_item64(const float* W, int ldw, int col0, int K, int N, bf16* WT, int row_off, int row_mul, int row_add, LAS float* scr, int item, int lane) {
    const int nblk = N / 64, kb = item / nblk, nb = item % nblk, k0 = 64 * kb, n0 = 64 * nb;
    const int lr = lane >> 4, c4 = (lane & 15) * 4;
    const float* src = W + (size_t)(k0 + lr) * ldw + col0 + n0 + c4;
    f32x4 v[16];
#pragma unroll
    for (int i = 0; i < 16; ++i) v[i] = *(const f32x4*)(src + (size_t)(4 * i) * ldw);
#pragma unroll
    for (int i = 0; i < 16; ++i) { LAS float* d = scr + (4 * i + lr) * 65 + c4; d[0] = v[i].x; d[1] = v[i].y; d[2] = v[i].z; d[3] = v[i].w; }
    LDS_WAIT(); asm volatile("" ::: "memory");
    const int c = lane & 7;
#pragma unroll
    for (int j = 0; j < 8; ++j) { const int n = (lane >> 3) + 8 * j; const LAS float* t = scr + (8 * c) * 65 + n;
        u32x4 o; o.x = pk2(t[0 * 65], t[1 * 65]); o.y = pk2(t[2 * 65], t[3 * 65]); o.z = pk2(t[4 * 65], t[5 * 65]); o.w = pk2(t[6 * 65], t[7 * 65]);
        *(u32x4*)(WT + (size_t)(row_off + (n0 + n) * row_mul + row_add) * K + k0 + 8 * c) = o; }
    LDS_WAIT(); asm volatile("" ::: "memory");
}

__device__ __forceinline__ void phase_prologue(Frame& F, const Args& a) {
    const int gw = F.bid * 8 + F.wave, NGW = F.G * 8;
    const int gt = F.bid * 512 + F.tid, NGT = F.G * 512;
    LAS float* scr = (LAS float*)(F.lds + F.wave * 16640);
    {
        constexpr int I_QKV = 16 * 48, I_Z = 16 * 16, I_G = 16 * 32, I_AB = 16, I_F = 16 * 8, I_SQ = 16 * 16;
        constexpr int PER_LAYER = I_QKV + I_Z + I_G + I_AB + I_F + 2 * I_SQ;
        for (int it = gw; it < DEPTH * PER_LAYER; it += NGW) {
            const int layer = it / PER_LAYER; int r = it % PER_LAYER;
            const float* win = inp(F, I_WIN) + (size_t)layer * D * IN_COLS;
            bf16* wt = WSP(bf16, WS_WIN) + (size_t)layer * WIN_ROWS * D;
            if (r < I_QKV) { transpose_item64(win, IN_COLS, 0, D, 3072, wt, 0, 1, 0, scr, r, F.lane); continue; } r -= I_QKV;
            if (r < I_Z)   { transpose_item64(win, IN_COLS, OFF_Z, D, 1024, wt, PM_Z, 1, 0, scr, r, F.lane); continue; } r -= I_Z;
            if (r < I_G)   { transpose_item64(win, IN_COLS, OFF_G, D, 2048, wt, PM_GA, 1, 0, scr, r, F.lane); continue; } r -= I_G;
            if (r < I_AB)  { transpose_item(win, IN_COLS, OFF_A, D, 32, wt, PM_AB, 1, 0, scr, r, F.lane); continue; } r -= I_AB;
            if (r < I_F)   { transpose_item64(win, IN_COLS, OFF_F, D, 512, wt, PM_LD, 1, 0, scr, r, F.lane); continue; } r -= I_F;
            if (r < I_SQ)  { transpose_item64(inp(F, I_WDL) + (size_t)layer * D * D, D, 0, D, D, WSP(bf16, WS_WDL) + (size_t)layer * D * D, 0, 1, 0, scr, r, F.lane); continue; } r -= I_SQ;
            transpose_item64(inp(F, I_WOUT) + (size_t)layer * D * D, D, 0, D, D, WSP(bf16, WS_WOUT) + (size_t)layer * D * D, 0, 1, 0, scr, r, F.lane);
        }
        for (int i = gt; i < DEPTH * 224 * (D / 8); i += NGT) { const int layer = i / (224 * 128), rr = i % (224 * 128);
            *(u32x4*)(WSP(bf16, WS_WIN) + ((size_t)layer * WIN_ROWS + 6176) * D + (size_t)rr * 8) = (u32x4){0u, 0u, 0u, 0u}; }
    }
    {
        LAS float* tb = (LAS float*)(F.lds + 8 * 16640);
        if (F.tid < 128) { tb[F.tid] = cospif((float)F.tid / 64.f); tb[128 + F.tid] = -sinpif((float)F.tid / 64.f); }
        __syncthreads();
        for (int it = gw; it < DEPTH * 4 * 2 * 16 * 4; it += NGW) {
            const int cb = it & 3, nb = (it >> 2) & 15, ri = (it >> 6) & 1, g = (it >> 7) & 3, layer = it >> 9;
            const int n = nb * 64 + F.lane;
            const float* wf = inp(F, I_WF) + ((size_t)layer * 512 + g * 128) * D + n;
            float o[32];
#pragma unroll
            for (int q = 0; q < 32; ++q) o[q] = 0.f;
#pragma unroll 4
            for (int cp = 0; cp < 128; ++cp) { const float w = wf[(size_t)cp * D];
#pragma unroll
                for (int q = 0; q < 32; ++q) o[q] += tb[ri * 128 + (((cb * 32 + q) * cp) & 127)] * w; }
            bf16* dst = WSP(bf16, WS_WPA) + ((size_t)layer * D + n) * D + g * 256 + ri * 128 + cb * 32;
#pragma unroll
            for (int q8 = 0; q8 < 4; ++q8) { const float sc_ = 0.08838834764831845f;
                *(u32x4*)(dst + q8 * 8) = (u32x4){pk2(o[q8 * 8] * sc_, o[q8 * 8 + 1] * sc_), pk2(o[q8 * 8 + 2] * sc_, o[q8 * 8 + 3] * sc_), pk2(o[q8 * 8 + 4] * sc_, o[q8 * 8 + 5] * sc_), pk2(o[q8 * 8 + 6] * sc_, o[q8 * 8 + 7] * sc_)}; }
        }
        __syncthreads();
    }
    {
        LAS float* ct = (LAS float*)F.lds;
        for (int m = F.tid; m < 4096; m += 512) ct[m] = cospif((float)m / 2048.f) * (1.f / 64.f);
        __syncthreads();
        for (int i = gt; i < 4096 * 512; i += NGT) { const int row = i >> 9, t0 = (i & 511) * 8, ri = row >> 11, tp = row & 2047; float v[8];
#pragma unroll
            for (int q = 0; q < 8; ++q) v[q] = ct[((t0 + q) * tp - ri * 1024) & 4095];
            *(u32x4*)(WSP(bf16, WS_DFTL) + (size_t)row * 4096 + t0) = (u32x4){pk2(v[0], v[1]), pk2(v[2], v[3]), pk2(v[4], v[5]), pk2(v[6], v[7])}; }
        for (int i = gt; i < 512 * 32; i += NGT) { const int row = i >> 5, t0 = (i & 31) * 8, ri = row >> 8, tp = row & 255; float v[8];
#pragma unroll
            for (int q = 0; q < 8; ++q) v[q] = ct[((((t0 + q) * tp) & 255) * 16 - ri * 1024) & 4095] * 4.f;
            *(u32x4*)(WSP(bf16, WS_DFTC) + (size_t)row * 256 + t0) = (u32x4){pk2(v[0], v[1]), pk2(v[2], v[3]), pk2(v[4], v[5]), pk2(v[6], v[7])}; }
        __syncthreads();
    }
    { const f32x4* pc_ = (const f32x4*)inp(F, I_CTX); const f32x4* px_ = (const f32x4*)inp(F, I_X);
    for (size_t i = gt; i < (size_t)NTOK * D / 4; i += NGT) {
        const f32x4 v = (i < (size_t)NCTX * D / 4) ? pc_[i] : px_[i - (size_t)NCTX * D / 4];
        WSP(f32x4, WS_X)[i] = v; } }
    {
        LAS float* sc = (LAS float*)(F.lds + 0);
        { const float* pc_ = inp(F, I_C); const float* pcc_ = inp(F, I_CCTX);
        for (int i = F.tid; i < 9 * 1024; i += 512) { const float v = (i < 8192) ? pc_[i] : pcc_[i - 8192]; sc[i] = siluf_(v); } }
        __syncthreads();
        LAS float* red = sc + 9 * 1024;
        for (int it = F.bid; it < DEPTH * 192; it += F.G) {
            const int layer = it / 192, cb = it % 192, col = cb * 32 + (F.lane & 31), kp = F.lane >> 5;
            const float* wm = inp(F, I_WMOD) + (size_t)layer * D * 6144 + col;
            float acc[9];
#pragma unroll
            for (int r = 0; r < 9; ++r) acc[r] = 0.f;
#pragma unroll 16
            for (int k = F.wave * 128 + kp; k < F.wave * 128 + 128; k += 2) { const float w = wm[(size_t)k * 6144];
#pragma unroll
                for (int r = 0; r < 9; ++r) acc[r] += sc[r * 1024 + k] * w; }
#pragma unroll
            for (int r = 0; r < 9; ++r) acc[r] += __shfl_xor(acc[r], 32);
            if (kp == 0) {
#pragma unroll
                for (int r = 0; r < 9; ++r) red[(F.wave * 9 + r) * 32 + F.lane] = acc[r]; }
            __syncthreads();
            if (F.tid < 9 * 32) { const int r = F.tid >> 5, c = F.tid & 31; float t = inp(F, I_BMOD)[layer * 6144 + cb * 32 + c];
#pragma unroll
                for (int w = 0; w < 8; ++w) t += red[(w * 9 + r) * 32 + c];
                WSP(float, WS_MOD)[((size_t)layer * 9 + r) * 6144 + cb * 32 + c] = t; }
            __syncthreads();
        }
        __syncthreads();
    }
}

__device__ __forceinline__ void moe_weight_convert(Frame& F, int layer, bool down, int wg0, LAS float* scr) {
    if (F.bid < wg0) return;
    const int gw = (F.bid - wg0) * 8 + F.wave, NGW = (F.G - wg0) * 8;
    if (down) {
        for (int it = gw; it < NEXP * 128; it += NGW) { const int e = it >> 7, r = it & 127;
            transpose_item64(inp(F, I_WD) + ((size_t)layer * NEXP + e) * (size_t)D * EDIM, D, 0, EDIM, D, WSP(bf16, WS_MOEWD) + (size_t)e * 1024 * 512, 0, 1, 0, scr, r, F.lane); }
    } else {
        for (int it = gw; it < NEXP * 256; it += NGW) { const int e = it >> 8, r = it & 255;
            transpose_item64(inp(F, r < 128 ? I_WG : I_WU) + ((size_t)layer * NEXP + e) * (size_t)D * EDIM, EDIM, 0, D, EDIM, WSP(bf16, WS_MOEW) + (size_t)e * 1024 * 1024, 0, 2, r < 128 ? 0 : 1, scr, r & 127, F.lane); }
    }
}

__device__ __forceinline__ int mod_row(int row) { return row < NCTX ? 8 : ((row - NCTX) >> 12); }

__device__ __forceinline__ void build_moe_tables(Frame& F, int layer);
template <int MODE, bool COMBINE>
__device__ __forceinline__ void phase_norm(Frame& F, const Args& a, int layer, float out_scale = 1.f) {
    const int gw = F.bid * 8 + F.wave, NGW = F.G * 8;
    const f32x4* fwp = (const f32x4*)inp(F, MODE == 1 ? I_FNORM : I_NMIX) + (MODE == 1 ? 0 : layer * 256) + F.lane; f32x4* outp = (f32x4*)inp(F, 24);
    int so_all = 0; float cb_all = 0.f;
    if (COMBINE) {
        const int rr = gw + (F.lane >> 1) * NGW; if (rr < NTOK) { so_all = (int)F.LCTL[16 + WSP(int, WS_ROUTE)[rr * 2 + (F.lane & 1)]] + WSP(int, WS_ROUTE + 2 * NTOK * 8)[rr * 2 + (F.lane & 1)]; cb_all = WSP(float, WS_ROUTE + NTOK * 8)[rr * 2 + (F.lane & 1)]; } }
    f32x4 nwv[4];
#pragma unroll
    for (int j = 0; j < 4; ++j) nwv[j] = fwp[64 * j];
    f32x4 nx[4], ng2[4], nsh[4], nsc[4]; u32x2 ny0[4], ny1[4];
#define NORM_LOAD(row_, it_) do { const f32x4* xr_ = WSP(f32x4, WS_X) + (size_t)(row_) * 256 + F.lane; const int mb_ = mod_row(row_); \
        _Pragma("unroll") for (int j = 0; j < 4; ++j) nx[j] = xr_[64 * j]; \
        if (COMBINE) { const int li_ = __builtin_amdgcn_readfirstlane(2 * (it_)); const int s0_ = __builtin_amdgcn_readlane(so_all, li_), s1_ = __builtin_amdgcn_readlane(so_all, li_ + 1); \
            const u32x2* y0_ = WSP(u32x2, WS_YS) + (size_t)s0_ * 256 + F.lane; const u32x2* y1_ = WSP(u32x2, WS_YS) + (size_t)s1_ * 256 + F.lane; \
            const f32x4* g2_ = WSP(f32x4, WS_MOD) + ((size_t)(layer - 1) * 9 + mb_) * 1536 + 5 * 256 + F.lane; \
            _Pragma("unroll") for (int j = 0; j < 4; ++j) { ny0[j] = y0_[64 * j]; ny1[j] = y1_[64 * j]; ng2[j] = g2_[64 * j]; } } \
        if (MODE == 0) { const f32x4* sh_ = WSP(f32x4, WS_MOD) + ((size_t)layer * 9 + mb_) * 1536 + 0 * 256 + F.lane; \
            _Pragma("unroll") for (int j = 0; j < 4; ++j) { nsh[j] = sh_[64 * j]; nsc[j] = sh_[256 + 64 * j]; } } } while (0)
    if (gw < NTOK) NORM_LOAD(gw, 0);
    int it = 0;
    for (int row = gw; row < NTOK; row += NGW, ++it) {
        f32x4* xr = WSP(f32x4, WS_X) + (size_t)row * 256 + F.lane;
        f32x4 v[4], g2[4], sh[4], sc[4]; u32x2 y0[4], y1[4];
#pragma unroll
        for (int j = 0; j < 4; ++j) { v[j] = nx[j]; if (COMBINE) { y0[j] = ny0[j]; y1[j] = ny1[j]; g2[j] = ng2[j]; } if (MODE == 0) { sh[j] = nsh[j]; sc[j] = nsc[j]; } }
        if (row + NGW < NTOK) NORM_LOAD(row + NGW, it + 1);
        if (COMBINE) {
            const int li = __builtin_amdgcn_readfirstlane(2 * it); const float c0 = __builtin_bit_cast(float, __builtin_amdgcn_readlane(__builtin_bit_cast(int, cb_all), li)), c1 = __builtin_bit_cast(float, __builtin_amdgcn_readlane(__builtin_bit_cast(int, cb_all), li + 1));
#pragma unroll
            for (int j = 0; j < 4; ++j) { const u32x2 p = y0[j], q = y1[j]; const f32x4 g = g2[j];
                v[j].x += g.x * (c0 * bf_lo(p.x) + c1 * bf_lo(q.x)); v[j].y += g.y * (c0 * bf_hi(p.x) + c1 * bf_hi(q.x));
                v[j].z += g.z * (c0 * bf_lo(p.y) + c1 * bf_lo(q.y)); v[j].w += g.w * (c0 * bf_hi(p.y) + c1 * bf_hi(q.y));
                if (MODE == 0) xr[64 * j] = v[j]; }
        }
        float ss = 0.f;
#pragma unroll
        for (int j = 0; j < 4; ++j) ss += (v[j].x * v[j].x + v[j].y * v[j].y) + (v[j].z * v[j].z + v[j].w * v[j].w);
        const float r = rsqrtf(wave_sum(ss) * (1.f / 1024.f) + EPS);
        if (MODE == 1) {
            if (row >= NCTX) { f32x4* o = outp + (size_t)(row - NCTX) * 256 + F.lane;
#pragma unroll
                for (int j = 0; j < 4; ++j) o[64 * j] = v[j] * (r * out_scale) * nwv[j]; }
        } else {
            u32x2* ho = WSP(u32x2, WS_H) + (size_t)row * 256 + F.lane;
#pragma unroll
            for (int j = 0; j < 4; ++j) { const f32x4 h = v[j] * r * nwv[j] * (sc[j] + 1.f) + sh[j];
                ho[64 * j] = (u32x2){pk2(h.x, h.y), pk2(h.z, h.w)}; }
        }
    }
#undef NORM_LOAD
}

__device__ __forceinline__ void ffn_load(Frame& F, int layer, int row, f32x4 (&v)[4], f32x4 (&sh)[4], f32x4 (&sc)[4]) {
    const f32x4* xr = WSP(f32x4, WS_X) + (size_t)row * 256 + F.lane;
    const f32x4* shp = WSP(f32x4, WS_MOD) + ((size_t)layer * 9 + mod_row(row)) * 1536 + 3 * 256 + F.lane;
#pragma unroll
    for (int j = 0; j < 4; ++j) { v[j] = xr[64 * j]; sh[j] = shp[64 * j]; sc[j] = shp[256 + 64 * j]; }
}
__device__ __forceinline__ void ffn_row(const f32x4 (&nw)[4], const f32x4 (&v)[4], const f32x4 (&sh)[4], const f32x4 (&sc)[4], f32x4 (&h)[4]) {
    float ss = 0.f;
#pragma unroll
    for (int j = 0; j < 4; ++j) ss += (v[j].x * v[j].x + v[j].y * v[j].y) + (v[j].z * v[j].z + v[j].w * v[j].w);
    const float r = rsqrtf(wave_sum(ss) * (1.f / 1024.f) + EPS);
#pragma unroll
    for (int j = 0; j < 4; ++j) h[j] = v[j] * r * nw[j] * (sc[j] + 1.f) + sh[j];
}

__device__ __forceinline__ void route_table_fill(Frame& F, int layer) {
    LAS float* wl = (LAS float*)F.lds;
    const float* wrg = inp(F, I_WRG) + (size_t)layer * D * 4; const float* wre = inp(F, I_WRE) + (size_t)layer * D * 32;
    {
        f32x4 rb[5][4];
#pragma unroll
        for (int q = 0; q < 4; ++q) { const int bI = F.tid + 512 * q, kq = bI >> 3, jq = bI & 7;
#pragma unroll
            for (int r = 0; r < 4; ++r) rb[q][r] = *(const f32x4*)(wre + (size_t)(4 * kq + r) * 32 + 4 * jq); }
        if (F.tid < 256) {
#pragma unroll
            for (int r = 0; r < 4; ++r) rb[4][r] = *(const f32x4*)(wrg + (size_t)(4 * F.tid + r) * 4); }
#pragma unroll
        for (int q = 0; q < 4; ++q) { const int bI = F.tid + 512 * q, kq = bI >> 3, jq = bI & 7;
#pragma unroll
            for (int c = 0; c < 4; ++c) *(LAS f32x4*)(wl + (kq * 37 + 4 + 4 * jq + c) * 4) = (f32x4){rb[q][0][c], rb[q][1][c], rb[q][2][c], rb[q][3][c]}; }
        if (F.tid < 256) {
#pragma unroll
            for (int c = 0; c < 4; ++c) *(LAS f32x4*)(wl + (F.tid * 37 + c) * 4) = (f32x4){rb[4][0][c], rb[4][1][c], rb[4][2][c], rb[4][3][c]}; }
    }
}
__device__ __forceinline__ void phase_route(Frame& F, const Args& a, int layer, bool dry) {
    const int gw = F.bid * 8 + F.wave, NGW = F.G * 8;
    LAS float* wl = (LAS float*)F.lds;
    volatile LAS unsigned* cl = F.LCTL + 64;
    if (F.tid < 32) cl[F.tid] = 0u;
    __syncthreads();
    const float* brg = inp(F, I_BRG) + layer * 4; const float* bre = inp(F, I_BRE) + layer * 32;
    const f32x4* nwp = (const f32x4*)(inp(F, I_NFFN) + layer * D) + F.lane;
    f32x4 nx[4], nsh[4], nsc[4], nwv[4]; int my_e = 0, my_lr = 0, it = 0;
    const f32x4 brgv = *(const f32x4*)brg; const int brel = __builtin_bit_cast(int, bre[F.lane & 31]);
#pragma unroll
    for (int j = 0; j < 4; ++j) nwv[j] = nwp[64 * j];
    if (gw < NTOK) ffn_load(F, layer, gw, nx, nsh, nsc);
    for (int row = gw; row < NTOK; row += NGW) {
        f32x4 xv[4], shv[4], scv[4];
#pragma unroll
        for (int j = 0; j < 4; ++j) { xv[j] = nx[j]; shv[j] = nsh[j]; scv[j] = nsc[j]; }
        if (row + NGW < NTOK) ffn_load(F, layer, row + NGW, nx, nsh, nsc);
        f32x4 h[4]; ffn_row(nwv, xv, shv, scv, h);
        float lg[4];
#pragma unroll
        for (int g = 0; g < 4; ++g) { float s = 0.f;
#pragma unroll
            for (int j = 0; j < 4; ++j) { const f32x4 w = *(const LAS f32x4*)(wl + ((F.lane + 64 * j) * 37 + g) * 4); s += (h[j].x * w.x + h[j].y * w.y) + (h[j].z * w.z + h[j].w * w.w); }
            lg[g] = wave_sum(s) + brgv[g]; }
        int grp = 0; float mx = lg[0];
#pragma unroll
        for (int g = 1; g < 4; ++g) if (lg[g] > mx) { mx = lg[g]; grp = g; }
        float den = 0.f;
#pragma unroll
        for (int g = 0; g < 4; ++g) den += __expf(lg[g] - mx);
        const float pgrp = 1.f / den;
        float le[8]; const int grp8 = __builtin_amdgcn_readfirstlane(grp * 8);
#pragma unroll
        for (int e = 0; e < 8; ++e) { float s = 0.f;
#pragma unroll
            for (int j = 0; j < 4; ++j) { const f32x4 w = *(const LAS f32x4*)(wl + ((F.lane + 64 * j) * 37 + 4 + grp * 8 + e) * 4); s += (h[j].x * w.x + h[j].y * w.y) + (h[j].z * w.z + h[j].w * w.w); }
            le[e] = wave_sum(s) + __builtin_bit_cast(float, __builtin_amdgcn_readlane(brel, grp8 + e)); }
        int i0 = 0; float v0 = le[0];
#pragma unroll
        for (int e = 1; e < 8; ++e) if (le[e] > v0) { v0 = le[e]; i0 = e; }
        int i1 = -1; float v1 = -3.0e38f;
#pragma unroll
        for (int e = 0; e < 8; ++e) if (e != i0 && le[e] > v1) { v1 = le[e]; i1 = e; }
        const float e1 = __expf(v1 - v0), inv = 1.f / (1.f + e1);
        {
            u32x2* ho = WSP(u32x2, WS_H) + (size_t)row * 256 + F.lane;
#pragma unroll
            for (int j = 0; j < 4; ++j) ho[64 * j] = (u32x2){pk2(h[j].x, h[j].y), pk2(h[j].z, h[j].w)};
        }
        int lr0 = 0, lr1 = 0;
        if (F.lane == 0) {
            float* cb = WSP(float, WS_ROUTE + NTOK * 8) + row * 2; cb[0] = pgrp * inv; cb[1] = pgrp * e1 * inv;
            lr0 = (int)__hip_atomic_fetch_add((LAS unsigned*)(cl + grp * 8 + i0), 1u, __ATOMIC_RELAXED, __HIP_MEMORY_SCOPE_WORKGROUP);
            lr1 = (int)__hip_atomic_fetch_add((LAS unsigned*)(cl + grp * 8 + i1), 1u, __ATOMIC_RELAXED, __HIP_MEMORY_SCOPE_WORKGROUP);
        }
        lr0 = __builtin_amdgcn_readfirstlane(lr0); lr1 = __builtin_amdgcn_readfirstlane(lr1);
        if (F.lane == 2 * it) { my_e = grp * 8 + i0; my_lr = lr0; }
        if (F.lane == 2 * it + 1) { my_e = grp * 8 + i1; my_lr = lr1; }
        ++it;
    }
    __syncthreads();
    if (dry) return;
    if (F.tid < 32) { const unsigned c = cl[F.tid]; F.LCTL[96 + F.tid] = c ? atomicAdd(WSP(unsigned, WS_CTL) + CW_CNT + layer * 64 + F.tid, c) : 0u; }
    if (F.bid == 0) { for (int i = F.tid; i < 512; i += 512) WSP(unsigned, WS_XS)[i] = 0u; }
    __syncthreads();
    { const int row = gw + (F.lane >> 1) * NGW;
      if (F.lane < 36 && row < NTOK) { const int rank = (int)F.LCTL[96 + my_e] + my_lr;
          WSP(int, WS_ROUTE)[row * 2 + (F.lane & 1)] = my_e; WSP(int, WS_ROUTE + 2 * NTOK * 8)[row * 2 + (F.lane & 1)] = rank;
          WSP(int, WS_TOKOF)[(size_t)my_e * NTOK + rank] = row; } }
}

__device__ __forceinline__ void build_moe_tables(Frame& F, int layer) {
    if (F.tid < 64) {
        const int e = F.tid & 31;
        const unsigned c = __hip_atomic_load(WSP(unsigned, WS_CTL) + CW_CNT + layer * 64 + e, __ATOMIC_RELAXED, __HIP_MEMORY_SCOPE_AGENT);
        const unsigned nt = (c + 255u) >> 8;
        unsigned incl = nt;
#pragma unroll
        for (int o = 1; o < 32; o <<= 1) { const unsigned v = __shfl_up(incl, o, 32); if (e >= o) incl += v; }
        const unsigned excl = incl - nt;
        if (F.tid < 32) {
            F.LCTL[16 + e] = excl << 8; F.LCTL[64 + e] = c;
            for (unsigned t = 0; t < nt; ++t) F.LCTL[128 + excl + t] = (unsigned)e;
            if (e == NEXP - 1) F.LCTL[16 + NEXP] = incl << 8;
        }
    }
    __syncthreads();
}

template <int NSTEP, bool dry>
__device__ __forceinline__ void conv_wave_unit(Frame& F, int tok0, int slab) {
    int lane_ = F.lane; asm volatile("" : "+v"(lane_));
    const int lane = lane_, rg = lane >> 3, cc = lane & 7, c0l = cc * 16, c0 = slab * 128 + c0l;
    const int sect = slab >> 3, head = slab & 7;
    const LAS float* wl = (const LAS float*)F.lds + c0;
    u32x4 carry[2] = {(u32x4){0u, 0u, 0u, 0u}, (u32x4){0u, 0u, 0u, 0u}};
#pragma unroll
    for (int p = 0; p < NSTEP; ++p) {
        unsigned ob[2][4][8];
#pragma unroll
        for (int hs = 0; hs < 2; ++hs) {
            const int rb = tok0 + 64 * p + 32 * hs + 4 * rg;
            u32x4 in[6][2];
            const bf16* pr = WSP(bf16, WS_PM) + (size_t)(rb - 1) * PM_LD + c0;
#pragma unroll
            for (int i = 0; i < 6; ++i) { const int row = rb - 1 + i; const bool ok = (row >= tok0) && (row < tok0 + 64 * NSTEP) && !(NSTEP > 1 && p > 0 && hs == 0 && i == 0 && rg == 0);
                if (ok) { in[i][0] = *(const u32x4*)pr; in[i][1] = *(const u32x4*)(pr + 8); } else { in[i][0] = in[i][1] = (u32x4){0u, 0u, 0u, 0u}; }
                pr += PM_LD; asm volatile("" : "+v"(pr)); }
            if (NSTEP > 1 && p > 0 && hs == 0 && rg == 0) { in[0][0] = carry[0]; in[0][1] = carry[1]; }
            if (NSTEP > 1 && p + 1 < NSTEP && hs == 1) {
#pragma unroll
                for (int hq = 0; hq < 2; ++hq) { carry[hq].x = __shfl(in[4][hq].x, 56 + cc); carry[hq].y = __shfl(in[4][hq].y, 56 + cc); carry[hq].z = __shfl(in[4][hq].z, 56 + cc); carry[hq].w = __shfl(in[4][hq].w, 56 + cc); } }
            float xw[3][16];
#define CONV_UNPACK(dst, src) do { _Pragma("unroll") for (int q = 0; q < 16; ++q) { const unsigned w_ = src[q >> 3][(q >> 1) & 3]; dst[q] = (q & 1) ? bf_hi(w_) : bf_lo(w_); } } while (0)
            CONV_UNPACK(xw[0], in[0]); CONV_UNPACK(xw[1], in[1]);
#pragma unroll
            for (int i = 0; i < 4; ++i) {
                CONV_UNPACK(xw[(i + 2) % 3], in[i + 2]);
                float y[16]; float ss = 0.f;
#pragma unroll
                for (int q4 = 0; q4 < 4; ++q4) { const f32x4 a0 = *(const LAS f32x4*)(wl + 4 * q4), a1 = *(const LAS f32x4*)(wl + 3072 + 4 * q4), a2 = *(const LAS f32x4*)(wl + 6144 + 4 * q4);
#pragma unroll
                    for (int e = 0; e < 4; ++e) { const int q = 4 * q4 + e; const float sv = siluf_(a0[e] * xw[i % 3][q] + a1[e] * xw[(i + 1) % 3][q] + a2[e] * xw[(i + 2) % 3][q]); y[q] = sv; ss += sv * sv; } }
                if (sect < 2) { ss = sum8(ss);
                    const float sc = rsqrtf(ss + EPS) * (sect == 0 ? 0.08838834764831845f : 1.f);
#pragma unroll
                    for (int q = 0; q < 16; ++q) y[q] *= sc; }
#pragma unroll
                for (int d = 0; d < 8; ++d) ob[hs][i][d] = pk2(y[2 * d], y[2 * d + 1]);
                __builtin_amdgcn_sched_barrier(0);
            }
#undef CONV_UNPACK
            asm volatile("s_waitcnt vmcnt(0)" ::: "memory");
        }
        if (sect < 2) {
#pragma unroll
            for (int hs = 0; hs < 2; ++hs) { const int row0 = tok0 + 64 * p + 32 * hs + 4 * rg;
                bf16* pw = dry ? WSP(bf16, WS_OF) + (size_t)row0 * 2048 + c0 : WSP(bf16, WS_PM) + (size_t)row0 * PM_LD + c0;
#pragma unroll
                for (int i = 0; i < 4; ++i) {
                    *(u32x4*)pw = (u32x4){ob[hs][i][0], ob[hs][i][1], ob[hs][i][2], ob[hs][i][3]}; *(u32x4*)(pw + 8) = (u32x4){ob[hs][i][4], ob[hs][i][5], ob[hs][i][6], ob[hs][i][7]};
                    pw += dry ? 2048 : PM_LD; asm volatile("" : "+v"(pw)); } }
        }
        if (sect > 0) {
            const int chunk = (tok0 >> 6) + p;
            bf16* tp = (sect == 1) ? (dry ? WSP(bf16, WS_PBUF) : WSP(bf16, WS_KT)) + ((size_t)(chunk * 8 + head) * 128 + c0l) * 64 + 4 * rg
                                   : (dry ? WSP(bf16, WS_H) + (size_t)(chunk * 64 + (c0l >> 1)) * 1024 + head * 128 + 4 * rg
                                          : WSP(bf16, WS_PM) + (size_t)(chunk * 64 + (c0l >> 1)) * PM_LD + 2048 + head * 128 + 4 * rg);
            const int pstep = (sect == 1) ? 128 : (dry ? 1024 : PM_LD);
#pragma unroll
            for (int d = 0; d < 8; ++d) {
#pragma unroll
                for (int e = 0; e < 2; ++e) { const unsigned sel = e ? 0x07060302u : 0x05040100u;
#pragma unroll
                    for (int hs = 0; hs < 2; ++hs) {
                        const u32x2 o = (u32x2){__builtin_amdgcn_perm(ob[hs][1][d], ob[hs][0][d], sel), __builtin_amdgcn_perm(ob[hs][3][d], ob[hs][2][d], sel)};
                        *(u32x2*)(tp + e * 64 + 32 * hs) = o; } }
                tp += pstep; asm volatile("" : "+v"(tp));
            }
        }
        asm volatile("" ::: "memory");
    }
}
#define CONV_UNPACK(dst, src) do { dst[0] = bf_lo(src.x); dst[1] = bf_hi(src.x); dst[2] = bf_lo(src.y); dst[3] = bf_hi(src.y); dst[4] = bf_lo(src.z); dst[5] = bf_hi(src.z); dst[6] = bf_lo(src.w); dst[7] = bf_hi(src.w); } while (0)
template <int HS>
__device__ __forceinline__ void conv_load(Frame& F, u32x4 (&in)[10], int tok0, int c0, int rg) {
    const GAS bf16* pr = WSG(bf16, WS_PM) + (size_t)(tok0 + 32 * HS + 8 * rg - 1) * PM_LD + c0;
#pragma unroll
    for (int i = 0; i < 10; ++i) {
        const bool ok = (i == 0) ? (rg != 0) : ((i == 9 && HS == 1) ? (rg != 3) : true);
        if (ok) in[i] = *(const GAS u32x4*)pr; else in[i] = (u32x4){0u, 0u, 0u, 0u};
        pr += PM_LD; asm volatile("" : "+v"(pr)); }
}
template <int SECT>
__device__ __forceinline__ void conv_half(const u32x4 (&in)[10], const LAS float* wl, GAS bf16* pw, unsigned (&ob)[8][4]) {
    float xw[3][8];
    f32x4 wt[3][2];
#pragma unroll
    for (int k = 0; k < 3; ++k)
#pragma unroll
        for (int q4 = 0; q4 < 2; ++q4) wt[k][q4] = *(const LAS f32x4*)(wl + 3072 * k + 4 * q4);
    CONV_UNPACK(xw[0], in[0]); CONV_UNPACK(xw[1], in[1]);
#pragma unroll
    for (int i = 0; i < 8; ++i) {
        CONV_UNPACK(xw[(i + 2) % 3], in[i + 2]);
        float y[8]; float ss = 0.f;
#pragma unroll
        for (int q = 0; q < 8; ++q) { const float sv = siluf_(wt[0][q >> 2][q & 3] * xw[i % 3][q] + wt[1][q >> 2][q & 3] * xw[(i + 1) % 3][q] + wt[2][q >> 2][q & 3] * xw[(i + 2) % 3][q]); y[q] = sv; ss += sv * sv; }
        if (SECT < 2) { ss = sum16(ss);
            const float sc = rsqrtf(ss + EPS) * (SECT == 0 ? 0.08838834764831845f : 1.f);
#pragma unroll
            for (int q = 0; q < 8; ++q) y[q] *= sc; }
#pragma unroll
        for (int d = 0; d < 4; ++d) ob[i][d] = pk2(y[2 * d], y[2 * d + 1]);
        if (SECT < 2) { *(GAS u32x4*)pw = (u32x4){ob[i][0], ob[i][1], ob[i][2], ob[i][3]}; pw += PM_LD; asm volatile("" : "+v"(pw)); }
        __builtin_amdgcn_sched_barrier(0);
    }
}
__device__ __forceinline__ void conv_tstore(const unsigned (&ob)[8][4], GAS bf16* tp, int pstep) {
#pragma unroll
    for (int d = 0; d < 4; ++d) {
#pragma unroll
        for (int e = 0; e < 2; ++e) { const unsigned sel = e ? 0x07060302u : 0x05040100u;
            *(GAS u32x4*)(tp + e * 64) = (u32x4){__builtin_amdgcn_perm(ob[1][d], ob[0][d], sel), __builtin_amdgcn_perm(ob[3][d], ob[2][d], sel), __builtin_amdgcn_perm(ob[5][d], ob[4][d], sel), __builtin_amdgcn_perm(ob[7][d], ob[6][d], sel)}; }
        tp += pstep; asm volatile("" : "+v"(tp)); __builtin_amdgcn_sched_barrier(0); }
}
__device__ __forceinline__ void conv_latent(Frame& F) {
    int lane_ = F.lane; asm volatile("" : "+v"(lane_));
    const int lane = lane_, rg = lane >> 4, cc = lane & 15, c0l = cc * 8;
    const int gw = F.wave * F.G + F.bid, NGW = F.G * 8;
    int t = gw; if (t >= 512 * 8) return;
    u32x4 A[10], B[10];
    conv_load<0>(F, A, NCTX + (t >> 3) * 64, (t & 7) * 128 + c0l, rg);
#define CONV_NEXT(t_) ((t_) + NGW + (((t_) + NGW >= NGW && (t_) + NGW < NGW + 192) ? NGW : 0))
#pragma nounroll
    for (; t < 512 * 8; t = CONV_NEXT(t)) {
        int cq_ = (t & 7) * 128 + c0l; asm volatile("" : "+v"(cq_));
        const int tok0 = NCTX + (t >> 3) * 64, head = t & 7, chunk = tok0 >> 6, cq = cq_;
        const int tn = CONV_NEXT(t); const bool more = tn < 512 * 8; const int ntok0 = NCTX + (tn >> 3) * 64, ncq = (tn & 7) * 128 + c0l;
        u32x4 carry; unsigned o0[8][4], o1[8][4];
#define CONV_CARRY() do { carry.x = __shfl(A[8].x, 48 + cc); carry.y = __shfl(A[8].y, 48 + cc); carry.z = __shfl(A[8].z, 48 + cc); carry.w = __shfl(A[8].w, 48 + cc); } while (0)
#define CONV_APPLY() do { if (rg == 0) B[0] = carry; } while (0)
        conv_load<1>(F, B, tok0, cq, rg); CONV_CARRY(); __builtin_amdgcn_sched_barrier(0);
        conv_half<0>(A, (const LAS float*)F.lds + cq, WSG(bf16, WS_PM) + (size_t)(tok0 + 8 * rg) * PM_LD + cq, o0);
        conv_load<0>(F, A, tok0, 1024 + cq, rg); __builtin_amdgcn_sched_barrier(0);
        CONV_APPLY();
        conv_half<0>(B, (const LAS float*)F.lds + cq, WSG(bf16, WS_PM) + (size_t)(tok0 + 32 + 8 * rg) * PM_LD + cq, o1);
        conv_load<1>(F, B, tok0, 1024 + cq, rg); CONV_CARRY(); __builtin_amdgcn_sched_barrier(0);
        conv_half<1>(A, (const LAS float*)F.lds + 1024 + cq, WSG(bf16, WS_PM) + (size_t)(tok0 + 8 * rg) * PM_LD + 1024 + cq, o0);
        conv_tstore(o0, WSG(bf16, WS_KT) + ((size_t)(chunk * 8 + head) * 128 + c0l) * 64 + 8 * rg, 128);
        conv_load<0>(F, A, tok0, 2048 + cq, rg); __builtin_amdgcn_sched_barrier(0);
        CONV_APPLY();
        conv_half<1>(B, (const LAS float*)F.lds + 1024 + cq, WSG(bf16, WS_PM) + (size_t)(tok0 + 32 + 8 * rg) * PM_LD + 1024 + cq, o1);
        conv_tstore(o1, WSG(bf16, WS_KT) + ((size_t)(chunk * 8 + head) * 128 + c0l) * 64 + 32 + 8 * rg, 128);
        conv_load<1>(F, B, tok0, 2048 + cq, rg); CONV_CARRY(); __builtin_amdgcn_sched_barrier(0);
        conv_half<2>(A, (const LAS float*)F.lds + 2048 + cq, nullptr, o0);
        CONV_APPLY();
        conv_half<2>(B, (const LAS float*)F.lds + 2048 + cq, nullptr, o1);
        if (more) conv_load<0>(F, A, ntok0, ncq, rg);
        __builtin_amdgcn_sched_barrier(0);
        conv_tstore(o0, WSG(bf16, WS_PM) + (size_t)(chunk * 64 + (c0l >> 1)) * PM_LD + 2048 + head * 128 + 8 * rg, PM_LD);
        conv_tstore(o1, WSG(bf16, WS_PM) + (size_t)(chunk * 64 + (c0l >> 1)) * PM_LD + 2048 + head * 128 + 32 + 8 * rg, PM_LD);
#undef CONV_CARRY
#undef CONV_APPLY
    }
#undef CONV_NEXT
}
#undef CONV_UNPACK
__device__ __forceinline__ void conv_taps_fill(Frame& F, int layer) {
    const f32x4* cw = (const f32x4*)(inp(F, I_CONVW) + (size_t)layer * 3 * 3072);
    f32x4 tv[5];
#pragma unroll
    for (int q = 0; q < 5; ++q) { const int i = F.tid + 512 * q; if (i < 3 * 3072 / 4) tv[q] = cw[i]; }
#pragma unroll
    for (int q = 0; q < 5; ++q) { const int i = F.tid + 512 * q; if (i < 3 * 3072 / 4) ((LAS f32x4*)F.lds)[i] = tv[q]; }
}
template <bool dry>
__device__ __forceinline__ void phase_conv(Frame& F, const Args& a, int layer) {
    const float* cw = inp(F, I_CONVW) + (size_t)layer * 3 * 3072;
    (void)cw;
    __syncthreads();
    { const int gw = F.wave * F.G + F.bid, NGW = F.G * 8;
      for (int u = gw; u < 8 * 24; u += NGW) conv_wave_unit<4, dry>(F, (u / 24) * 256, u % 24);
      for (int m = (gw + NGW - 192) % NGW; m < 576; m += NGW) { const int t = NGW + m / 3; if (t < 512 * 8) conv_wave_unit<1, dry>(F, NCTX + (t >> 3) * 64, (m % 3) * 8 + (t & 7)); } }
    if (!dry) conv_latent(F);
    const int gt = F.bid * 512 + F.tid, NGT = F.G * 512;
    const float dtb_ = inp(F, I_DTB)[layer * 16 + (gt & 15)], ea_ = __expf(inp(F, I_ALOG)[layer * 16 + (gt & 15)]);
    for (int i = gt; i < NTOK * 16; i += NGT) { const int tok = i >> 4, dh = i & 15;
        const bf16* p = WSP(bf16, WS_PM) + (size_t)tok * PM_LD + PM_AB;
        const float av = bf2f(p[dh]) + dtb_, bv = bf2f(p[16 + dh]);
        const float sp = av > 20.f ? av : log1pf(__expf(av));
        WSP(float, WS_GB)[(size_t)dh * NTOK + tok] = -ea_ * sp;
        WSP(float, WS_GB)[(size_t)(16 + dh) * NTOK + tok] = sigmoidf_(bv); }
}

typedef float f32x16 __attribute__((ext_vector_type(16)));
#define MFMA32(a, b, c) __builtin_amdgcn_mfma_f32_32x32x16_bf16((a), (b), (c), 0, 0, 0)
__device__ __forceinline__ unsigned pkbf(float a, float b) { const f32x2 v = {a, b}; const bfx2_t r = __builtin_convertvector(v, bfx2_t); return __builtin_bit_cast(unsigned, r); }
__device__ __forceinline__ bf16x8 pack_step(const f32x16& x, int s) {
    const u32x4 p = {pkbf(x[8 * s], x[8 * s + 1]), pkbf(x[8 * s + 2], x[8 * s + 3]), pkbf(x[8 * s + 4], x[8 * s + 5]), pkbf(x[8 * s + 6], x[8 * s + 7])};
    return __builtin_bit_cast(bf16x8, p);
}
__device__ __forceinline__ int crow(int reg, int h) { return (reg & 3) + 8 * (reg >> 2) + 4 * h; }
__device__ __forceinline__ bf16x8 scale8(const u32x4 t, const f32x4 s0, const f32x4 s1) {
    const u32x4 p = {pkbf(bf_lo(t.x) * s0.x, bf_hi(t.x) * s0.y), pkbf(bf_lo(t.y) * s0.z, bf_hi(t.y) * s0.w), pkbf(bf_lo(t.z) * s1.x, bf_hi(t.z) * s1.y), pkbf(bf_lo(t.w) * s1.z, bf_hi(t.w) * s1.w)};
    return __builtin_bit_cast(bf16x8, p);
}

template <int DIR>
__device__ __forceinline__ void prep_unit(Frame& F, int unit, LAS float* wl, bool dry) {
    const int h = (unit >> 1) & 7, c = unit >> 4, tok0 = c * 64, lane = F.lane, r = lane & 31, hh = lane >> 5;
    float* gptr = WSP(float, WS_GB) + (size_t)(DIR * 8 + h) * NTOK + tok0; const float* bptr = WSP(float, WS_GB) + (size_t)(16 + DIR * 8 + h) * NTOK + tok0;
    float gc = gptr[lane]; const float be = bptr[lane];
#pragma unroll
    for (int o = 1; o < 64; o <<= 1) { const int src = DIR ? lane + o : lane - o; const float t = __shfl(gc, src & 63); if (src >= 0 && src < 64) gc += t; }
    if (!dry) gptr[lane] = gc;
    LAS float* lgc = wl + 4096; LAS float* lbe = wl + 4160;
    lgc[lane] = gc; lbe[lane] = be;
    const bf16* kp = WSP(bf16, WS_PM) + (size_t)tok0 * PM_LD + 1024 + h * 128;
    {
        bf16x8 KF[2][8];
#pragma unroll
        for (int blk = 0; blk < 2; ++blk)
#pragma unroll
            for (int s = 0; s < 8; ++s) KF[blk][s] = *(const bf16x8*)(kp + (size_t)(32 * blk + r) * PM_LD + 16 * s + 8 * hh);
        LAS float* wrow = wl + (4 * hh) * 64 + r;
#pragma unroll
        for (int ib = 0; ib < 2; ++ib)
#pragma unroll
            for (int jb = 0; jb < 2; ++jb) { f32x16 acc;
#pragma unroll
                for (int i = 0; i < 16; ++i) acc[i] = 0.f;
#pragma unroll
                for (int s = 0; s < 8; ++s) acc = MFMA32(KF[ib][s], KF[jb][s], acc);
#pragma unroll
                for (int i = 0; i < 16; ++i) wrow[(32 * ib + crow(i, 0)) * 64 + 32 * jb] = acc[i]; }
    }
    asm volatile("" ::: "memory");
#pragma unroll 4
    for (int ti = 0; ti < 64; ++ti) { const float x = wl[ti * 64 + lane]; const bool before = DIR ? (lane > ti) : (lane < ti);
        wl[ti * 64 + lane] = before ? lbe[ti] * x * __expf(fminf(lgc[ti] - gc, 0.f)) : 0.f; }
    asm volatile("" ::: "memory");
    float Tc[64]; const float lanef = (float)lane;
#pragma unroll
    for (int i = 0; i < 64; ++i) Tc[i] = 0.f;
    LAS float* wlr = wl;
#pragma unroll
    for (int pi = 0; pi < 64; ++pi) {
        constexpr int dummy = 0; (void)dummy;
        const int ti = DIR ? 63 - pi : pi;
        float sacc = fmaxf(0.f, 1.f - fabsf(lanef - (float)pi));
        if (pi >= 2) asm volatile("" : "+v"(wlr) : "v"(Tc[pi - 2]));
        float sb1 = 0.f, sb2 = 0.f, sb3 = 0.f;
#pragma unroll
        for (int q = 0; q < (pi + 3) / 4; ++q) { const f32x4 l4 = *(const LAS f32x4*)(wlr + ti * 64 + (DIR ? 60 - 4 * q : 4 * q));
            if (DIR) { sacc -= l4.w * Tc[4 * q]; sb1 -= l4.z * Tc[4 * q + 1]; sb2 -= l4.y * Tc[4 * q + 2]; sb3 -= l4.x * Tc[4 * q + 3]; }
            else { sacc -= l4.x * Tc[4 * q]; sb1 -= l4.y * Tc[4 * q + 1]; sb2 -= l4.z * Tc[4 * q + 2]; sb3 -= l4.w * Tc[4 * q + 3]; } }
        Tc[pi] = (sacc + sb1) + (sb2 + sb3);
    }
    bf16* tb = (dry ? WSP(bf16, WS_OF) : WSP(bf16, WS_TB)) + ((size_t)(DIR * 544 + c) * 8 + h) * 4096 + (DIR ? 63 - lane : lane);
#pragma unroll
    for (int pi = 0; pi < 64; ++pi) tb[(DIR ? 63 - pi : pi) * 64] = (bf16)f2bf(Tc[pi]);
}
__device__ __forceinline__ void phase_prep(Frame& F, bool dry) {
    const int gw = F.wave * F.G + F.bid, NGW = F.G * 8;
    LAS float* wl = (LAS float*)(F.lds + F.wave * 17408);
    if (gw & 1) { for (int u = gw; u < 544 * 16; u += NGW) prep_unit<1>(F, u, wl, dry); }
    else { for (int u = gw; u < 544 * 16; u += NGW) prep_unit<0>(F, u, wl, dry); }
}

constexpr int SC_WF = 0, SC_QF = 16384, SC_KF = 32768, SC_AF = 49152, SC_TUF = 57344, SC_EGL = 65536, SC_BUF = 65600, SC_VEC = 2 * SC_BUF, SC_OST = SC_VEC + 1280, SC_OCNT = SC_OST + 16384;
__device__ __forceinline__ int scan_chunk(int b, int d, int n) { return n < 4 ? (b * 4 + (d ? 3 - n : n)) : (32 + b * 64 + (d ? 67 - n : n - 4)); }
struct HLoad {
    float gc, be; bf16x8 KA[4]; u32x4 T8[2][4]; bf16x8 ka[8], qb[8]; u32x2 ql[2][2], qh[2][2];
};
__device__ __forceinline__ void scan_load(Frame& F, int h, int d, int chunk, int hw, HLoad& R) {
    int lane_ = F.lane; asm volatile("" : "+v"(lane_));
    const int lane = lane_, r = lane & 31, hh = lane >> 5, tok0 = chunk * 64;
    R.gc = WSP(float, WS_GB)[(size_t)(d * 8 + h) * NTOK + tok0 + lane]; R.be = WSP(float, WS_GB)[(size_t)(16 + d * 8 + h) * NTOK + tok0 + lane];
    const bf16* tb = WSP(bf16, WS_TB) + ((size_t)(d * 544 + chunk) * 8 + h) * 4096;
    const bf16* kt = WSP(bf16, WS_KT) + (size_t)(chunk * 8 + h) * 8192;
    const bf16* qp = WSP(bf16, WS_PM) + (size_t)tok0 * PM_LD + h * 128;
    const int d4 = hw, jb = hw >> 1, ib = hw & 1;
#pragma unroll
    for (int s4 = 0; s4 < 4; ++s4) R.KA[s4] = *(const bf16x8*)(kt + (32 * d4 + r) * 64 + 16 * s4 + 8 * hh);
#pragma unroll
    for (int tb_ = 0; tb_ < 2; ++tb_)
#pragma unroll
        for (int s4 = 0; s4 < 4; ++s4) R.T8[tb_][s4] = *(const u32x4*)(tb + (32 * tb_ + r) * 64 + 16 * s4 + 8 * hh);
#pragma unroll
    for (int s8 = 0; s8 < 8; ++s8) { R.ka[s8] = *(const bf16x8*)(qp + (size_t)(32 * jb + r) * PM_LD + 1024 + 16 * s8 + 8 * hh);
        R.qb[s8] = *(const bf16x8*)(qp + (size_t)(32 * ib + r) * PM_LD + 16 * s8 + 8 * hh); }
#pragma unroll
    for (int tb_ = 0; tb_ < 2; ++tb_)
#pragma unroll
        for (int s = 0; s < 2; ++s) { const bf16* q0 = qp + (size_t)(32 * tb_ + r) * PM_LD + 32 * d4 + 16 * s + 4 * hh;
            R.ql[tb_][s] = *(const u32x2*)q0; R.qh[tb_][s] = *(const u32x2*)(q0 + 8); }
}
__device__ __forceinline__ void scan_produce(Frame& F, int h, int d, LAS unsigned char* buf, int hw, HLoad& R, int nchunk) {
    int lane_ = F.lane; asm volatile("" : "+v"(lane_));
    const int lane = lane_, r = lane & 31, hh = lane >> 5;
    constexpr bool more = true; const int ntok0 = nchunk * 64;
    const bf16* ntb = WSP(bf16, WS_TB) + ((size_t)(d * 544 + nchunk) * 8 + h) * 4096;
    const bf16* nkt = WSP(bf16, WS_KT) + (size_t)(nchunk * 8 + h) * 8192;
    const bf16* nqp = WSP(bf16, WS_PM) + (size_t)ntok0 * PM_LD + h * 128;
    LAS float* vec = (LAS float*)(F.lds + SC_VEC);
    { const float gc = R.gc, be = R.be;
      const float gl = __shfl(gc, d ? 0 : 63), eg = __expf(gc);
      vec[lane] = gc; vec[64 + lane] = eg; vec[128 + lane] = -be * eg; vec[192 + lane] = be; vec[256 + lane] = __expf(gl - gc);
      if (hw == 0 && lane == 0) *(LAS float*)(buf + SC_EGL) = __expf(gl); }
    if (more) { R.gc = WSP(float, WS_GB)[(size_t)(d * 8 + h) * NTOK + ntok0 + lane]; R.be = WSP(float, WS_GB)[(size_t)(16 + d * 8 + h) * NTOK + ntok0 + lane]; }
    __builtin_amdgcn_sched_barrier(0);
    {
        const int jb = hw >> 1, ib = hw & 1;
        f32x16 acc;
#pragma unroll
        for (int i = 0; i < 16; ++i) acc[i] = 0.f;
#pragma unroll
        for (int s8 = 0; s8 < 8; ++s8) acc = MFMA32(R.ka[s8], R.qb[s8], acc);
        __builtin_amdgcn_sched_barrier(0);
        if (more) { int l2_ = F.lane; asm volatile("" : "+v"(l2_)); const int r = l2_ & 31, hh = l2_ >> 5;
#pragma unroll
            for (int s8 = 0; s8 < 8; ++s8) { R.ka[s8] = *(const bf16x8*)(nqp + (size_t)(32 * jb + r) * PM_LD + 1024 + 16 * s8 + 8 * hh);
                R.qb[s8] = *(const bf16x8*)(nqp + (size_t)(32 * ib + r) * PM_LD + 16 * s8 + 8 * hh); } }
        __builtin_amdgcn_sched_barrier(0);
        const int ti = 32 * ib + r; const float gci = vec[ti];
#pragma unroll
        for (int i = 0; i < 16; ++i) { const int tj = 32 * jb + crow(i, hh); const float msk = fminf(fmaxf((float)((d ? tj - ti : ti - tj) + 1), 0.f), 1.f);
            acc[i] = msk * acc[i] * __expf(fminf(gci - vec[tj], 0.f)); }
#pragma unroll
        for (int s = 0; s < 2; ++s) *(LAS bf16x8*)(buf + SC_AF + ((ib * 2 + jb) * 2 + s) * 1024 + lane * 16) = pack_step(acc, s);
    }
    __builtin_amdgcn_sched_barrier(0);
    {
        const int d4 = hw;
#pragma unroll
        for (int tb_ = 0; tb_ < 2; ++tb_) { const float eq = vec[64 + 32 * tb_ + r];
#pragma unroll
            for (int s = 0; s < 2; ++s) {
                const u32x2 lo = R.ql[tb_][s], hi = R.qh[tb_][s];
                const u32x4 qv = {pkbf(bf_lo(lo.x) * eq, bf_hi(lo.x) * eq), pkbf(bf_lo(lo.y) * eq, bf_hi(lo.y) * eq), pkbf(bf_lo(hi.x) * eq, bf_hi(hi.x) * eq), pkbf(bf_lo(hi.y) * eq, bf_hi(hi.y) * eq)};
                *(LAS u32x4*)(buf + SC_QF + ((tb_ * 4 + d4) * 2 + s) * 1024 + lane * 16) = qv;
                const u32x4 own = __builtin_bit_cast(u32x4, R.KA[2 * tb_ + s]);
                const unsigned sx = hh ? own.x : own.z, sy = hh ? own.y : own.w; const unsigned rx = __shfl_xor(sx, 32), ry = __shfl_xor(sy, 32);
                const u32x2 kl = hh ? (u32x2){rx, ry} : (u32x2){own.x, own.y}, kh = hh ? (u32x2){own.z, own.w} : (u32x2){rx, ry};
                const f32x4 e0 = *(const LAS f32x4*)(vec + 256 + 32 * tb_ + 16 * s + 4 * hh), e1 = *(const LAS f32x4*)(vec + 256 + 32 * tb_ + 16 * s + 8 + 4 * hh);
                const u32x4 kv = {pkbf(bf_lo(kl.x) * e0.x, bf_hi(kl.x) * e0.y), pkbf(bf_lo(kl.y) * e0.z, bf_hi(kl.y) * e0.w), pkbf(bf_lo(kh.x) * e1.x, bf_hi(kh.x) * e1.y), pkbf(bf_lo(kh.y) * e1.z, bf_hi(kh.y) * e1.w)};
                *(LAS u32x4*)(buf + SC_KF + ((d4 * 2 + tb_) * 2 + s) * 1024 + lane * 16) = kv;
            } }
        __builtin_amdgcn_sched_barrier(0);
        if (more) { int l2_ = F.lane; asm volatile("" : "+v"(l2_)); const int r = l2_ & 31, hh = l2_ >> 5;
#pragma unroll
            for (int tb_ = 0; tb_ < 2; ++tb_)
#pragma unroll
                for (int s = 0; s < 2; ++s) { const bf16* q0 = nqp + (size_t)(32 * tb_ + r) * PM_LD + 32 * d4 + 16 * s + 4 * hh;
                    R.ql[tb_][s] = *(const u32x2*)q0; R.qh[tb_][s] = *(const u32x2*)(q0 + 8); } }
    }
    __builtin_amdgcn_sched_barrier(0);
    {
        const int d4 = hw;
#pragma unroll
        for (int tb_ = 0; tb_ < 2; ++tb_) {
            f32x16 acc;
#pragma unroll
            for (int i = 0; i < 16; ++i) acc[i] = 0.f;
#pragma unroll
            for (int s4 = 0; s4 < 4; ++s4) {
                const f32x4 s0 = *(const LAS f32x4*)(vec + 128 + 16 * s4 + 8 * hh), s1 = *(const LAS f32x4*)(vec + 128 + 16 * s4 + 8 * hh + 4);
                acc = MFMA32(R.KA[s4], scale8(R.T8[tb_][s4], s0, s1), acc); }
#pragma unroll
            for (int s = 0; s < 2; ++s) *(LAS bf16x8*)(buf + SC_WF + ((tb_ * 4 + d4) * 2 + s) * 1024 + lane * 16) = pack_step(acc, s);
        }
        __builtin_amdgcn_sched_barrier(0);
        if (more) { int l2_ = F.lane; asm volatile("" : "+v"(l2_)); const int r = l2_ & 31, hh = l2_ >> 5;
#pragma unroll
            for (int s4 = 0; s4 < 4; ++s4) R.KA[s4] = *(const bf16x8*)(nkt + (32 * d4 + r) * 64 + 16 * s4 + 8 * hh); }
    }
    __builtin_amdgcn_sched_barrier(0);
#pragma unroll
    for (int q = 0; q < 2; ++q) { const int s4q = 2 * (hw & 1) + q;
        const f32x4 s0 = *(const LAS f32x4*)(vec + 192 + 16 * s4q + 8 * hh), s1 = *(const LAS f32x4*)(vec + 192 + 16 * s4q + 8 * hh + 4);
        u32x4 t8;
        if (hw == 0) t8 = R.T8[0][q]; else if (hw == 1) t8 = R.T8[0][2 + q]; else if (hw == 2) t8 = R.T8[1][q]; else t8 = R.T8[1][2 + q];
        *(LAS bf16x8*)(buf + SC_TUF + ((hw >> 1) * 4 + s4q) * 1024 + lane * 16) = scale8(t8, s0, s1); }
    __builtin_amdgcn_sched_barrier(0);
    if (more) { int l2_ = F.lane; asm volatile("" : "+v"(l2_)); const int r = l2_ & 31, hh = l2_ >> 5;
#pragma unroll
        for (int tb_ = 0; tb_ < 2; ++tb_)
#pragma unroll
            for (int s4 = 0; s4 < 4; ++s4) R.T8[tb_][s4] = *(const u32x4*)(ntb + (32 * tb_ + r) * 64 + 16 * s4 + 8 * hh); }
}
#define SCAN_BAR() do { asm volatile("s_waitcnt lgkmcnt(0)" ::: "memory"); __builtin_amdgcn_s_barrier(); asm volatile("" ::: "memory"); } while (0)
__device__ __forceinline__ void phase_scan(Frame& F) {
    if (F.bid >= 128) return;
    const int b = F.bid >> 4, h = (F.bid >> 1) & 7, d = F.bid & 1, lane = F.lane, r = lane & 31, hh = lane >> 5;
    const int sl = F.wave & 3;
    if (F.tid == 0) *(LAS unsigned*)(F.lds + SC_OCNT) = 0u;
    if (F.wave >= 4) {
        constexpr int NIT = 68 * REPS(5);
        HLoad R;
        bf16* obase = WSP(bf16, d ? WS_OB : WS_OF) + h * 128;
        const int hl = sl * 64 + lane;
#define SCAN_OSTORE(chunk_) do { u32x4 ov[4]; \
            _Pragma("unroll") for (int p = 0; p < 4; ++p) ov[p] = *(const LAS u32x4*)(F.lds + SC_OST + ((hl >> 4) + 16 * p) * 256 + (hl & 15) * 16); \
            _Pragma("unroll") for (int p = 0; p < 4; ++p) *(u32x4*)(obase + (size_t)((chunk_) * 64 + (hl >> 4) + 16 * p) * D + (hl & 15) * 8) = ov[p]; \
            asm volatile("s_waitcnt lgkmcnt(0)" ::: "memory"); \
            if (lane == 0) __hip_atomic_fetch_add((LAS unsigned*)(F.lds + SC_OCNT), 1u, __ATOMIC_RELAXED, __HIP_MEMORY_SCOPE_WORKGROUP); } while (0)
        scan_load(F, h, d, scan_chunk(b, d, 0), sl, R);
        for (int n = -1; n < NIT; ++n) {
            if (n > 0) SCAN_OSTORE(scan_chunk(b, d, (n - 1) % 68));
            if (n + 1 < NIT) scan_produce(F, h, d, F.lds + ((n + 1) & 1) * SC_BUF, sl, R, scan_chunk(b, d, (n + 2 < NIT ? n + 2 : n + 1) % 68));
            SCAN_BAR();
        }
        SCAN_OSTORE(scan_chunk(b, d, (NIT - 1) % 68));
#undef SCAN_OSTORE
        return;
    }
    __builtin_amdgcn_s_setprio(3);
    f32x16 S[4]; bf16x8 vtf[4];
#pragma unroll
    for (int d4 = 0; d4 < 4; ++d4)
#pragma unroll
        for (int i = 0; i < 16; ++i) S[d4][i] = 0.f;
    const int dv = 32 * sl + r;
#define SCAN_VT(chunk_) do { const bf16* vp = WSP(bf16, WS_PM) + (size_t)((chunk_) * 64 + (dv >> 1)) * PM_LD + 2048 + h * 128 + (dv & 1) * 64 + 8 * hh; \
        _Pragma("unroll") for (int s4 = 0; s4 < 4; ++s4) vtf[s4] = *(const bf16x8*)(vp + 16 * s4); } while (0)
#define SCAN_FR(off, idx) (*(const LAS bf16x8*)(buf + (off) + (idx) * 1024 + lane * 16))
    SCAN_VT(scan_chunk(b, d, 0));
    SCAN_BAR();
    for (int n = 0; n < 68 * REPS(5); ++n) {
        LAS unsigned char* buf = F.lds + (n & 1) * SC_BUF;
        if (REPS(5) > 1 && n == 68) {
#pragma unroll
            for (int d4 = 0; d4 < 4; ++d4)
#pragma unroll
                for (int i = 0; i < 16; ++i) S[d4][i] = 0.f; }
#define LDG(dst, off, i0, i1, i2, i3) do { dst[0] = SCAN_FR(off, i0); dst[1] = SCAN_FR(off, i1); dst[2] = SCAN_FR(off, i2); dst[3] = SCAN_FR(off, i3); } while (0)
#define PIPE() __builtin_amdgcn_sched_barrier(0)
        bf16x8 ga[4], gb[4];
        f32x16 vn[2], o[2];
#pragma unroll
        for (int tb_ = 0; tb_ < 2; ++tb_)
#pragma unroll
            for (int i = 0; i < 16; ++i) { vn[tb_][i] = 0.f; o[tb_][i] = 0.f; }
        LDG(ga, SC_TUF, 0, 1, 2, 3); PIPE();
        LDG(gb, SC_TUF, 4, 5, 6, 7); PIPE();
#pragma unroll
        for (int s4 = 0; s4 < 4; ++s4) vn[0] = MFMA32(ga[s4], vtf[s4], vn[0]);
        PIPE();
        LDG(ga, SC_WF, 0, 8, 0 + 16, 8 + 16); PIPE();
#pragma unroll
        for (int s4 = 0; s4 < 4; ++s4) vn[1] = MFMA32(gb[s4], vtf[s4], vn[1]);
        PIPE();
        if (n + 1 < 68 * REPS(5)) SCAN_VT(scan_chunk(b, d, (n + 1) % 68));
#pragma unroll
        for (int st = 0; st < 8; st += 2) {
            { const int e = st + 1; LDG(gb, SC_WF, e, 8 + e, 16 + e, 24 + e); PIPE(); }
            { const bf16x8 sf = pack_step(S[st >> 1], 0);
              vn[0] = MFMA32(ga[0], sf, vn[0]); vn[1] = MFMA32(ga[1], sf, vn[1]); o[0] = MFMA32(ga[2], sf, o[0]); o[1] = MFMA32(ga[3], sf, o[1]); PIPE(); }
            if (st + 2 < 8) { const int e = st + 2; LDG(ga, SC_WF, e, 8 + e, 16 + e, 24 + e); } else { LDG(ga, SC_AF, 0, 1, 2, 3); }
            PIPE();
            { const bf16x8 sf = pack_step(S[st >> 1], 1);
              vn[0] = MFMA32(gb[0], sf, vn[0]); vn[1] = MFMA32(gb[1], sf, vn[1]); o[0] = MFMA32(gb[2], sf, o[0]); o[1] = MFMA32(gb[3], sf, o[1]); PIPE(); }
        }
        bf16x8 vf[2][2];
#pragma unroll
        for (int tb_ = 0; tb_ < 2; ++tb_)
#pragma unroll
            for (int s = 0; s < 2; ++s) vf[tb_][s] = pack_step(vn[tb_], s);
        LDG(gb, SC_AF, 4, 5, 6, 7); PIPE();
        o[0] = MFMA32(ga[0], vf[0][0], o[0]); o[0] = MFMA32(ga[1], vf[0][1], o[0]); o[0] = MFMA32(ga[2], vf[1][0], o[0]); o[0] = MFMA32(ga[3], vf[1][1], o[0]);
        PIPE();
        LDG(ga, SC_KF, 0, 1, 2, 3); PIPE();
        o[1] = MFMA32(gb[0], vf[0][0], o[1]); o[1] = MFMA32(gb[1], vf[0][1], o[1]); o[1] = MFMA32(gb[2], vf[1][0], o[1]); o[1] = MFMA32(gb[3], vf[1][1], o[1]);
        PIPE();
        const float egl = *(const LAS float*)(buf + SC_EGL);
#pragma unroll
        for (int d4 = 0; d4 < 4; d4 += 2) {
            LDG(gb, SC_KF, 4 * (d4 + 1), 4 * (d4 + 1) + 1, 4 * (d4 + 1) + 2, 4 * (d4 + 1) + 3); PIPE();
#pragma unroll
            for (int i = 0; i < 16; ++i) S[d4][i] *= egl;
            S[d4] = MFMA32(ga[0], vf[0][0], S[d4]); S[d4] = MFMA32(ga[1], vf[0][1], S[d4]); S[d4] = MFMA32(ga[2], vf[1][0], S[d4]); S[d4] = MFMA32(ga[3], vf[1][1], S[d4]);
            PIPE();
            if (d4 + 2 < 4) { LDG(ga, SC_KF, 4 * (d4 + 2), 4 * (d4 + 2) + 1, 4 * (d4 + 2) + 2, 4 * (d4 + 2) + 3); PIPE(); }
#pragma unroll
            for (int i = 0; i < 16; ++i) S[d4 + 1][i] *= egl;
            S[d4 + 1] = MFMA32(gb[0], vf[0][0], S[d4 + 1]); S[d4 + 1] = MFMA32(gb[1], vf[0][1], S[d4 + 1]); S[d4 + 1] = MFMA32(gb[2], vf[1][0], S[d4 + 1]); S[d4 + 1] = MFMA32(gb[3], vf[1][1], S[d4 + 1]);
            PIPE();
        }
        if (n > 0) { unsigned sp = 0; while (*(volatile LAS unsigned*)(F.lds + SC_OCNT) < 4u * (unsigned)n && ++sp < (1u << 20)) __builtin_amdgcn_s_sleep(1); }
#pragma unroll
        for (int ib = 0; ib < 2; ++ib)
#pragma unroll
            for (int i = 0; i < 16; i += 2) { const unsigned w_ = pkbf(o[ib][i], o[ib][i + 1]);
                *(LAS bf16*)(F.lds + SC_OST + (32 * ib + crow(i, hh)) * 256 + dv * 2) = (bf16)(w_ & 0xffffu); *(LAS bf16*)(F.lds + SC_OST + (32 * ib + crow(i + 1, hh)) * 256 + dv * 2) = (bf16)(w_ >> 16); }
        SCAN_BAR();
    }
#undef LDG
#undef PIPE
    __builtin_amdgcn_s_setprio(0);
#undef SCAN_VT
#undef SCAN_FR
}

__device__ __forceinline__ void phase_od(Frame& F, const Args& a, int layer, int row0, int row1, int wg0, int nwg) {
    const int gw = row0 + (F.bid - wg0) * 8 + F.wave, NGW = nwg * 8; const int NTOK_ = row1;
    const f32x4 on = *((const f32x4*)(inp(F, I_ONORM) + layer * 128) + (F.lane & 31));
    u32x2 nf[4], nb[4], nz[4];
#define OD_LOAD(row_) do { const u32x2* of_ = WSP(u32x2, WS_OF) + (size_t)(row_) * 256 + F.lane; const u32x2* ob_ = WSP(u32x2, WS_OB) + (size_t)(row_) * 256 + F.lane; \
        const bf16* zr_ = WSP(bf16, WS_PM) + (size_t)(row_) * PM_LD + PM_Z + 4 * F.lane; \
        _Pragma("unroll") for (int j = 0; j < 4; ++j) { nf[j] = of_[64 * j]; nb[j] = ob_[64 * j]; nz[j] = *(const u32x2*)(zr_ + 256 * j); } } while (0)
    if (gw < NTOK_) OD_LOAD(gw);
    for (int row = gw; row < NTOK_; row += NGW) {
        u32x2 pf[4], pb[4], pz[4];
#pragma unroll
        for (int j = 0; j < 4; ++j) { pf[j] = nf[j]; pb[j] = nb[j]; pz[j] = nz[j]; }
        if (row + NGW < NTOK_) OD_LOAD(row + NGW);
        u32x2* od = WSP(u32x2, WS_H) + (size_t)row * 256 + F.lane;
#pragma unroll
        for (int j = 0; j < 4; ++j) { const u32x2 p = pf[j], q = pb[j]; const u32x2 z = pz[j];
            f32x4 o = (f32x4){bf_lo(p.x) + bf_lo(q.x), bf_hi(p.x) + bf_hi(q.x), bf_lo(p.y) + bf_lo(q.y), bf_hi(p.y) + bf_hi(q.y)};
            float ss = (o.x * o.x + o.y * o.y) + (o.z * o.z + o.w * o.w);
            ss = sum32(ss, F.lane);
            const float r = rsqrtf(ss * (1.f / 128.f) + EPS);
            o = o * r * on;
            o.x *= siluf_(bf_lo(z.x)); o.y *= siluf_(bf_hi(z.x)); o.z *= siluf_(bf_lo(z.y)); o.w *= siluf_(bf_hi(z.y));
            od[64 * j] = (u32x2){pk2(o.x, o.y), pk2(o.z, o.w)}; }
    }
#undef OD_LOAD
}

struct SchedMain {
    const char* H; const char* W; int G, c;
    __device__ __forceinline__ bool next(int i, Unit& u) const {
        int L = i * G + c; constexpr int NM = NTILE * 25;
        if (REPS(2) > 1 && L >= NM + 2 * NTILE) L -= NM + 2 * NTILE - 0;
        if (REPS(2) > 1 ? (i * G + c >= NM + 2 * NTILE + 768) : (L >= NM + 2 * NTILE)) return false;
        if (L < NM) { int pm, pn; pg8::tile_map(L, NTILE, 25, pm, pn); u.pm = pm; u.pn = pn; u.aux = 0; }
        else { const int f = L - NM; u.pm = f & 1; u.pn = f >> 1; u.aux = 1; }
        return true;
    }
    __device__ __forceinline__ const char* a_ptr(const Unit& u) const { return u.aux ? W + (size_t)(PM_LD + u.pm * 256) * D * 2 : H + (size_t)u.pm * 256 * D * 2; }
    __device__ __forceinline__ const char* b_ptr(const Unit& u) const { return u.aux ? H + (size_t)u.pn * 256 * D * 2 : W + (size_t)u.pn * 256 * D * 2; }
};
#define EPI_LANE_IDX int tz_ = threadIdx.x; asm volatile("" : "+v"(tz_)); const int wr_ = tz_ >> 8, wc_ = (tz_ >> 6) & 3, fr_ = tz_ & 15, fq_ = (tz_ >> 4) & 3; (void)wr; (void)wc; (void)fr; (void)fq;
#define EPI_ROWS_BEGIN EPI_LANE_IDX const int rbase = wr_ * 64 + fr_, cbase = wc_ * 32 + 8 * fq_; (void)rbase; (void)cbase;
struct EpiMain {
    static constexpr bool PERM = true;
    bf16* PM; bf16* UTL; bf16* UTC;
    __device__ __forceinline__ void operator()(const f32x4 (&acc)[2][2][4][2], const Unit& u, int wr, int wc, int fr, int fq) const {
        EPI_ROWS_BEGIN
#pragma unroll
        for (int ai = 0; ai < 2; ++ai)
#pragma unroll
            for (int m = 0; m < 4; ++m) { const int r = ai * 128 + m * 16 + rbase;
                bf16* rowp;
                if (u.aux == 0) rowp = PM + (size_t)(u.pm * 256 + r) * PM_LD + u.pn * 256 + cbase;
                else { const int ch = u.pm * 256 + r;
                    if (u.pn < 8) rowp = UTC + ((size_t)(u.pn * 512 + ch)) * 256 + cbase;
                    else { const int q = u.pn - 8; rowp = UTL + ((size_t)((q >> 4) * 512 + ch)) * 4096 + (q & 15) * 256 + cbase; } }
#pragma unroll
                for (int bj = 0; bj < 2; ++bj) { const f32x4 v0 = acc[ai][bj][m][0], v1 = acc[ai][bj][m][1];
                    *(u32x4*)(rowp + bj * 128) = (u32x4){cvt_pk_bf16(v0[0], v0[1]), cvt_pk_bf16(v0[2], v0[3]), cvt_pk_bf16(v1[0], v1[1]), cvt_pk_bf16(v1[2], v1[3])}; } }
    }
};
template <int LAT> struct SchedDft {
    const char* A; const char* B; int G, c;
    __device__ __forceinline__ bool next(int i, Unit& u) const {
        const int L = i * G + c;
        if (LAT) { if (L >= 256) return false; u.aux = L >> 5; u.pm = (L & 31) >> 1; u.pn = L & 1; }
        else { if (L >= 32) return false; u.aux = L >> 2; u.pm = (L >> 1) & 1; u.pn = L & 1; }
        return true;
    }
    __device__ __forceinline__ const char* a_ptr(const Unit& u) const { return A + (size_t)u.pm * 256 * (LAT ? 4096 : 256) * 2; }
    __device__ __forceinline__ const char* b_ptr(const Unit& u) const { return B + ((size_t)u.aux * 512 + u.pn * 256) * (LAT ? 4096 : 256) * 2; }
};
template <int LAT> struct EpiDft {
    static constexpr bool PERM = true;
    bf16* PBUF;
    __device__ __forceinline__ void operator()(const f32x4 (&acc)[2][2][4][2], const Unit& u, int wr, int wc, int fr, int fq) const {
        EPI_ROWS_BEGIN
        const int ri = LAT ? (u.pm >> 3) : u.pm;
        const int tokb = LAT ? (NCTX + u.aux * 4096) : (u.aux * 256);
        const int t0 = LAT ? (u.pm & 7) * 256 : 0;
        const unsigned sgn = ri ? 0x80008000u : 0u;
#pragma unroll
        for (int ai = 0; ai < 2; ++ai)
#pragma unroll
            for (int m = 0; m < 4; ++m) { const int tp = t0 + ai * 128 + m * 16 + rbase;
#pragma unroll
                for (int bj = 0; bj < 2; ++bj) { const int ch = u.pn * 256 + bj * 128 + cbase; const f32x4 v0 = acc[ai][bj][m][0], v1 = acc[ai][bj][m][1];
                    const u32x4 w = (u32x4){cvt_pk_bf16(v0[0], v0[1]), cvt_pk_bf16(v0[2], v0[3]), cvt_pk_bf16(v1[0], v1[1]), cvt_pk_bf16(v1[2], v1[3])};
                    const size_t colo = (size_t)(ch >> 7) * 256 + ri * 128 + (ch & 127);
                    *(u32x4*)(PBUF + (size_t)(tokb + tp) * D + colo) = w;
                    if (LAT && tp > 0) *(u32x4*)(PBUF + (size_t)(tokb + 4096 - tp) * D + colo) = (u32x4){w.x ^ sgn, w.y ^ sgn, w.z ^ sgn, w.w ^ sgn}; } }
    }
};
__device__ __forceinline__ void dft_row2048(Frame& F, int wg0) {
    const int gw = (F.bid - wg0) * 8 + F.wave, NGW = (F.G - wg0) * 8;
    for (int rw = gw; rw < NB * 512; rw += NGW) { const int b = rw >> 9, ch = rw & 511;
        const u32x4* up = (const u32x4*)(WSP(bf16, WS_UTL) + (size_t)rw * 4096) + F.lane;
        float s = 0.f;
#pragma unroll
        for (int j = 0; j < 8; ++j) { const u32x4 q = up[64 * j];
            s += (bf_lo(q.x) - bf_hi(q.x)) + (bf_lo(q.y) - bf_hi(q.y)) + (bf_lo(q.z) - bf_hi(q.z)) + (bf_lo(q.w) - bf_hi(q.w)); }
        s = wave_sum(s) * (1.f / 64.f);
        if (F.lane == 0) { bf16* o = WSP(bf16, WS_PBUF) + (size_t)(NCTX + b * 4096 + 2048) * D + (ch >> 7) * 256 + (ch & 127); o[0] = (bf16)f2bf(s); o[128] = 0; }
    }
}
__device__ __forceinline__ bf16* ma_tile(unsigned char GAS* ws, int pm) {
    size_t off;
    if (pm < 8) off = WS_MAC + (size_t)pm * 256 * D * 2;
    else { const int q = pm - 8, b = q >> 4;
        off = (b < 4 ? WS_MA0 + (size_t)q * 256 * D * 2 : b < 7 ? WS_MA1 + (size_t)(q - 64) * 256 * D * 2 : WS_MA2 + (size_t)(q - 112) * 256 * D * 2); }
    return (bf16*)(GAS bf16*)(ws + off);
}
struct SchedRows {
    const char* A; const char* B; int G, c, Lbeg, Lend, pm0, nM;
    __device__ __forceinline__ bool next(int i, Unit& u) const {
        const int L = Lbeg + i * G + c; if (L >= Lend) return false;
        int pm, pn; pg8::tile_map(L, nM, 4, pm, pn); u.pm = pm0 + pm; u.pn = pn; u.aux = 0; return true;
    }
    __device__ __forceinline__ const char* a_ptr(const Unit& u) const { return A + (size_t)u.pm * 256 * D * 2; }
    __device__ __forceinline__ const char* b_ptr(const Unit& u) const { return B + (size_t)u.pn * 256 * D * 2; }
};
template <int MODE> struct EpiGate {
    static constexpr bool PERM = true;
    bf16* M; const bf16* PM; unsigned char GAS* ws;
    __device__ __forceinline__ void operator()(const f32x4 (&acc)[2][2][4][2], const Unit& u, int wr, int wc, int fr, int fq) const {
        EPI_ROWS_BEGIN
        bf16* mat = ma_tile(ws, u.pm);
#pragma unroll
        for (int ai = 0; ai < 2; ++ai) {
            u32x4 gq[4][2], pq[4][2];
#pragma unroll
            for (int m = 0; m < 4; ++m)
#pragma unroll
                for (int bj = 0; bj < 2; ++bj) { const int rt = ai * 128 + m * 16 + rbase, col = u.pn * 256 + bj * 128 + cbase;
                    gq[m][bj] = *(const u32x4*)(PM + (size_t)(u.pm * 256 + rt) * PM_LD + (MODE == 0 ? PM_GA : PM_GB) + col);
                    if (MODE == 1) pq[m][bj] = *(const u32x4*)(mat + (size_t)rt * D + col); }
#pragma unroll
            for (int m = 0; m < 4; ++m) { const int rt = ai * 128 + m * 16 + rbase, row = u.pm * 256 + rt;
#pragma unroll
                for (int bj = 0; bj < 2; ++bj) { const int col = u.pn * 256 + bj * 128 + cbase; const f32x4 v0 = acc[ai][bj][m][0], v1 = acc[ai][bj][m][1];
                    const u32x4 g = gq[m][bj];
                    float o[8] = {v0[0] * sigmoidf_(bf_lo(g.x)), v0[1] * sigmoidf_(bf_hi(g.x)), v0[2] * sigmoidf_(bf_lo(g.y)), v0[3] * sigmoidf_(bf_hi(g.y)),
                                  v1[0] * sigmoidf_(bf_lo(g.z)), v1[1] * sigmoidf_(bf_hi(g.z)), v1[2] * sigmoidf_(bf_lo(g.w)), v1[3] * sigmoidf_(bf_hi(g.w))};
                    if (MODE == 1) { const u32x4 p = pq[m][bj]; o[0] += bf_lo(p.x); o[1] += bf_hi(p.x); o[2] += bf_lo(p.y); o[3] += bf_hi(p.y); o[4] += bf_lo(p.z); o[5] += bf_hi(p.z); o[6] += bf_lo(p.w); o[7] += bf_hi(p.w); }
                    u32x4* mp = (MODE == 1) ? (u32x4*)(M + (size_t)row * D + col) : (u32x4*)(mat + (size_t)rt * D + col);
                    *mp = (u32x4){cvt_pk_bf16(o[0], o[1]), cvt_pk_bf16(o[2], o[3]), cvt_pk_bf16(o[4], o[5]), cvt_pk_bf16(o[6], o[7])}; } }
        }
    }
};
__device__ __forceinline__ void sub_barrier(unsigned* ctr, unsigned n) {
    asm volatile("s_waitcnt vmcnt(0)" ::: "memory");
    __syncthreads();
    if (threadIdx.x == 0) {
        __builtin_amdgcn_fence(__ATOMIC_RELEASE, "agent");
        asm volatile("s_waitcnt vmcnt(0)" ::: "memory");
        (void)xb_add(ctr, 1u);
        unsigned sp = 0; while (xb_ld(ctr) < n && ++sp < (1u << 22)) __builtin_amdgcn_s_sleep(1);
        __builtin_amdgcn_fence(__ATOMIC_ACQUIRE, "agent");
        asm volatile("s_waitcnt vmcnt(0)" ::: "memory");
    }
    __syncthreads();
}
__device__ __forceinline__ void sub_arrive(unsigned* ctr) {
    asm volatile("s_waitcnt vmcnt(0)" ::: "memory");
    __syncthreads();
    if (threadIdx.x == 0) { __builtin_amdgcn_fence(__ATOMIC_RELEASE, "agent"); asm volatile("s_waitcnt vmcnt(0)" ::: "memory"); (void)xb_add(ctr, 1u); }
}
__device__ __forceinline__ void sub_wait(unsigned* ctr, unsigned n) {
    if (threadIdx.x == 0) {
        unsigned sp = 0; while (xb_ld(ctr) < n && ++sp < (1u << 22)) __builtin_amdgcn_s_sleep(1);
        __builtin_amdgcn_fence(__ATOMIC_ACQUIRE, "agent");
        asm volatile("s_waitcnt vmcnt(0)" ::: "memory");
    }
    __syncthreads();
}
struct EpiResid {
    static constexpr bool PERM = false;
    float* X; const float* MODL;
    __device__ __forceinline__ void operator()(const f32x4 (&acc)[2][2][4][2], const Unit& u, int wr, int wc, int fr, int fq) const {
        EPI_LANE_IDX
        const int rbase = wr_ * 64 + fr_, cb = u.pn * 256 + wc_ * 32 + 4 * fq_;
        const int mb = mod_row(u.pm * 256);
        f32x4 gv[2][2];
#pragma unroll
        for (int bj = 0; bj < 2; ++bj)
#pragma unroll
            for (int n = 0; n < 2; ++n) gv[bj][n] = *(const f32x4*)(MODL + (size_t)mb * 6144 + 2048 + cb + bj * 128 + n * 16);
#pragma unroll
        for (int ai = 0; ai < 2; ++ai) {
            f32x4 xq[4][2][2];
#pragma unroll
            for (int m = 0; m < 4; ++m)
#pragma unroll
                for (int bj = 0; bj < 2; ++bj)
#pragma unroll
                    for (int n = 0; n < 2; ++n) xq[m][bj][n] = *(const f32x4*)(X + (size_t)(u.pm * 256 + ai * 128 + m * 16 + rbase) * D + cb + bj * 128 + n * 16);
#pragma unroll
            for (int m = 0; m < 4; ++m)
#pragma unroll
                for (int bj = 0; bj < 2; ++bj)
#pragma unroll
                    for (int n = 0; n < 2; ++n) *(f32x4*)(X + (size_t)(u.pm * 256 + ai * 128 + m * 16 + rbase) * D + cb + bj * 128 + n * 16) = xq[m][bj][n] + gv[bj][n] * acc[ai][bj][m][n];
        }
    }
};
template <int KD, bool GATH = false> struct SchedMoe {
    const char* A; const char* W; volatile LAS unsigned* LCTL; int G, c, ntile;
    __device__ __forceinline__ bool next(int i, Unit& u) const {
        const int cr = ((G & 7) || (i + 1) * G > ntile * 4) ? c : (c & 7) * (G >> 3) + (c >> 3);
        const int L = i * G + cr;
        if (L >= ntile * 4) return false;
        u.pm = L >> 2; u.pn = L & 3; u.aux = __builtin_amdgcn_readfirstlane((int)LCTL[128 + (L >> 2)]); return true;
    }
    __device__ __forceinline__ const char* a_ptr(const Unit& u) const { return GATH ? A : A + (size_t)u.pm * 256 * KD * 2; }
    __device__ __forceinline__ const char* b_ptr(const Unit& u) const { return W + ((size_t)u.aux * 1024 + u.pn * 256) * KD * 2; }
};
struct EpiGU {
    static constexpr bool PERM = true;
    bf16* HID;
    __device__ __forceinline__ void operator()(const f32x4 (&acc)[2][2][4][2], const Unit& u, int wr, int wc, int fr, int fq) const {
        EPI_ROWS_BEGIN
#pragma unroll
        for (int ai = 0; ai < 2; ++ai)
#pragma unroll
            for (int m = 0; m < 4; ++m) { const int row = u.pm * 256 + ai * 128 + m * 16 + rbase;
#pragma unroll
                for (int bj = 0; bj < 2; ++bj) { const f32x4 v0 = acc[ai][bj][m][0], v1 = acc[ai][bj][m][1];
                    *(u32x2*)(HID + (size_t)row * EDIM + u.pn * 128 + ((bj * 128 + cbase) >> 1)) =
                        (u32x2){cvt_pk_bf16(siluf_(v0[0]) * v0[1], siluf_(v0[2]) * v0[3]), cvt_pk_bf16(siluf_(v1[0]) * v1[1], siluf_(v1[2]) * v1[3])}; } }
    }
};
struct EpiDown {
    static constexpr bool PERM = true;
    bf16* YS;
    __device__ __forceinline__ void operator()(const f32x4 (&acc)[2][2][4][2], const Unit& u, int wr, int wc, int fr, int fq) const {
        EPI_ROWS_BEGIN
#pragma unroll
        for (int ai = 0; ai < 2; ++ai)
#pragma unroll
            for (int m = 0; m < 4; ++m) { const int row = u.pm * 256 + ai * 128 + m * 16 + rbase;
#pragma unroll
                for (int bj = 0; bj < 2; ++bj) { const f32x4 v0 = acc[ai][bj][m][0], v1 = acc[ai][bj][m][1];
                    *(u32x4*)(YS + (size_t)row * D + u.pn * 256 + bj * 128 + cbase) = (u32x4){cvt_pk_bf16(v0[0], v0[1]), cvt_pk_bf16(v0[2], v0[3]), cvt_pk_bf16(v1[0], v1[1]), cvt_pk_bf16(v1[2], v1[3])}; } }
    }
};

constexpr int PH_PER_LAYER = 11, PH_FINAL = 1 + DEPTH * PH_PER_LAYER, N_PHASES = PH_FINAL + 1;
__global__ void __launch_bounds__(512, 2) fwd_kernel(Args args) {
    extern __shared__ __attribute__((aligned(16))) unsigned char lds[];
    Frame F;
    F.lds = (LAS unsigned char*)lds; F.LCTL = (volatile LAS unsigned*)(F.lds + LDSCTL_OFF);
    F.ws = (GAS unsigned char*)args.ws; F.tid = threadIdx.x; F.lane = F.tid & 63; F.wave = __builtin_amdgcn_readfirstlane(F.tid >> 6); F.G = gridDim.x; F.bid = blockIdx.x;
    for (int u = F.tid; u < 512; u += 512) F.LCTL[u] = 0u;
    if (F.tid < 25) { const unsigned long long p = (F.tid < 24) ? (unsigned long long)args.in[F.tid] : (unsigned long long)args.out; F.LCTL[512 + 2 * F.tid] = (unsigned)p; F.LCTL[513 + 2 * F.tid] = (unsigned)(p >> 32); }
    __syncthreads();
    XcdBarrier bar; bar.bar = WSP(unsigned, WS_CTL) + CW_BAR; bar.x = 0; bar.st = F.LCTL;
    if (ONE_LAUNCH) bar = xcd_barrier_post(WSP(unsigned, WS_CTL) + CW_BAR, F.LCTL);
    const int lo = args.ph_lo, hi = args.ph_hi;
#define IN(k) (lo <= (k) && (k) < hi)
#ifdef PROBE_MASK
    unsigned long long t_last = __builtin_amdgcn_s_memrealtime(), t_sum = 0;
#define PSTAMP(type) do { const unsigned long long now_ = __builtin_amdgcn_s_memrealtime(); if ((PROBE_MASK >> (type)) & 1) t_sum += now_ - t_last; t_last = now_; } while (0)
#else
#define PSTAMP(type) do {} while (0)
#endif
#define SEAM(k) do { if (IN(k) && IN((k) + 1)) { XcdBarrier b2_ = bar; GAS unsigned* gb_ = (GAS unsigned*)b2_.bar; asm volatile("" : "+s"(gb_)); b2_.bar = (unsigned*)gb_; xcd_barrier(b2_); } } while (0)

    if (PHON(0) && IN(0)) { LAUNDER(F); for (int rep_ = 0; rep_ < REPS(0); ++rep_) phase_prologue(F, args); SEAM(0); PSTAMP(0); }

    for (int layer = 0; layer < DEPTH; ++layer) {
        const int pb = 1 + layer * PH_PER_LAYER;
        const char* WL = (const char*)(WSP(bf16, WS_WIN) + (size_t)layer * WIN_ROWS * D);
        if (PHON(1) && IN(pb + 0)) { LAUNDER(F); if (layer == 0) phase_norm<0, false>(F, args, layer); else phase_norm<0, true>(F, args, layer); if (REPS(1) > 1) { LAUNDER(F); phase_norm<0, false>(F, args, layer); } SEAM(pb + 0); PSTAMP(1); }
        if (PHON(2) && IN(pb + 1)) { LAUNDER(F);
            SchedMain S{(const char*)WSP(bf16, WS_H), WL, F.G, F.bid}; EpiMain E{WSP(bf16, WS_PM), WSP(bf16, WS_UTL), WSP(bf16, WS_UTC)};
            pg8::gemm_phase<EpiMain, SchedMain>(F.lds, D, D, D, S, E);
            LAUNDER(F); conv_taps_fill(F, layer);
            SEAM(pb + 1); PSTAMP(2);
        }
        if (PHON(3) && IN(pb + 2)) { LAUNDER(F);
            phase_conv<false>(F, args, layer);
            if (REPS(18) > 1) { LAUNDER(F); phase_conv<true>(F, args, layer); }
            SEAM(pb + 2); PSTAMP(3);
        }
        if (PHON(4) && IN(pb + 3)) { LAUNDER(F); phase_prep(F, false); if (REPS(4) > 1) phase_prep(F, true); SEAM(pb + 3); PSTAMP(4); }
        if (PHON(13) && IN(pb + 4)) { LAUNDER(F);
            if (F.bid < 128) phase_scan(F);
            else {
            LAUNDER(F);
            { SchedDft<1> S{(const char*)WSP(bf16, WS_DFTL), (const char*)WSP(bf16, WS_UTL), F.G - 128, F.bid - 128}; EpiDft<1> E{WSP(bf16, WS_PBUF)};
              for (int rep_ = 0; rep_ < REPS(3); ++rep_) pg8::gemm_phase<EpiDft<1>, SchedDft<1>>(F.lds, 4096, 4096, 4096, S, E); }
            { SchedDft<0> S{(const char*)WSP(bf16, WS_DFTC), (const char*)WSP(bf16, WS_UTC), F.G - 128, F.bid - 128}; EpiDft<0> E{WSP(bf16, WS_PBUF)};
              pg8::gemm_phase<EpiDft<0>, SchedDft<0>>(F.lds, 256, 256, 256, S, E); }
            LAUNDER(F); dft_row2048(F, 128);
            sub_barrier(WSP(unsigned, WS_CTL) + CW_SUB + layer * 64, (unsigned)(F.G - 128));
            LAUNDER(F);
            { SchedRows S{(const char*)WSP(bf16, WS_PBUF), (const char*)(WSP(bf16, WS_WPA) + (size_t)layer * D * D), F.G - 128, F.bid - 128, 0, NTILE * 4, 0, NTILE}; EpiGate<0> E{nullptr, WSP(bf16, WS_PM), F.ws};
              pg8::gemm_phase<EpiGate<0>, SchedRows>(F.lds, D, D, D, S, E); }
            }
            SEAM(pb + 4); PSTAMP(5); }
        if (PHON(5) && IN(pb + 5)) { LAUNDER(F);
            const bool chain = layer < DEPTH - 1;
            unsigned* sb = WSP(unsigned, WS_CTL) + CW_SUB + layer * 64;
            if (chain) { phase_od(F, args, layer, 0, NCTX, 0, F.G); sub_arrive(sb + 16); LAUNDER(F); }
            if (chain && F.bid < 32) {
                sub_wait(sb + 16, (unsigned)F.G);
                LAUNDER(F);
                { SchedRows S{(const char*)WSP(bf16, WS_H), (const char*)(WSP(bf16, WS_WDL) + (size_t)layer * D * D), 32, F.bid, 0, 32, 0, 8}; EpiGate<1> E{WSP(bf16, WS_OF), WSP(bf16, WS_PM), F.ws};
                  pg8::gemm_phase<EpiGate<1>, SchedRows>(F.lds, D, D, D, S, E); }
                sub_barrier(sb + 32, 32u);
                LAUNDER(F);
                { SchedRows S{(const char*)WSP(bf16, WS_OF), (const char*)(WSP(bf16, WS_WOUT) + (size_t)layer * D * D), 32, F.bid, 0, 32, 0, 8}; EpiResid E{WSP(float, WS_X), WSP(float, WS_MOD) + (size_t)layer * 9 * 6144};
                  pg8::gemm_phase<EpiResid, SchedRows>(F.lds, D, D, D, S, E); }
            } else {
                const int wg0 = chain ? 32 : 0;
                for (int rep_ = 0; rep_ < REPS(6); ++rep_) { phase_od(F, args, layer, NCTX, NTOK, wg0, F.G - wg0); }
                for (int rep2_ = 0; rep2_ < REPS(19); ++rep2_) {LAUNDER(F); moe_weight_convert(F, layer, true, wg0, (LAS float*)(F.lds + F.wave * 16640)); moe_weight_convert(F, layer, false, wg0, (LAS float*)(F.lds + F.wave * 16640)); }
            }
            SEAM(pb + 5); PSTAMP(6); }
        if (PHON(6) && IN(pb + 6)) { LAUNDER(F);
            { SchedRows S{(const char*)WSP(bf16, WS_H), (const char*)(WSP(bf16, WS_WDL) + (size_t)layer * D * D), F.G, F.bid, 0, 512, 8, NTILE - 8}; EpiGate<1> E{WSP(bf16, WS_OF), WSP(bf16, WS_PM), F.ws};
              pg8::gemm_phase<EpiGate<1>, SchedRows>(F.lds, D, D, D, S, E);
              if (REPS(7) > 1) { LAUNDER(F); pg8::gemm_phase<EpiGate<1>, SchedRows>(F.lds, D, D, D, S, E); } }
            SEAM(pb + 6); PSTAMP(7);
        }
        if (PHON(7) && IN(pb + 7)) { LAUNDER(F);
            SchedRows S{(const char*)WSP(bf16, WS_OF), (const char*)(WSP(bf16, WS_WOUT) + (size_t)layer * D * D), F.G, F.bid, 0, 512, 8, NTILE - 8}; EpiResid E{WSP(float, WS_X), WSP(float, WS_MOD) + (size_t)layer * 9 * 6144};
            pg8::gemm_phase<EpiResid, SchedRows>(F.lds, D, D, D, S, E);
            LAUNDER(F); route_table_fill(F, layer);
            SEAM(pb + 7); PSTAMP(8);
        }
        if (PHON(8) && IN(pb + 8)) { LAUNDER(F); phase_route(F, args, layer, false); if (REPS(9) > 1) { LAUNDER(F); phase_route(F, args, layer, true); } SEAM(pb + 8); PSTAMP(9); }
        if (PHON(10) && IN(pb + 9)) { LAUNDER(F);
            build_moe_tables(F, layer);
            SchedMoe<D, true> S{(const char*)WSP(bf16, WS_H), (const char*)WSP(bf16, WS_MOEW), F.LCTL, F.G, F.bid, __builtin_amdgcn_readfirstlane((int)(F.LCTL[16 + NEXP] >> 8))}; EpiGU E{WSP(bf16, WS_HID)};
            { LAS unsigned* gi = (LAS unsigned*)(F.lds + 131072); Unit u;
              int tokv[3];
#pragma unroll
              for (int ii = 0; ii < 3; ++ii) { const int i = 2 * ii + (F.tid >> 8); tokv[ii] = -1;
                  if (S.next(i, u)) { const int e = u.aux, t0 = (u.pm << 8) - (int)F.LCTL[16 + e], cnt = (int)F.LCTL[64 + e];
                      const int rk = t0 + (F.tid & 255); tokv[ii] = rk < cnt ? WSP(int, WS_TOKOF)[(size_t)e * NTOK + rk] : NTOK; } }
#pragma unroll
              for (int ii = 0; ii < 3; ++ii) if (tokv[ii] >= 0) gi[(2 * ii + (F.tid >> 8)) * 256 + (F.tid & 255)] = (unsigned)tokv[ii] * (unsigned)(D * 2);
              for (int i = 6; S.next(i, u); ++i) { const int e = u.aux, t0 = (u.pm << 8) - (int)F.LCTL[16 + e], cnt = (int)F.LCTL[64 + e];
                  if (F.tid < 256) { const int rk = t0 + F.tid; const int tok = rk < cnt ? WSP(int, WS_TOKOF)[(size_t)e * NTOK + rk] : NTOK; gi[i * 256 + F.tid] = (unsigned)tok * (unsigned)(D * 2); } }
              __syncthreads(); }
            for (int rep_ = 0; rep_ < REPS(11); ++rep_) pg8::gemm_phase<EpiGU, SchedMoe<D, true>, true>(F.lds, D, D, D, S, E, (const LAS unsigned*)(F.lds + 131072));
            SEAM(pb + 9); PSTAMP(11);
        }
        if (PHON(11) && IN(pb + 10)) { LAUNDER(F);
            SchedMoe<EDIM> S{(const char*)WSP(bf16, WS_HID), (const char*)WSP(bf16, WS_MOEWD), F.LCTL, F.G, F.bid, __builtin_amdgcn_readfirstlane((int)(F.LCTL[16 + NEXP] >> 8))}; EpiDown E{WSP(bf16, WS_YS)};
            for (int rep_ = 0; rep_ < REPS(12); ++rep_) pg8::gemm_phase<EpiDown, SchedMoe<EDIM>>(F.lds, EDIM, EDIM, EDIM, S, E);
            SEAM(pb + 10); PSTAMP(12);
        }
    }
    float out_scale = 1.f;
#ifdef PROBE_MASK
    if (F.bid == 0 && F.tid == 0) __hip_atomic_store(WSP(unsigned, WS_CTL) + 32, (unsigned)t_sum, __ATOMIC_RELAXED, __HIP_MEMORY_SCOPE_AGENT);
    { XcdBarrier b2_ = bar; GAS unsigned* gb_ = (GAS unsigned*)b2_.bar; asm volatile("" : "+s"(gb_)); b2_.bar = (unsigned*)gb_; xcd_barrier(b2_); }
    out_scale = 1.f + (float)__hip_atomic_load(WSP(unsigned, WS_CTL) + 32, __ATOMIC_RELAXED, __HIP_MEMORY_SCOPE_AGENT) * 1e-5f;
#endif
    if (PHON(12) && IN(PH_FINAL)) { LAUNDER(F); phase_norm<1, true>(F, args, DEPTH, out_scale); }
#undef IN
#undef SEAM
}

extern "C" void kernel_launch(void* const* d_in, const int* in_sizes, int n_in, void* d_out, int out_size, void* d_ws, size_t ws_size, hipStream_t stream) {
    static int grid = 0;
    if (grid == 0) {
        if (n_in != 24 || out_size != NLAT * D || ws_size < WS_END) { fprintf(stderr, "kernel_launch: unexpected problem (n_in %d, out %d, ws %zu < %zu)\n", n_in, out_size, ws_size, (size_t)WS_END); grid = -1; return; }
        int dev = 0, cus = 0, per_cu = 0;
        if (hipGetDevice(&dev) != hipSuccess || hipDeviceGetAttribute(&cus, hipDeviceAttributeMultiprocessorCount, dev) != hipSuccess) { grid = -1; return; }
        if (hipFuncSetAttribute((const void*)fwd_kernel, hipFuncAttributeMaxDynamicSharedMemorySize, LDS_BYTES) != hipSuccess) { fprintf(stderr, "kernel_launch: hipFuncSetAttribute failed\n"); grid = -1; return; }
        if (hipOccupancyMaxActiveBlocksPerMultiprocessor(&per_cu, (const void*)fwd_kernel, 512, LDS_BYTES) != hipSuccess || per_cu < 1) fprintf(stderr, "kernel_launch: occupancy query reports %d\n", per_cu);
        (void)hipGetLastError();
        grid = cus;
    }
    if (grid < 0) return;
    hipMemsetAsync((char*)d_ws + WS_CTL, 0, CTL_ZERO_BYTES, stream);
    Args a{};
    for (int i = 0; i < 24; ++i) a.in[i] = (const float*)d_in[i];
    a.out = (float*)d_out; a.ws = (unsigned char*)d_ws;
#if ONE_LAUNCH
    a.ph_lo = 0; a.ph_hi = N_PHASES;
    hipLaunchKernelGGL(fwd_kernel, dim3(grid), dim3(512), LDS_BYTES, stream, a);
#else
    for (int p = 0; p < N_PHASES; ++p) { a.ph_lo = p; a.ph_hi = p + 1; hipLaunchKernelGGL(fwd_kernel, dim3(grid), dim3(512), LDS_BYTES, stream, a); }
#endif
}
```

```cpp
#include <hip/hip_runtime.h>
#include <cstdio>
#include <cstdint>

#ifndef ONE_LAUNCH
#define ONE_LAUNCH 1
#endif
#ifndef PHMASK
#define PHMASK 0xFFFFu
#endif
#define PHON(k) ((PHMASK >> (k)) & 1u)
#ifndef REPEAT_MASK
#define REPEAT_MASK 0
#endif
#define REPS(k) (1 + ((REPEAT_MASK >> (k)) & 1))

#define GAS __attribute__((address_space(1)))
#define LAS __attribute__((address_space(3)))
typedef unsigned short bf16;
typedef short bf16x8 __attribute__((ext_vector_type(8)));
typedef float f32x4 __attribute__((ext_vector_type(4)));
typedef float f32x2 __attribute__((ext_vector_type(2)));
typedef unsigned u32x4 __attribute__((ext_vector_type(4)));
typedef unsigned u32x2 __attribute__((ext_vector_type(2)));

constexpr int D = 1024, NB = 8, SEQ = 4096, DEPTH = 4, CTXL = 256;
constexpr int NCTX = NB * CTXL;
constexpr int NLAT = NB * SEQ;
constexpr int NTOK = NCTX + NLAT;
constexpr int NTILE = NTOK / 256;
constexpr int IN_COLS = 6688, OFF_A = 3072, OFF_Z = 3104, OFF_F = 4128, OFF_G = 4640;
constexpr int PM_LD = 6400;
constexpr int PM_Z = 3072, PM_GA = 4096, PM_GB = 5120, PM_AB = 6144;
constexpr int WIN_ROWS = 6912;
constexpr int NEXP = 32, EDIM = 512, NSLOT = 77824, MAXTILES = 304;
constexpr float EPS = 1e-6f;

constexpr size_t MiB = 1u << 20;
constexpr size_t WS_CTL = 0, CTL_ZERO_BYTES = 1 * MiB;
constexpr size_t WS_MOD = 1 * MiB;
constexpr size_t WS_X = 2 * MiB;
constexpr size_t WS_WIN = WS_X + 136 * MiB;
constexpr size_t WS_WPA = WS_WIN + 54 * MiB;
constexpr size_t WS_WDL = WS_WPA + 8 * MiB;
constexpr size_t WS_WOUT = WS_WDL + 8 * MiB;
constexpr size_t WS_DFTL = WS_WOUT + 8 * MiB;
constexpr size_t WS_DFTC = WS_DFTL + 64 * MiB;
constexpr size_t WS_MOEW = WS_DFTC + 1 * MiB;
constexpr size_t WS_MOEWD = WS_MOEW + 64 * MiB;
constexpr size_t WS_KT = WS_MOEW + 28 * MiB;
constexpr size_t WS_H = WS_MOEW + 96 * MiB;
constexpr size_t WS_TB = WS_H;
constexpr size_t WS_PM = WS_H + 68 * MiB;
constexpr size_t WS_XS = WS_PM;
constexpr size_t WS_TOKOF = WS_XS + 1 * MiB;
constexpr size_t WS_HID = WS_XS + 152 * MiB;
constexpr size_t WS_YS = WS_HID + 76 * MiB;
constexpr size_t WS_UTL = WS_PM + 425 * MiB;
constexpr size_t WS_UTC = WS_UTL + 32 * MiB;
constexpr size_t WS_PBUF = WS_UTC + 2 * MiB;
constexpr size_t WS_OF = WS_PBUF + 68 * MiB;
constexpr size_t WS_OB = WS_OF + 68 * MiB;
constexpr size_t WS_GB = WS_OB + 68 * MiB;
constexpr size_t WS_ROUTE = WS_GB + 5 * MiB;
constexpr size_t WS_MA0 = WS_DFTL + 32 * MiB;
constexpr size_t WS_MA1 = WS_PM + 425 * MiB;
constexpr size_t WS_MA2 = WS_ROUTE + 1 * MiB;
constexpr size_t WS_MAC = WS_MA2 + 8 * MiB;
constexpr size_t WS_END = WS_MAC + 4 * MiB;
static_assert(WS_YS + 152 * MiB <= WS_UTL, "MoE overlay fits inside PM");
static_assert(WS_END <= 1145ull * MiB, "d_ws budget");
constexpr int CW_BAR = 4096;
constexpr int CW_CNT = 16384;
constexpr int CW_CUR = 16384 + 1024;
constexpr int CW_SUB = 16384 + 2048;

constexpr int LDS_SCRATCH = 151552;
constexpr int LDSCTL_OFF = LDS_SCRATCH;
constexpr int LDS_BYTES = LDS_SCRATCH + 4096;

#define LDS_WAIT() asm volatile("s_waitcnt lgkmcnt(0)" ::: "memory")
#define LDS_BARRIER() do { asm volatile("s_waitcnt lgkmcnt(0)" ::: "memory"); __builtin_amdgcn_s_barrier(); asm volatile("" ::: "memory"); } while (0)
#define VM_WAIT() asm volatile("s_waitcnt vmcnt(0)" ::: "memory")

typedef __bf16 bfx2_t __attribute__((ext_vector_type(2)));
__device__ __forceinline__ unsigned pk2(float lo, float hi) { const f32x2 v = {lo, hi}; const bfx2_t r = __builtin_convertvector(v, bfx2_t); return __builtin_bit_cast(unsigned, r); }
__device__ __forceinline__ unsigned f2bf(float f) { return pk2(f, 0.f) & 0xffffu; }
__device__ __forceinline__ float bf_lo(unsigned w) { return __builtin_bit_cast(float, w << 16); }
__device__ __forceinline__ float bf_hi(unsigned w) { return __builtin_bit_cast(float, w & 0xffff0000u); }
__device__ __forceinline__ float bf2f(bf16 b) { return __builtin_bit_cast(float, (unsigned)b << 16); }
__device__ __forceinline__ float sigmoidf_(float x) { return __builtin_amdgcn_rcpf(1.f + __expf(-x)); }
__device__ __forceinline__ float siluf_(float x) { return x * __builtin_amdgcn_rcpf(1.f + __expf(-x)); }
template <int CTRL> __device__ __forceinline__ float dpp_add(float v) { return v + __builtin_bit_cast(float, __builtin_amdgcn_update_dpp(0, __builtin_bit_cast(int, v), CTRL, 0xf, 0xf, true)); }
__device__ __forceinline__ float sum8(float v) { v = dpp_add<0xB1>(v); v = dpp_add<0x4E>(v); return dpp_add<0x141>(v); }
__device__ __forceinline__ float sum16(float v) { return dpp_add<0x140>(sum8(v)); }
__device__ __forceinline__ float wave_sum(float v) {
    const int r = __builtin_bit_cast(int, sum16(v));
    return (__builtin_bit_cast(float, __builtin_amdgcn_readlane(r, 0)) + __builtin_bit_cast(float, __builtin_amdgcn_readlane(r, 16))) +
           (__builtin_bit_cast(float, __builtin_amdgcn_readlane(r, 32)) + __builtin_bit_cast(float, __builtin_amdgcn_readlane(r, 48)));
}
__device__ __forceinline__ float sum32(float v, int lane) {
    const int r = __builtin_bit_cast(int, sum16(v));
    const float a = __builtin_bit_cast(float, __builtin_amdgcn_readlane(r, 0)) + __builtin_bit_cast(float, __builtin_amdgcn_readlane(r, 16));
    const float b = __builtin_bit_cast(float, __builtin_amdgcn_readlane(r, 32)) + __builtin_bit_cast(float, __builtin_amdgcn_readlane(r, 48));
    return lane < 32 ? a : b;
}
#define XB_TMO      128
#define XB_XCNT(j)  (256  + 64 * (j))
#define XB_XSUB(j)  (1280 + 64 * (j))
#define XB_XGEN(j)  (2304 + 64 * (j))
#define XB_TOP      3328
#define XB_TOPGEN   3392
#define XCD_BAR_WORDS 3456
#define XB_SPIN_CAP (1u << 18)
__device__ __forceinline__ unsigned xb_ld(unsigned* p)              { return __hip_atomic_load(p, __ATOMIC_RELAXED, __HIP_MEMORY_SCOPE_AGENT); }
__device__ __forceinline__ unsigned xb_add(unsigned* p, unsigned v) { return __hip_atomic_fetch_add(p, v, __ATOMIC_RELAXED, __HIP_MEMORY_SCOPE_AGENT); }
__device__ __forceinline__ unsigned xb_xcc_id() { return (unsigned)__builtin_amdgcn_s_getreg((3 << 11) | 20) & 0xFu; }
#define XB_SPIN(cond, bar) do { unsigned _sp = 0; while (cond) { __builtin_amdgcn_s_sleep(1); \
    if ((++_sp & 255u) == 0u) { if (xb_ld(&(bar)[XB_TMO])) break; if (_sp > XB_SPIN_CAP) { atomicAdd(&(bar)[XB_TMO], 1u); break; } } } } while (0)
struct XcdBarrier { unsigned* bar; unsigned x; volatile LAS unsigned* st; };
__device__ __forceinline__ XcdBarrier xcd_barrier_post(unsigned* bar, volatile LAS unsigned* st) {
    XcdBarrier b; b.bar = bar; b.x = xb_xcc_id(); b.st = st;
    if (threadIdx.x == 0) (void)xb_add(&bar[XB_XCNT(b.x)], 1u);
    return b;
}
__device__ __forceinline__ void xcd_barrier_complete(unsigned* bar, unsigned x, unsigned& nloc, unsigned& nx) {
    const unsigned G = gridDim.x * gridDim.y * gridDim.z;
    unsigned sum, cnt, mine, sp = 0u;
    for (;;) {
        sum = 0u; cnt = 0u; mine = 0u;
#pragma unroll
        for (unsigned j = 0; j < 16; ++j) { const unsigned c = xb_ld(&bar[XB_XCNT(j)]); sum += c; cnt += (c > 0u) ? 1u : 0u; mine = (j == x) ? c : mine; }
        if (sum == G) break;
        __builtin_amdgcn_s_sleep(1);
        if ((++sp & 255u) == 0u) { if (xb_ld(&bar[XB_TMO])) break; if (sp > XB_SPIN_CAP) { atomicAdd(&bar[XB_TMO], 1u); break; } }
    }
    nloc = mine > 0u ? mine : 1u; nx = cnt > 0u ? cnt : 1u;
}
__device__ __forceinline__ void xcd_barrier(const XcdBarrier& b) {
    asm volatile("s_waitcnt vmcnt(0)" ::: "memory");
    __syncthreads();
    if (threadIdx.x == 0) {
        unsigned* bar = b.bar;
        __builtin_amdgcn_s_waitcnt(0);
        unsigned nloc = b.st[0], nx = b.st[1];
        if (nloc == 0u) { xcd_barrier_complete(bar, b.x, nloc, nx); b.st[0] = nloc; b.st[1] = nx; }
        const unsigned old = xb_add(&bar[XB_XSUB(b.x)], 1u);
        const unsigned gen = old / nloc;
        if (old + 1u == (gen + 1u) * nloc) {
            __builtin_amdgcn_fence(__ATOMIC_RELEASE, "agent");
            asm volatile("s_waitcnt vmcnt(0)" ::: "memory");
            const unsigned og = xb_add(&bar[XB_TOP], 1u);
            const unsigned tg = og / nx;
            if (og + 1u == (tg + 1u) * nx) xb_add(&bar[XB_TOPGEN], 1u);
            else XB_SPIN(xb_ld(&bar[XB_TOPGEN]) == tg, bar);
            __builtin_amdgcn_fence(__ATOMIC_ACQUIRE, "agent");
            xb_add(&bar[XB_XGEN(b.x)], 1u);
            asm volatile("s_waitcnt vmcnt(0)" ::: "memory");
        } else {
            XB_SPIN(xb_ld(&bar[XB_XGEN(b.x)]) == gen, bar);
            __builtin_amdgcn_fence(__ATOMIC_ACQUIRE, "agent");
            asm volatile("s_waitcnt vmcnt(0)" ::: "memory");
        }
    }
    __syncthreads();
}

namespace pg8 {
constexpr int BM = 256, BK = 64, HALF = 128, HTB = HALF * BK * 2, STAGE_BYTES = 8 * HTB, NXCD = 8, WGM = 8;
__device__ __forceinline__ int lds_byte(int r, int c) { const int st = (r >> 4) * 2 + (c >> 5), rr = r & 15, cc = c & 31, ob = rr * 64 + cc * 2; return st * 1024 + (ob ^ (((ob >> 9) & 1) << 5)); }
__device__ __forceinline__ void stage_rc(int b, int& R, int& C) { const int st = b / 1024, sb = b % 1024, swz = sb ^ (((sb >> 9) & 1) << 5); R = (st >> 1) * 16 + swz / 64; C = (st & 1) * 32 + (swz % 64) / 2; }
__device__ __forceinline__ int perm32(int rho) { const int n = rho >> 4, i = rho & 15; return 8 * (i >> 2) + 4 * n + (i & 3); }
__device__ __forceinline__ unsigned cvt_pk_bf16(float lo, float hi) { unsigned r; asm volatile("v_cvt_pk_bf16_f32 %0, %1, %2" : "=v"(r) : "v"(lo), "v"(hi)); return r; }

struct Unit { int pm, pn, aux; };

__device__ __forceinline__ void tile_map(int L, int nM, int nN, int& pm, int& pn) {
    const int nwg = nM * nN; int wgid = L;
    { const int q = nwg / NXCD, r = nwg % NXCD, xcd = wgid % NXCD, off = wgid / NXCD; wgid = (xcd < r ? xcd * (q + 1) : r * (q + 1) + (xcd - r) * q) + off; }
    const int nig = WGM * nN, gid = wgid / nig, fm = gid * WGM, gsz = (nM - fm) < WGM ? (nM - fm) : WGM;
    pm = fm + ((wgid % nig) % gsz); pn = (wgid % nig) / gsz;
}

template <class Epi, class Sched, bool GATHER = false>
__device__ __forceinline__ void gemm_phase(LAS unsigned char* lds_v, const int lda, const int ldb, const int K, const Sched& S, const Epi& E, const LAS unsigned* gidx = nullptr) {
    LAS unsigned char* lds = (LAS unsigned char*)(size_t)(unsigned)__builtin_amdgcn_readfirstlane((int)(size_t)lds_v);
    int tid_ = threadIdx.x; asm volatile("" : "+v"(tid_));
    const int tid = tid_, wid = __builtin_amdgcn_readfirstlane(tid >> 6), lane = tid & 63, wr = wid >> 2, wc = wid & 3, fr = lane & 15, fq = lane >> 4;
    const int nt = K / BK;
    unsigned voffA[2], voffB[2], voffG[2][2]; int gR[2];
#pragma unroll
    for (int i = 0; i < 2; ++i) { int R, C; stage_rc(tid * 16 + i * 8192, R, C); const int Rb = Epi::PERM ? ((R & ~31) + perm32(R & 31)) : R;
        voffA[i] = GATHER ? (unsigned)C * 2u : (unsigned)(R * lda + C) * 2u; voffB[i] = (unsigned)(Rb * ldb + C) * 2u; gR[i] = R; }
#define PG8_GLOAD(u_) do { if constexpr (GATHER) { _Pragma("unroll") for (int h_ = 0; h_ < 2; ++h_) _Pragma("unroll") for (int p_ = 0; p_ < 2; ++p_) voffG[h_][p_] = gidx[(u_) * 256 + h_ * 128 + gR[p_]] + voffA[p_]; } } while (0)
    const size_t kstep = (size_t)(BK * 2);
    const unsigned hstepA = (unsigned)(HALF * lda * 2), hstepB = (unsigned)(HALF * ldb * 2);
    const unsigned ldsw = (unsigned)wid * 1024u;
    const int aoff = lds_byte(wr * 64 + fr, fq * 8), boff = lds_byte(wc * 32 + fr, fq * 8);
#define PG8_SA(b, h) (((b) * 2 + (h)) * HTB)
#define PG8_SB(b, h) ((4 + (b) * 2 + (h)) * HTB)
#define PG8_STAGE(bufoff, gbase, voff) do { _Pragma("unroll") for (int _i = 0; _i < 2; ++_i) \
        __builtin_amdgcn_global_load_lds((const unsigned*)((const char*)(gbase) + (voff)[_i]), (LAS unsigned*)(lds + (bufoff) + ldsw + _i * 8192), 16, 0, 0); } while (0)
#define PG8_STAGEA(bufoff, ptr, h, koff) do { if constexpr (GATHER) { _Pragma("unroll") for (int _i = 0; _i < 2; ++_i) \
        __builtin_amdgcn_global_load_lds((const unsigned*)(gA + (koff) + voffG[h][_i]), (LAS unsigned*)(lds + (bufoff) + ldsw + _i * 8192), 16, 0, 0); } else { PG8_STAGE(bufoff, ptr, voffA); } } while (0)
#define PG8_LDA(dst, b, h) do { _Pragma("unroll") for (int m = 0; m < 4; ++m) _Pragma("unroll") for (int k = 0; k < 2; ++k) dst[m][k] = *(const LAS bf16x8*)(lds + PG8_SA(b, h) + aoff + m * 2048 + k * 1024); } while (0)
#define PG8_LDB(dst, b, h) do { _Pragma("unroll") for (int n = 0; n < 2; ++n) _Pragma("unroll") for (int k = 0; k < 2; ++k) dst[n][k] = *(const LAS bf16x8*)(lds + PG8_SB(b, h) + boff + n * 2048 + k * 1024); } while (0)
#define PG8_MMA(ai, bj, At, Bt) do { __builtin_amdgcn_s_setprio(1); _Pragma("unroll") for (int m = 0; m < 4; ++m) _Pragma("unroll") for (int n = 0; n < 2; ++n) _Pragma("unroll") for (int k = 0; k < 2; ++k) \
        acc[ai][bj][m][n] = __builtin_amdgcn_mfma_f32_16x16x32_bf16(Bt[n][k], At[m][k], acc[ai][bj][m][n], 0, 0, 0); __builtin_amdgcn_s_setprio(0); } while (0)
#define PG8_WAIT_V(n) asm volatile("s_waitcnt vmcnt(" #n ")" ::: "memory")
#define PG8_WAIT_L(n) asm volatile("s_waitcnt lgkmcnt(" #n ")" ::: "memory")
#define PG8_BAR __builtin_amdgcn_s_barrier()
#define PG8_SCHED __builtin_amdgcn_sched_barrier(0)
    Unit cur, nxt; int ui = 0;
    if (!S.next(0, cur)) return;
    f32x4 acc[2][2][4][2];
#pragma unroll
    for (int a = 0; a < 2; ++a)
#pragma unroll
        for (int b = 0; b < 2; ++b)
#pragma unroll
            for (int m = 0; m < 4; ++m)
#pragma unroll
                for (int n = 0; n < 2; ++n) acc[a][b][m][n] = (f32x4){0.f, 0.f, 0.f, 0.f};
    bf16x8 At[4][2], B0[2][2], B1[2][2];
    const char* cA = GATHER ? nullptr : S.a_ptr(cur); const char* cB = S.b_ptr(cur); const char* gA = GATHER ? S.a_ptr(cur) : nullptr;
    PG8_GLOAD(0);
    PG8_STAGE(PG8_SB(0, 0), cB, voffB); PG8_STAGE(PG8_SB(0, 1), cB + hstepB, voffB); PG8_STAGEA(PG8_SA(0, 0), cA, 0, 0); PG8_STAGEA(PG8_SA(0, 1), cA + hstepA, 1, 0);
    if (wr == 1) PG8_BAR;
    PG8_WAIT_V(2); PG8_BAR;
    PG8_STAGE(PG8_SB(1, 0), cB + kstep, voffB); PG8_STAGEA(PG8_SA(1, 0), cA + kstep, 0, kstep); PG8_STAGE(PG8_SB(1, 1), cB + hstepB + kstep, voffB);
    PG8_WAIT_V(6); PG8_BAR;
    for (;;) {
        const bool has_next = S.next(ui + 1, nxt);
        const char* nA = GATHER ? nullptr : (has_next ? S.a_ptr(nxt) : cA); const char* nB = has_next ? S.b_ptr(nxt) : cB;
#pragma nounroll
        for (int t = 0; t < nt; t += 2) {
            const bool last = (t == nt - 2);
            const char* a1 = cA + (size_t)(t + 1) * kstep;
            const char* a2 = last ? nA : cA + (size_t)(t + 2) * kstep; const char* b2 = last ? nB : cB + (size_t)(t + 2) * kstep;
            const char* a3 = a2 + kstep; const char* b3 = b2 + kstep;
            const size_t k1 = (size_t)(t + 1) * kstep, k2 = last ? 0 : (size_t)(t + 2) * kstep, k3 = k2 + kstep;
            PG8_LDB(B0, 0, 0); PG8_LDB(B1, 0, 1); PG8_SCHED; PG8_LDA(At, 0, 0); PG8_STAGEA(PG8_SA(1, 1), a1 + hstepA, 1, k1);
            if (last && has_next) PG8_GLOAD(ui + 1);
            PG8_WAIT_V(8); PG8_WAIT_L(0); PG8_BAR; PG8_MMA(0, 0, At, B0); PG8_MMA(0, 1, At, B1); PG8_BAR; PG8_SCHED;
            PG8_LDA(At, 0, 1); PG8_STAGE(PG8_SB(0, 0), b2, voffB); PG8_STAGE(PG8_SB(0, 1), b2 + hstepB, voffB); PG8_STAGEA(PG8_SA(0, 0), a2, 0, k2);
            PG8_WAIT_V(8); PG8_WAIT_L(0); PG8_BAR; PG8_MMA(1, 0, At, B0); PG8_MMA(1, 1, At, B1); PG8_BAR; PG8_SCHED;
            PG8_LDB(B0, 1, 0); PG8_LDB(B1, 1, 1); PG8_SCHED; PG8_LDA(At, 1, 0); PG8_STAGEA(PG8_SA(0, 1), a2 + hstepA, 1, k2);
            PG8_WAIT_V(8); PG8_WAIT_L(0); PG8_BAR; PG8_MMA(0, 0, At, B0); PG8_MMA(0, 1, At, B1); PG8_BAR; PG8_SCHED;
            PG8_LDA(At, 1, 1); PG8_STAGE(PG8_SB(1, 0), b3, voffB); PG8_STAGE(PG8_SB(1, 1), b3 + hstepB, voffB); PG8_STAGEA(PG8_SA(1, 0), a3, 0, k3);
            PG8_WAIT_V(8); PG8_WAIT_L(0); PG8_BAR; PG8_MMA(1, 0, At, B0); PG8_MMA(1, 1, At, B1); PG8_BAR; PG8_SCHED;
        }
        if (wr == 0) PG8_BAR;
        E(acc, cur, wr, wc, fr, fq);
        if (!has_next) break;
#pragma unroll
        for (int a = 0; a < 2; ++a)
#pragma unroll
            for (int b = 0; b < 2; ++b)
#pragma unroll
                for (int m = 0; m < 4; ++m)
#pragma unroll
                    for (int n = 0; n < 2; ++n) acc[a][b][m][n] = (f32x4){0.f, 0.f, 0.f, 0.f};
        cur = nxt; cA = nA; cB = nB; ++ui;
        if (wr == 1) PG8_BAR;
    }
    PG8_WAIT_V(0);
    PG8_BAR;
#undef PG8_SA
#undef PG8_SB
#undef PG8_STAGE
#undef PG8_STAGEA
#undef PG8_GLOAD
#undef PG8_LDA
#undef PG8_LDB
#undef PG8_MMA
#undef PG8_WAIT_V
#undef PG8_WAIT_L
#undef PG8_BAR
#undef PG8_SCHED
}
}
using pg8::Unit;
using pg8::cvt_pk_bf16;

struct Args { const float* in[24]; float* out; unsigned char* ws; int ph_lo, ph_hi; };
enum { I_X = 0, I_C, I_CTX, I_CCTX, I_WMOD, I_BMOD, I_NMIX, I_NFFN, I_WIN, I_CONVW, I_ALOG, I_DTB, I_ONORM, I_WF, I_WDL, I_WOUT, I_WRG, I_BRG, I_WRE, I_BRE, I_WG, I_WU, I_WD, I_FNORM };

struct Frame {
    LAS unsigned char* lds;
    volatile LAS unsigned* LCTL;
    GAS unsigned char* ws;
    int tid, lane, wave, G, bid;
};
#define WSP(T, off) ((T*)(GAS T*)(F.ws + (off)))
#define WSG(T, off) ((GAS T*)(F.ws + (off)))
__device__ __forceinline__ const float* inp(const Frame& F, int i) {
    const unsigned lo = __builtin_amdgcn_readfirstlane(F.LCTL[512 + 2 * i]), hi = __builtin_amdgcn_readfirstlane(F.LCTL[513 + 2 * i]);
    const float* p = (const float*)(GAS const float*)(((unsigned long long)hi << 32) | lo);
    return p;
}
#define LAUNDER(F) do { int t_ = threadIdx.x; LAS unsigned char* l_ = (LAS unsigned char*)lds; \
    unsigned wl_ = __builtin_amdgcn_readfirstlane((unsigned)(unsigned long long)args.ws), wh_ = __builtin_amdgcn_readfirstlane((unsigned)((unsigned long long)args.ws >> 32)); \
    int b_ = __builtin_amdgcn_readfirstlane((int)blockIdx.x), g_ = __builtin_amdgcn_readfirstlane((int)gridDim.x); \
    asm volatile("" : "+v"(t_), "+s"(wl_), "+s"(wh_), "+s"(b_), "+s"(g_), "+v"(l_)); \
    F.tid = t_; F.ws = (GAS unsigned char*)(((unsigned long long)wh_ << 32) | wl_); F.bid = b_; F.G = g_; F.lds = l_; F.LCTL = (volatile LAS unsigned*)(F.lds + LDSCTL_OFF); \
    F.lane = F.tid & 63; F.wave = __builtin_amdgcn_readfirstlane(F.tid >> 6); } while (0)

__device__ __forceinline__ void transpose_item(const float* W, int ldw, int col0, int K, int N, bf16* WT, int row_off, int row_mul, int row_add, LAS float* scr, int item, int lane) {
    const int nblk = N / 32, kb = item / nblk, nb = item % nblk, k0 = 64 * kb, n0 = 32 * nb;
#pragma unroll 8
    for (int i = 0; i < 32; ++i) { const int kk = 2 * i + (lane >> 5); scr[kk * 33 + (lane & 31)] = W[(size_t)(k0 + kk) * ldw + col0 + n0 + (lane & 31)]; }
    LDS_WAIT(); asm volatile("" ::: "memory");
    const int c = lane & 7;
#pragma unroll
    for (int j = 0; j < 4; ++j) { const int n = (lane >> 3) + 8 * j; const LAS float* s = scr + (8 * c) * 33 + n;
        u32x4 o; o.x = pk2(s[0 * 33], s[1 * 33]); o.y = pk2(s[2 * 33], s[3 * 33]); o.z = pk2(s[4 * 33], s[5 * 33]); o.w = pk2(s[6 * 33], s[7 * 33]);
        *(u32x4*)(WT + (size_t)(row_off + (n0 + n) * row_mul + row_add) * K + k0 + 8 * c) = o; }
    LDS_WAIT(); asm volatile("" ::: "memory");
}

__device__ __forceinline__ void transpose_item64(const float* W, int ldw, int col0, int K, int N, bf16* WT, int row_off, int row_mul, int row_add, LAS float* scr, int item, int lane) {
    const int nblk = N / 64, kb = item / nblk, nb = item % nblk, k0 = 64 * kb, n0 = 64 * nb;
    const int lr = lane >> 4, c4 = (lane & 15) * 4;
    const float* src = W + (size_t)(k0 + lr) * ldw + col0 + n0 + c4;
    f32x4 v[16];
#pragma unroll
    for (int i = 0; i < 16; ++i) v[i] = *(const f32x4*)(src + (size_t)(4 * i) * ldw);
#pragma unroll
    for (int i = 0; i < 16; ++i) { LAS float* d = scr + (4 * i + lr) * 65 + c4; d[0] = v[i].x; d[1] = v[i].y; d[2] = v[i].z; d[3] = v[i].w; }
    LDS_WAIT(); asm volatile("" ::: "memory");
    const int c = lane & 7;
#pragma unroll
    for (int j = 0; j < 8; ++j) { const int n = (lane >> 3) + 8 * j; const LAS float* t = scr + (8 * c) * 65 + n;
        u32x4 o; o.x = pk2(t[0 * 65], t[1 * 65]); o.y = pk2(t[2 * 65], t[3 * 65]); o.z = pk2(t[4 * 65], t[5 * 65]); o.w = pk2(t[6 * 65], t[7 * 65]);
        *(u32x4*)(WT + (size_t)(row_off + (n0 + n) * row_mul + row_add) * K + k0 + 8 * c) = o; }
    LDS_WAIT(); asm volatile("" ::: "memory");
}

__device__ __forceinline__ void phase_prologue(Frame& F, const Args& a) {
    const int gw = F.bid * 8 + F.wave, NGW = F.G * 8;
    const int gt = F.bid * 512 + F.tid, NGT = F.G * 512;
    LAS float* scr = (LAS float*)(F.lds + F.wave * 16640);
    {
        constexpr int I_QKV = 16 * 48, I_Z = 16 * 16, I_G = 16 * 32, I_AB = 16, I_F = 16 * 8, I_SQ = 16 * 16;
        constexpr int PER_LAYER = I_QKV + I_Z + I_G + I_AB + I_F + 2 * I_SQ;
        for (int it = gw; it < DEPTH * PER_LAYER; it += NGW) {
            const int layer = it / PER_LAYER; int r = it % PER_LAYER;
            const float* win = inp(F, I_WIN) + (size_t)layer * D * IN_COLS;
            bf16* wt = WSP(bf16, WS_WIN) + (size_t)layer * WIN_ROWS * D;
            if (r < I_QKV) { transpose_item64(win, IN_COLS, 0, D, 3072, wt, 0, 1, 0, scr, r, F.lane); continue; } r -= I_QKV;
            if (r < I_Z)   { transpose_item64(win, IN_COLS, OFF_Z, D, 1024, wt, PM_Z, 1, 0, scr, r, F.lane); continue; } r -= I_Z;
            if (r < I_G)   { transpose_item64(win, IN_COLS, OFF_G, D, 2048, wt, PM_GA, 1, 0, scr, r, F.lane); continue; } r -= I_G;
            if (r < I_AB)  { transpose_item(win, IN_COLS, OFF_A, D, 32, wt, PM_AB, 1, 0, scr, r, F.lane); continue; } r -= I_AB;
            if (r < I_F)   { transpose_item64(win, IN_COLS, OFF_F, D, 512, wt, PM_LD, 1, 0, scr, r, F.lane); continue; } r -= I_F;
            if (r < I_SQ)  { transpose_item64(inp(F, I_WDL) + (size_t)layer * D * D, D, 0, D, D, WSP(bf16, WS_WDL) + (size_t)layer * D * D, 0, 1, 0, scr, r, F.lane); continue; } r -= I_SQ;
            transpose_item64(inp(F, I_WOUT) + (size_t)layer * D * D, D, 0, D, D, WSP(bf16, WS_WOUT) + (size_t)layer * D * D, 0, 1, 0, scr, r, F.lane);
        }
        for (int i = gt; i < DEPTH * 224 * (D / 8); i += NGT) { const int layer = i / (224 * 128), rr = i % (224 * 128);
            *(u32x4*)(WSP(bf16, WS_WIN) + ((size_t)layer * WIN_ROWS + 6176) * D + (size_t)rr * 8) = (u32x4){0u, 0u, 0u, 0u}; }
    }
    {
        LAS float* tb = (LAS float*)(F.lds + 8 * 16640);
        if (F.tid < 128) { tb[F.tid] = cospif((float)F.tid / 64.f); tb[128 + F.tid] = -sinpif((float)F.tid / 64.f); }
        __syncthreads();
        LAS float* T2 = (LAS float*)F.lds;
        for (int e = F.tid; e < 2 * 128 * 128; e += 512) T2[e] = tb[(e >> 14) * 128 + (((e & 127) * ((e >> 7) & 127)) & 127)];
        __syncthreads();
        for (int it = gw; it < DEPTH * 4 * 2 * 16 * 4; it += NGW) {
            const int cb = it & 3, nb = (it >> 2) & 15, ri = (it >> 6) & 1, g = (it >> 7) & 3, layer = it >> 9;
            const int n = nb * 64 + F.lane;
            const float* wf = inp(F, I_WF) + ((size_t)layer * 512 + g * 128) * D + n;
            float o[32];
#pragma unroll
            for (int q = 0; q < 32; ++q) o[q] = 0.f;
#pragma unroll 4
            for (int cp = 0; cp < 128; ++cp) { const float w = wf[(size_t)cp * D]; const LAS f32x4* t4 = (const LAS f32x4*)(T2 + ri * 16384 + cp * 128 + cb * 32);
#pragma unroll
                for (int q4 = 0; q4 < 8; ++q4) { const f32x4 t = t4[q4]; o[4 * q4] += t.x * w; o[4 * q4 + 1] += t.y * w; o[4 * q4 + 2] += t.z * w; o[4 * q4 + 3] += t.w * w; } }
            bf16* dst = WSP(bf16, WS_WPA) + ((size_t)layer * D + n) * D + g * 256 + ri * 128 + cb * 32;
#pragma unroll
            for (int q8 = 0; q8 < 4; ++q8) { const float sc_ = 0.08838834764831845f;
                *(u32x4*)(dst + q8 * 8) = (u32x4){pk2(o[q8 * 8] * sc_, o[q8 * 8 + 1] * sc_), pk2(o[q8 * 8 + 2] * sc_, o[q8 * 8 + 3] * sc_), pk2(o[q8 * 8 + 4] * sc_, o[q8 * 8 + 5] * sc_), pk2(o[q8 * 8 + 6] * sc_, o[q8 * 8 + 7] * sc_)}; }
        }
        __syncthreads();
    }
    {
        LAS float* ct = (LAS float*)F.lds;
        for (int m = F.tid; m < 4096; m += 512) ct[m] = cospif((float)m / 2048.f) * (1.f / 64.f);
        __syncthreads();
        for (int i = gt; i < 4096 * 512; i += NGT) { const int row = i >> 9, t0 = (i & 511) * 8, ri = row >> 11, tp = row & 2047; float v[8];
#pragma unroll
            for (int q = 0; q < 8; ++q) v[q] = ct[((t0 + q) * tp - ri * 1024) & 4095];
            *(u32x4*)(WSP(bf16, WS_DFTL) + (size_t)row * 4096 + t0) = (u32x4){pk2(v[0], v[1]), pk2(v[2], v[3]), pk2(v[4], v[5]), pk2(v[6], v[7])}; }
        for (int i = gt; i < 512 * 32; i += NGT) { const int row = i >> 5, t0 = (i & 31) * 8, ri = row >> 8, tp = row & 255; float v[8];
#pragma unroll
            for (int q = 0; q < 8; ++q) v[q] = ct[((((t0 + q) * tp) & 255) * 16 - ri * 1024) & 4095] * 4.f;
            *(u32x4*)(WSP(bf16, WS_DFTC) + (size_t)row * 256 + t0) = (u32x4){pk2(v[0], v[1]), pk2(v[2], v[3]), pk2(v[4], v[5]), pk2(v[6], v[7])}; }
        __syncthreads();
    }
    { const f32x4* pc_ = (const f32x4*)inp(F, I_CTX); const f32x4* px_ = (const f32x4*)inp(F, I_X);
    for (size_t i = gt; i < (size_t)NTOK * D / 4; i += NGT) {
        const f32x4 v = (i < (size_t)NCTX * D / 4) ? pc_[i] : px_[i - (size_t)NCTX * D / 4];
        WSP(f32x4, WS_X)[i] = v; } }
    {
        LAS float* sc = (LAS float*)(F.lds + 0);
        { const float* pc_ = inp(F, I_C); const float* pcc_ = inp(F, I_CCTX);
        for (int i = F.tid; i < 9 * 1024; i += 512) { const float v = (i < 8192) ? pc_[i] : pcc_[i - 8192]; sc[i] = siluf_(v); } }
        __syncthreads();
        LAS float* red = sc + 9 * 1024;
        for (int it = F.bid; it < DEPTH * 192; it += F.G) {
            const int layer = it / 192, cb = it % 192, col = cb * 32 + (F.lane & 31), kp = F.lane >> 5;
            const float* wm = inp(F, I_WMOD) + (size_t)layer * D * 6144 + col;
            float acc[9];
#pragma unroll
            for (int r = 0; r < 9; ++r) acc[r] = 0.f;
#pragma unroll 16
            for (int k = F.wave * 128 + kp; k < F.wave * 128 + 128; k += 2) { const float w = wm[(size_t)k * 6144];
#pragma unroll
                for (int r = 0; r < 9; ++r) acc[r] += sc[r * 1024 + k] * w; }
#pragma unroll
            for (int r = 0; r < 9; ++r) acc[r] += __shfl_xor(acc[r], 32);
            if (kp == 0) {
#pragma unroll
                for (int r = 0; r < 9; ++r) red[(F.wave * 9 + r) * 32 + F.lane] = acc[r]; }
            __syncthreads();
            if (F.tid < 9 * 32) { const int r = F.tid >> 5, c = F.tid & 31; float t = inp(F, I_BMOD)[layer * 6144 + cb * 32 + c];
#pragma unroll
                for (int w = 0; w < 8; ++w) t += red[(w * 9 + r) * 32 + c];
                WSP(float, WS_MOD)[((size_t)layer * 9 + r) * 6144 + cb * 32 + c] = t; }
            __syncthreads();
        }
        __syncthreads();
    }
}

__device__ __forceinline__ void moe_weight_convert(Frame& F, int layer, bool down, int wg0, LAS float* scr) {
    if (F.bid < wg0) return;
    const int gw = (F.bid - wg0) * 8 + F.wave, NGW = (F.G - wg0) * 8;
    if (down) {
        for (int it = gw; it < NEXP * 128; it += NGW) { const int e = it >> 7, r = it & 127;
            transpose_item64(inp(F, I_WD) + ((size_t)layer * NEXP + e) * (size_t)D * EDIM, D, 0, EDIM, D, WSP(bf16, WS_MOEWD) + (size_t)e * 1024 * 512, 0, 1, 0, scr, r, F.lane); }
    } else {
        for (int it = gw; it < NEXP * 256; it += NGW) { const int e = it >> 8, r = it & 255;
            transpose_item64(inp(F, r < 128 ? I_WG : I_WU) + ((size_t)layer * NEXP + e) * (size_t)D * EDIM, EDIM, 0, D, EDIM, WSP(bf16, WS_MOEW) + (size_t)e * 1024 * 1024, 0, 2, r < 128 ? 0 : 1, scr, r & 127, F.lane); }
    }
}

__device__ __forceinline__ int mod_row(int row) { return row < NCTX ? 8 : ((row - NCTX) >> 12); }

__device__ __forceinline__ void build_moe_tables(Frame& F, int layer);
template <int MODE, bool COMBINE>
__device__ __forceinline__ void phase_norm(Frame& F, const Args& a, int layer, float out_scale = 1.f) {
    const int gw = F.bid * 8 + F.wave, NGW = F.G * 8;
    const f32x4* fwp = (const f32x4*)inp(F, MODE == 1 ? I_FNORM : I_NMIX) + (MODE == 1 ? 0 : layer * 256) + F.lane; f32x4* outp = (f32x4*)inp(F, 24);
    int so_all = 0; float cb_all = 0.f;
    if (COMBINE) { build_moe_tables(F, layer - 1);
        const int rr = gw + (F.lane >> 1) * NGW; if (rr < NTOK) { so_all = (int)F.LCTL[16 + WSP(int, WS_ROUTE)[rr * 2 + (F.lane & 1)]] + WSP(int, WS_ROUTE + 2 * NTOK * 8)[rr * 2 + (F.lane & 1)]; cb_all = WSP(float, WS_ROUTE + NTOK * 8)[rr * 2 + (F.lane & 1)]; } }
    f32x4 nwv[4];
#pragma unroll
    for (int j = 0; j < 4; ++j) nwv[j] = fwp[64 * j];
    f32x4 nx[4], ng2[4], nsh[4], nsc[4]; u32x2 ny0[4], ny1[4];
#define NORM_LOAD(row_, it_) do { const f32x4* xr_ = WSP(f32x4, WS_X) + (size_t)(row_) * 256 + F.lane; const int mb_ = mod_row(row_); \
        _Pragma("unroll") for (int j = 0; j < 4; ++j) nx[j] = xr_[64 * j]; \
        if (COMBINE) { const int li_ = __builtin_amdgcn_readfirstlane(2 * (it_)); const int s0_ = __builtin_amdgcn_readlane(so_all, li_), s1_ = __builtin_amdgcn_readlane(so_all, li_ + 1); \
            const u32x2* y0_ = WSP(u32x2, WS_YS) + (size_t)s0_ * 256 + F.lane; const u32x2* y1_ = WSP(u32x2, WS_YS) + (size_t)s1_ * 256 + F.lane; \
            const f32x4* g2_ = WSP(f32x4, WS_MOD) + ((size_t)(layer - 1) * 9 + mb_) * 1536 + 5 * 256 + F.lane; \
            _Pragma("unroll") for (int j = 0; j < 4; ++j) { ny0[j] = y0_[64 * j]; ny1[j] = y1_[64 * j]; ng2[j] = g2_[64 * j]; } } \
        if (MODE == 0) { const f32x4* sh_ = WSP(f32x4, WS_MOD) + ((size_t)layer * 9 + mb_) * 1536 + 0 * 256 + F.lane; \
            _Pragma("unroll") for (int j = 0; j < 4; ++j) { nsh[j] = sh_[64 * j]; nsc[j] = sh_[256 + 64 * j]; } } } while (0)
    if (gw < NTOK) NORM_LOAD(gw, 0);
    int it = 0;
    for (int row = gw; row < NTOK; row += NGW, ++it) {
        f32x4* xr = WSP(f32x4, WS_X) + (size_t)row * 256 + F.lane;
        f32x4 v[4], g2[4], sh[4], sc[4]; u32x2 y0[4], y1[4];
#pragma unroll
        for (int j = 0; j < 4; ++j) { v[j] = nx[j]; if (COMBINE) { y0[j] = ny0[j]; y1[j] = ny1[j]; g2[j] = ng2[j]; } if (MODE == 0) { sh[j] = nsh[j]; sc[j] = nsc[j]; } }
        if (row + NGW < NTOK) NORM_LOAD(row + NGW, it + 1);
        if (COMBINE) {
            const int li = __builtin_amdgcn_readfirstlane(2 * it); const float c0 = __builtin_bit_cast(float, __builtin_amdgcn_readlane(__builtin_bit_cast(int, cb_all), li)), c1 = __builtin_bit_cast(float, __builtin_amdgcn_readlane(__builtin_bit_cast(int, cb_all), li + 1));
#pragma unroll
            for (int j = 0; j < 4; ++j) { const u32x2 p = y0[j], q = y1[j]; const f32x4 g = g2[j];
                v[j].x += g.x * (c0 * bf_lo(p.x) + c1 * bf_lo(q.x)); v[j].y += g.y * (c0 * bf_hi(p.x) + c1 * bf_hi(q.x));
                v[j].z += g.z * (c0 * bf_lo(p.y) + c1 * bf_lo(q.y)); v[j].w += g.w * (c0 * bf_hi(p.y) + c1 * bf_hi(q.y));
                if (MODE == 0) xr[64 * j] = v[j]; }
        }
        float ss = 0.f;
#pragma unroll
        for (int j = 0; j < 4; ++j) ss += (v[j].x * v[j].x + v[j].y * v[j].y) + (v[j].z * v[j].z + v[j].w * v[j].w);
        const float r = rsqrtf(wave_sum(ss) * (1.f / 1024.f) + EPS);
        if (MODE == 1) {
            if (row >= NCTX) { f32x4* o = outp + (size_t)(row - NCTX) * 256 + F.lane;
#pragma unroll
                for (int j = 0; j < 4; ++j) o[64 * j] = v[j] * (r * out_scale) * nwv[j]; }
        } else {
            u32x2* ho = WSP(u32x2, WS_H) + (size_t)row * 256 + F.lane;
#pragma unroll
            for (int j = 0; j < 4; ++j) { const f32x4 h = v[j] * r * nwv[j] * (sc[j] + 1.f) + sh[j];
                ho[64 * j] = (u32x2){pk2(h.x, h.y), pk2(h.z, h.w)}; }
        }
    }
#undef NORM_LOAD
}

__device__ __forceinline__ void ffn_load(Frame& F, int layer, int row, f32x4 (&v)[4], f32x4 (&sh)[4], f32x4 (&sc)[4]) {
    const f32x4* xr = WSP(f32x4, WS_X) + (size_t)row * 256 + F.lane;
    const f32x4* shp = WSP(f32x4, WS_MOD) + ((size_t)layer * 9 + mod_row(row)) * 1536 + 3 * 256 + F.lane;
#pragma unroll
    for (int j = 0; j < 4; ++j) { v[j] = xr[64 * j]; sh[j] = shp[64 * j]; sc[j] = shp[256 + 64 * j]; }
}
__device__ __forceinline__ void ffn_row(const f32x4 (&nw)[4], const f32x4 (&v)[4], const f32x4 (&sh)[4], const f32x4 (&sc)[4], f32x4 (&h)[4]) {
    float ss = 0.f;
#pragma unroll
    for (int j = 0; j < 4; ++j) ss += (v[j].x * v[j].x + v[j].y * v[j].y) + (v[j].z * v[j].z + v[j].w * v[j].w);
    const float r = rsqrtf(wave_sum(ss) * (1.f / 1024.f) + EPS);
#pragma unroll
    for (int j = 0; j < 4; ++j) h[j] = v[j] * r * nw[j] * (sc[j] + 1.f) + sh[j];
}

__device__ __forceinline__ void phase_route(Frame& F, const Args& a, int layer, bool dry) {
    const int gw = F.bid * 8 + F.wave, NGW = F.G * 8;
    LAS float* wl = (LAS float*)F.lds;
    volatile LAS unsigned* cl = F.LCTL + 64;
    const float* wrg = inp(F, I_WRG) + (size_t)layer * D * 4; const float* wre = inp(F, I_WRE) + (size_t)layer * D * 32;
    {
        f32x4 rb[5][4];
#pragma unroll
        for (int q = 0; q < 4; ++q) { const int bI = F.tid + 512 * q, kq = bI >> 3, jq = bI & 7;
#pragma unroll
            for (int r = 0; r < 4; ++r) rb[q][r] = *(const f32x4*)(wre + (size_t)(4 * kq + r) * 32 + 4 * jq); }
        if (F.tid < 256) {
#pragma unroll
            for (int r = 0; r < 4; ++r) rb[4][r] = *(const f32x4*)(wrg + (size_t)(4 * F.tid + r) * 4); }
#pragma unroll
        for (int q = 0; q < 4; ++q) { const int bI = F.tid + 512 * q, kq = bI >> 3, jq = bI & 7;
#pragma unroll
            for (int c = 0; c < 4; ++c) *(LAS f32x4*)(wl + (kq * 37 + 4 + 4 * jq + c) * 4) = (f32x4){rb[q][0][c], rb[q][1][c], rb[q][2][c], rb[q][3][c]}; }
        if (F.tid < 256) {
#pragma unroll
            for (int c = 0; c < 4; ++c) *(LAS f32x4*)(wl + (F.tid * 37 + c) * 4) = (f32x4){rb[4][0][c], rb[4][1][c], rb[4][2][c], rb[4][3][c]}; }
    }
    if (F.tid < 32) cl[F.tid] = 0u;
    __syncthreads();
    const float* brg = inp(F, I_BRG) + layer * 4; const float* bre = inp(F, I_BRE) + layer * 32;
    const f32x4* nwp = (const f32x4*)(inp(F, I_NFFN) + layer * D) + F.lane;
    f32x4 nx[4], nsh[4], nsc[4], nwv[4]; int my_e = 0, my_lr = 0, it = 0;
    const f32x4 brgv = *(const f32x4*)brg; const int brel = __builtin_bit_cast(int, bre[F.lane & 31]);
#pragma unroll
    for (int j = 0; j < 4; ++j) nwv[j] = nwp[64 * j];
    if (gw < NTOK) ffn_load(F, layer, gw, nx, nsh, nsc);
    for (int row = gw; row < NTOK; row += NGW) {
        f32x4 xv[4], shv[4], scv[4];
#pragma unroll
        for (int j = 0; j < 4; ++j) { xv[j] = nx[j]; shv[j] = nsh[j]; scv[j] = nsc[j]; }
        if (row + NGW < NTOK) ffn_load(F, layer, row + NGW, nx, nsh, nsc);
        f32x4 h[4]; ffn_row(nwv, xv, shv, scv, h);
        float lg[4];
#pragma unroll
        for (int g = 0; g < 4; ++g) { float s = 0.f;
#pragma unroll
            for (int j = 0; j < 4; ++j) { const f32x4 w = *(const LAS f32x4*)(wl + ((F.lane + 64 * j) * 37 + g) * 4); s += (h[j].x * w.x + h[j].y * w.y) + (h[j].z * w.z + h[j].w * w.w); }
            lg[g] = wave_sum(s) + brgv[g]; }
        int grp = 0; float mx = lg[0];
#pragma unroll
        for (int g = 1; g < 4; ++g) if (lg[g] > mx) { mx = lg[g]; grp = g; }
        float den = 0.f;
#pragma unroll
        for (int g = 0; g < 4; ++g) den += __expf(lg[g] - mx);
        const float pgrp = 1.f / den;
        float le[8]; const int grp8 = __builtin_amdgcn_readfirstlane(grp * 8);
#pragma unroll
        for (int e = 0; e < 8; ++e) { float s = 0.f;
#pragma unroll
            for (int j = 0; j < 4; ++j) { const f32x4 w = *(const LAS f32x4*)(wl + ((F.lane + 64 * j) * 37 + 4 + grp * 8 + e) * 4); s += (h[j].x * w.x + h[j].y * w.y) + (h[j].z * w.z + h[j].w * w.w); }
            le[e] = wave_sum(s) + __builtin_bit_cast(float, __builtin_amdgcn_readlane(brel, grp8 + e)); }
        int i0 = 0; float v0 = le[0];
#pragma unroll
        for (int e = 1; e < 8; ++e) if (le[e] > v0) { v0 = le[e]; i0 = e; }
        int i1 = -1; float v1 = -3.0e38f;
#pragma unroll
        for (int e = 0; e < 8; ++e) if (e != i0 && le[e] > v1) { v1 = le[e]; i1 = e; }
        const float e1 = __expf(v1 - v0), inv = 1.f / (1.f + e1);
        {
            u32x2* ho = WSP(u32x2, WS_H) + (size_t)row * 256 + F.lane;
#pragma unroll
            for (int j = 0; j < 4; ++j) ho[64 * j] = (u32x2){pk2(h[j].x, h[j].y), pk2(h[j].z, h[j].w)};
        }
        int lr0 = 0, lr1 = 0;
        if (F.lane == 0) {
            float* cb = WSP(float, WS_ROUTE + NTOK * 8) + row * 2; cb[0] = pgrp * inv; cb[1] = pgrp * e1 * inv;
            lr0 = (int)__hip_atomic_fetch_add((LAS unsigned*)(cl + grp * 8 + i0), 1u, __ATOMIC_RELAXED, __HIP_MEMORY_SCOPE_WORKGROUP);
            lr1 = (int)__hip_atomic_fetch_add((LAS unsigned*)(cl + grp * 8 + i1), 1u, __ATOMIC_RELAXED, __HIP_MEMORY_SCOPE_WORKGROUP);
        }
        lr0 = __builtin_amdgcn_readfirstlane(lr0); lr1 = __builtin_amdgcn_readfirstlane(lr1);
        if (F.lane == 2 * it) { my_e = grp * 8 + i0; my_lr = lr0; }
        if (F.lane == 2 * it + 1) { my_e = grp * 8 + i1; my_lr = lr1; }
        ++it;
    }
    __syncthreads();
    if (dry) return;
    if (F.tid < 32) { const unsigned c = cl[F.tid]; F.LCTL[96 + F.tid] = c ? atomicAdd(WSP(unsigned, WS_CTL) + CW_CNT + layer * 64 + F.tid, c) : 0u; }
    if (F.bid == 0) { for (int i = F.tid; i < 512; i += 512) WSP(unsigned, WS_XS)[i] = 0u; }
    __syncthreads();
    { const int row = gw + (F.lane >> 1) * NGW;
      if (F.lane < 36 && row < NTOK) { const int rank = (int)F.LCTL[96 + my_e] + my_lr;
          WSP(int, WS_ROUTE)[row * 2 + (F.lane & 1)] = my_e; WSP(int, WS_ROUTE + 2 * NTOK * 8)[row * 2 + (F.lane & 1)] = rank;
          WSP(int, WS_TOKOF)[(size_t)my_e * NTOK + rank] = row; } }
}

__device__ __forceinline__ void build_moe_tables(Frame& F, int layer) {
    if (F.tid < 64) {
        const int e = F.tid & 31;
        const unsigned c = __hip_atomic_load(WSP(unsigned, WS_CTL) + CW_CNT + layer * 64 + e, __ATOMIC_RELAXED, __HIP_MEMORY_SCOPE_AGENT);
        const unsigned nt = (c + 255u) >> 8;
        unsigned incl = nt;
#pragma unroll
        for (int o = 1; o < 32; o <<= 1) { const unsigned v = __shfl_up(incl, o, 32); if (e >= o) incl += v; }
        const unsigned excl = incl - nt;
        if (F.tid < 32) {
            F.LCTL[16 + e] = excl << 8; F.LCTL[64 + e] = c;
            for (unsigned t = 0; t < nt; ++t) F.LCTL[128 + excl + t] = (unsigned)e;
            if (e == NEXP - 1) F.LCTL[16 + NEXP] = incl << 8;
        }
    }
    __syncthreads();
}

template <int NSTEP, bool dry>
__device__ __forceinline__ void conv_wave_unit(Frame& F, int tok0, int slab) {
    int lane_ = F.lane; asm volatile("" : "+v"(lane_));
    const int lane = lane_, rg = lane >> 3, cc = lane & 7, c0l = cc * 16, c0 = slab * 128 + c0l;
    const int sect = slab >> 3, head = slab & 7;
    const LAS float* wl = (const LAS float*)F.lds + c0;
    u32x4 carry[2] = {(u32x4){0u, 0u, 0u, 0u}, (u32x4){0u, 0u, 0u, 0u}};
#pragma unroll
    for (int p = 0; p < NSTEP; ++p) {
        unsigned ob[2][4][8];
#pragma unroll
        for (int hs = 0; hs < 2; ++hs) {
            const int rb = tok0 + 64 * p + 32 * hs + 4 * rg;
            u32x4 in[6][2];
            const bf16* pr = WSP(bf16, WS_PM) + (size_t)(rb - 1) * PM_LD + c0;
#pragma unroll
            for (int i = 0; i < 6; ++i) { const int row = rb - 1 + i; const bool ok = (row >= tok0) && (row < tok0 + 64 * NSTEP) && !(NSTEP > 1 && p > 0 && hs == 0 && i == 0 && rg == 0);
                if (ok) { in[i][0] = *(const u32x4*)pr; in[i][1] = *(const u32x4*)(pr + 8); } else { in[i][0] = in[i][1] = (u32x4){0u, 0u, 0u, 0u}; }
                pr += PM_LD; asm volatile("" : "+v"(pr)); }
            if (NSTEP > 1 && p > 0 && hs == 0 && rg == 0) { in[0][0] = carry[0]; in[0][1] = carry[1]; }
            if (NSTEP > 1 && p + 1 < NSTEP && hs == 1) {
#pragma unroll
                for (int hq = 0; hq < 2; ++hq) { carry[hq].x = __shfl(in[4][hq].x, 56 + cc); carry[hq].y = __shfl(in[4][hq].y, 56 + cc); carry[hq].z = __shfl(in[4][hq].z, 56 + cc); carry[hq].w = __shfl(in[4][hq].w, 56 + cc); } }
            float xw[3][16];
#define CONV_UNPACK(dst, src) do { _Pragma("unroll") for (int q = 0; q < 16; ++q) { const unsigned w_ = src[q >> 3][(q >> 1) & 3]; dst[q] = (q & 1) ? bf_hi(w_) : bf_lo(w_); } } while (0)
            CONV_UNPACK(xw[0], in[0]); CONV_UNPACK(xw[1], in[1]);
#pragma unroll
            for (int i = 0; i < 4; ++i) {
                CONV_UNPACK(xw[(i + 2) % 3], in[i + 2]);
                float y[16]; float ss = 0.f;
#pragma unroll
                for (int q4 = 0; q4 < 4; ++q4) { const f32x4 a0 = *(const LAS f32x4*)(wl + 4 * q4), a1 = *(const LAS f32x4*)(wl + 3072 + 4 * q4), a2 = *(const LAS f32x4*)(wl + 6144 + 4 * q4);
#pragma unroll
                    for (int e = 0; e < 4; ++e) { const int q = 4 * q4 + e; const float sv = siluf_(a0[e] * xw[i % 3][q] + a1[e] * xw[(i + 1) % 3][q] + a2[e] * xw[(i + 2) % 3][q]); y[q] = sv; ss += sv * sv; } }
                if (sect < 2) { ss = sum8(ss);
                    const float sc = rsqrtf(ss + EPS) * (sect == 0 ? 0.08838834764831845f : 1.f);
#pragma unroll
                    for (int q = 0; q < 16; ++q) y[q] *= sc; }
#pragma unroll
                for (int d = 0; d < 8; ++d) ob[hs][i][d] = pk2(y[2 * d], y[2 * d + 1]);
                __builtin_amdgcn_sched_barrier(0);
            }
#undef CONV_UNPACK
            asm volatile("s_waitcnt vmcnt(0)" ::: "memory");
        }
        if (sect < 2) {
#pragma unroll
            for (int hs = 0; hs < 2; ++hs) { const int row0 = tok0 + 64 * p + 32 * hs + 4 * rg;
                bf16* pw = dry ? WSP(bf16, WS_OF) + (size_t)row0 * 2048 + c0 : WSP(bf16, WS_PM) + (size_t)row0 * PM_LD + c0;
#pragma unroll
                for (int i = 0; i < 4; ++i) {
                    *(u32x4*)pw = (u32x4){ob[hs][i][0], ob[hs][i][1], ob[hs][i][2], ob[hs][i][3]}; *(u32x4*)(pw + 8) = (u32x4){ob[hs][i][4], ob[hs][i][5], ob[hs][i][6], ob[hs][i][7]};
                    pw += dry ? 2048 : PM_LD; asm volatile("" : "+v"(pw)); } }
        }
        if (sect > 0) {
            const int chunk = (tok0 >> 6) + p;
            bf16* tp = (sect == 1) ? (dry ? WSP(bf16, WS_PBUF) : WSP(bf16, WS_KT)) + ((size_t)(chunk * 8 + head) * 128 + c0l) * 64 + 4 * rg
                                   : (dry ? WSP(bf16, WS_H) + (size_t)(chunk * 64 + (c0l >> 1)) * 1024 + head * 128 + 4 * rg
                                          : WSP(bf16, WS_PM) + (size_t)(chunk * 64 + (c0l >> 1)) * PM_LD + 2048 + head * 128 + 4 * rg);
            const int pstep = (sect == 1) ? 128 : (dry ? 1024 : PM_LD);
#pragma unroll
            for (int d = 0; d < 8; ++d) {
#pragma unroll
                for (int e = 0; e < 2; ++e) { const unsigned sel = e ? 0x07060302u : 0x05040100u;
#pragma unroll
                    for (int hs = 0; hs < 2; ++hs) {
                        const u32x2 o = (u32x2){__builtin_amdgcn_perm(ob[hs][1][d], ob[hs][0][d], sel), __builtin_amdgcn_perm(ob[hs][3][d], ob[hs][2][d], sel)};
                        *(u32x2*)(tp + e * 64 + 32 * hs) = o; } }
                tp += pstep; asm volatile("" : "+v"(tp));
            }
        }
        asm volatile("" ::: "memory");
    }
}
#define CONV_UNPACK(dst, src) do { dst[0] = bf_lo(src.x); dst[1] = bf_hi(src.x); dst[2] = bf_lo(src.y); dst[3] = bf_hi(src.y); dst[4] = bf_lo(src.z); dst[5] = bf_hi(src.z); dst[6] = bf_lo(src.w); dst[7] = bf_hi(src.w); } while (0)
template <int HS>
__device__ __forceinline__ void conv_load(Frame& F, u32x4 (&in)[10], int tok0, int c0, int rg) {
    const GAS bf16* pr = WSG(bf16, WS_PM) + (size_t)(tok0 + 32 * HS + 8 * rg - 1) * PM_LD + c0;
#pragma unroll
    for (int i = 0; i < 10; ++i) {
        const bool ok = (i == 0) ? (rg != 0) : ((i == 9 && HS == 1) ? (rg != 3) : true);
        if (ok) in[i] = *(const GAS u32x4*)pr; else in[i] = (u32x4){0u, 0u, 0u, 0u};
        pr += PM_LD; asm volatile("" : "+v"(pr)); }
}
template <int SECT>
__device__ __forceinline__ void conv_half(const u32x4 (&in)[10], const LAS float* wl, GAS bf16* pw, unsigned (&ob)[8][4]) {
    float xw[3][8];
    f32x4 wt[3][2];
#pragma unroll
    for (int k = 0; k < 3; ++k)
#pragma unroll
        for (int q4 = 0; q4 < 2; ++q4) wt[k][q4] = *(const LAS f32x4*)(wl + 3072 * k + 4 * q4);
    CONV_UNPACK(xw[0], in[0]); CONV_UNPACK(xw[1], in[1]);
#pragma unroll
    for (int i = 0; i < 8; ++i) {
        CONV_UNPACK(xw[(i + 2) % 3], in[i + 2]);
        float y[8]; float ss = 0.f;
#pragma unroll
        for (int q = 0; q < 8; ++q) { const float sv = siluf_(wt[0][q >> 2][q & 3] * xw[i % 3][q] + wt[1][q >> 2][q & 3] * xw[(i + 1) % 3][q] + wt[2][q >> 2][q & 3] * xw[(i + 2) % 3][q]); y[q] = sv; ss += sv * sv; }
        if (SECT < 2) { ss = sum16(ss);
            const float sc = rsqrtf(ss + EPS) * (SECT == 0 ? 0.08838834764831845f : 1.f);
#pragma unroll
            for (int q = 0; q < 8; ++q) y[q] *= sc; }
#pragma unroll
        for (int d = 0; d < 4; ++d) ob[i][d] = pk2(y[2 * d], y[2 * d + 1]);
        if (SECT < 2) { *(GAS u32x4*)pw = (u32x4){ob[i][0], ob[i][1], ob[i][2], ob[i][3]}; pw += PM_LD; asm volatile("" : "+v"(pw)); }
        __builtin_amdgcn_sched_barrier(0);
    }
}
__device__ __forceinline__ void conv_tstore(const unsigned (&ob)[8][4], GAS bf16* tp, int pstep) {
#pragma unroll
    for (int d = 0; d < 4; ++d) {
#pragma unroll
        for (int e = 0; e < 2; ++e) { const unsigned sel = e ? 0x07060302u : 0x05040100u;
            *(GAS u32x4*)(tp + e * 64) = (u32x4){__builtin_amdgcn_perm(ob[1][d], ob[0][d], sel), __builtin_amdgcn_perm(ob[3][d], ob[2][d], sel), __builtin_amdgcn_perm(ob[5][d], ob[4][d], sel), __builtin_amdgcn_perm(ob[7][d], ob[6][d], sel)}; }
        tp += pstep; asm volatile("" : "+v"(tp)); __builtin_amdgcn_sched_barrier(0); }
}
__device__ __forceinline__ void conv_latent(Frame& F) {
    int lane_ = F.lane; asm volatile("" : "+v"(lane_));
    const int lane = lane_, rg = lane >> 4, cc = lane & 15, c0l = cc * 8;
    const int gw = F.wave * F.G + F.bid, NGW = F.G * 8;
    int t = gw; if (t >= 512 * 8) return;
    u32x4 A[10], B[10];
    conv_load<0>(F, A, NCTX + (t >> 3) * 64, (t & 7) * 128 + c0l, rg);
#define CONV_NEXT(t_) ((t_) + NGW + (((t_) + NGW >= NGW && (t_) + NGW < NGW + 192) ? NGW : 0))
#pragma nounroll
    for (; t < 512 * 8; t = CONV_NEXT(t)) {
        int cq_ = (t & 7) * 128 + c0l; asm volatile("" : "+v"(cq_));
        const int tok0 = NCTX + (t >> 3) * 64, head = t & 7, chunk = tok0 >> 6, cq = cq_;
        const int tn = CONV_NEXT(t); const bool more = tn < 512 * 8; const int ntok0 = NCTX + (tn >> 3) * 64, ncq = (tn & 7) * 128 + c0l;
        u32x4 carry; unsigned o0[8][4], o1[8][4];
#define CONV_CARRY() do { carry.x = __shfl(A[8].x, 48 + cc); carry.y = __shfl(A[8].y, 48 + cc); carry.z = __shfl(A[8].z, 48 + cc); carry.w = __shfl(A[8].w, 48 + cc); } while (0)
#define CONV_APPLY() do { if (rg == 0) B[0] = carry; } while (0)
        conv_load<1>(F, B, tok0, cq, rg); CONV_CARRY(); __builtin_amdgcn_sched_barrier(0);
        conv_half<0>(A, (const LAS float*)F.lds + cq, WSG(bf16, WS_PM) + (size_t)(tok0 + 8 * rg) * PM_LD + cq, o0);
        conv_load<0>(F, A, tok0, 1024 + cq, rg); __builtin_amdgcn_sched_barrier(0);
        CONV_APPLY();
        conv_half<0>(B, (const LAS float*)F.lds + cq, WSG(bf16, WS_PM) + (size_t)(tok0 + 32 + 8 * rg) * PM_LD + cq, o1);
        conv_load<1>(F, B, tok0, 1024 + cq, rg); CONV_CARRY(); __builtin_amdgcn_sched_barrier(0);
        conv_half<1>(A, (const LAS float*)F.lds + 1024 + cq, WSG(bf16, WS_PM) + (size_t)(tok0 + 8 * rg) * PM_LD + 1024 + cq, o0);
        conv_tstore(o0, WSG(bf16, WS_KT) + ((size_t)(chunk * 8 + head) * 128 + c0l) * 64 + 8 * rg, 128);
        conv_load<0>(F, A, tok0, 2048 + cq, rg); __builtin_amdgcn_sched_barrier(0);
        CONV_APPLY();
        conv_half<1>(B, (const LAS float*)F.lds + 1024 + cq, WSG(bf16, WS_PM) + (size_t)(tok0 + 32 + 8 * rg) * PM_LD + 1024 + cq, o1);
        conv_tstore(o1, WSG(bf16, WS_KT) + ((size_t)(chunk * 8 + head) * 128 + c0l) * 64 + 32 + 8 * rg, 128);
        conv_load<1>(F, B, tok0, 2048 + cq, rg); CONV_CARRY(); __builtin_amdgcn_sched_barrier(0);
        conv_half<2>(A, (const LAS float*)F.lds + 2048 + cq, nullptr, o0);
        CONV_APPLY();
        conv_half<2>(B, (const LAS float*)F.lds + 2048 + cq, nullptr, o1);
        if (more) conv_load<0>(F, A, ntok0, ncq, rg);
        __builtin_amdgcn_sched_barrier(0);
        conv_tstore(o0, WSG(bf16, WS_PM) + (size_t)(chunk * 64 + (c0l >> 1)) * PM_LD + 2048 + head * 128 + 8 * rg, PM_LD);
        conv_tstore(o1, WSG(bf16, WS_PM) + (size_t)(chunk * 64 + (c0l >> 1)) * PM_LD + 2048 + head * 128 + 32 + 8 * rg, PM_LD);
#undef CONV_CARRY
#undef CONV_APPLY
    }
#undef CONV_NEXT
}
#undef CONV_UNPACK
template <bool dry>
__device__ __forceinline__ void phase_conv(Frame& F, const Args& a, int layer) {
    const float* cw = inp(F, I_CONVW) + (size_t)layer * 3 * 3072;
    for (int i = F.tid; i < 3 * 3072 / 4; i += 512) ((LAS f32x4*)F.lds)[i] = ((const f32x4*)cw)[i];
    __syncthreads();
    { const int gw = F.wave * F.G + F.bid, NGW = F.G * 8;
      for (int u = gw; u < 8 * 24; u += NGW) conv_wave_unit<4, dry>(F, (u / 24) * 256, u % 24);
      for (int m = (gw + NGW - 192) % NGW; m < 576; m += NGW) { const int t = NGW + m / 3; if (t < 512 * 8) conv_wave_unit<1, dry>(F, NCTX + (t >> 3) * 64, (m % 3) * 8 + (t & 7)); } }
    if (!dry) conv_latent(F);
    const int gt = F.bid * 512 + F.tid, NGT = F.G * 512;
    const float dtb_ = inp(F, I_DTB)[layer * 16 + (gt & 15)], ea_ = __expf(inp(F, I_ALOG)[layer * 16 + (gt & 15)]);
    for (int i = gt; i < NTOK * 16; i += NGT) { const int tok = i >> 4, dh = i & 15;
        const bf16* p = WSP(bf16, WS_PM) + (size_t)tok * PM_LD + PM_AB;
        const float av = bf2f(p[dh]) + dtb_, bv = bf2f(p[16 + dh]);
        const float sp = av > 20.f ? av : log1pf(__expf(av));
        WSP(float, WS_GB)[(size_t)dh * NTOK + tok] = -ea_ * sp;
        WSP(float, WS_GB)[(size_t)(16 + dh) * NTOK + tok] = sigmoidf_(bv); }
}

typedef float f32x16 __attribute__((ext_vector_type(16)));
#define MFMA32(a, b, c) __builtin_amdgcn_mfma_f32_32x32x16_bf16((a), (b), (c), 0, 0, 0)
__device__ __forceinline__ unsigned pkbf(float a, float b) { const f32x2 v = {a, b}; const bfx2_t r = __builtin_convertvector(v, bfx2_t); return __builtin_bit_cast(unsigned, r); }
__device__ __forceinline__ bf16x8 pack_step(const f32x16& x, int s) {
    const u32x4 p = {pkbf(x[8 * s], x[8 * s + 1]), pkbf(x[8 * s + 2], x[8 * s + 3]), pkbf(x[8 * s + 4], x[8 * s + 5]), pkbf(x[8 * s + 6], x[8 * s + 7])};
    return __builtin_bit_cast(bf16x8, p);
}
__device__ __forceinline__ int crow(int reg, int h) { return (reg & 3) + 8 * (reg >> 2) + 4 * h; }
__device__ __forceinline__ bf16x8 scale8(const u32x4 t, const f32x4 s0, const f32x4 s1) {
    const u32x4 p = {pkbf(bf_lo(t.x) * s0.x, bf_hi(t.x) * s0.y), pkbf(bf_lo(t.y) * s0.z, bf_hi(t.y) * s0.w), pkbf(bf_lo(t.z) * s1.x, bf_hi(t.z) * s1.y), pkbf(bf_lo(t.w) * s1.z, bf_hi(t.w) * s1.w)};
    return __builtin_bit_cast(bf16x8, p);
}

template <int DIR>
__device__ __forceinline__ void prep_unit(Frame& F, int unit, LAS float* wl, bool dry) {
    const int h = (unit >> 1) & 7, c = unit >> 4, tok0 = c * 64, lane = F.lane, r = lane & 31, hh = lane >> 5;
    float* gptr = WSP(float, WS_GB) + (size_t)(DIR * 8 + h) * NTOK + tok0; const float* bptr = WSP(float, WS_GB) + (size_t)(16 + DIR * 8 + h) * NTOK + tok0;
    float gc = gptr[lane]; const float be = bptr[lane];
#pragma unroll
    for (int o = 1; o < 64; o <<= 1) { const int src = DIR ? lane + o : lane - o; const float t = __shfl(gc, src & 63); if (src >= 0 && src < 64) gc += t; }
    if (!dry) gptr[lane] = gc;
    LAS float* lgc = wl + 4096; LAS float* lbe = wl + 4160;
    lgc[lane] = gc; lbe[lane] = be;
    const bf16* kp = WSP(bf16, WS_PM) + (size_t)tok0 * PM_LD + 1024 + h * 128;
    {
        bf16x8 KF[2][8];
#pragma unroll
        for (int blk = 0; blk < 2; ++blk)
#pragma unroll
            for (int s = 0; s < 8; ++s) KF[blk][s] = *(const bf16x8*)(kp + (size_t)(32 * blk + r) * PM_LD + 16 * s + 8 * hh);
        LAS float* wrow = wl + (4 * hh) * 64 + r;
#pragma unroll
        for (int ib = 0; ib < 2; ++ib)
#pragma unroll
            for (int jb = 0; jb < 2; ++jb) { f32x16 acc;
#pragma unroll
                for (int i = 0; i < 16; ++i) acc[i] = 0.f;
#pragma unroll
                for (int s = 0; s < 8; ++s) acc = MFMA32(KF[ib][s], KF[jb][s], acc);
#pragma unroll
                for (int i = 0; i < 16; ++i) wrow[(32 * ib + crow(i, 0)) * 64 + 32 * jb] = acc[i]; }
    }
    asm volatile("" ::: "memory");
#pragma unroll 4
    for (int ti = 0; ti < 64; ++ti) { const float x = wl[ti * 64 + lane]; const bool before = DIR ? (lane > ti) : (lane < ti);
        wl[ti * 64 + lane] = before ? lbe[ti] * x * __expf(fminf(lgc[ti] - gc, 0.f)) : 0.f; }
    asm volatile("" ::: "memory");
    float Tc[64]; const float lanef = (float)lane;
#pragma unroll
    for (int i = 0; i < 64; ++i) Tc[i] = 0.f;
    LAS float* wlr = wl;
#pragma unroll
    for (int pi = 0; pi < 64; ++pi) {
        constexpr int dummy = 0; (void)dummy;
        const int ti = DIR ? 63 - pi : pi;
        float sacc = fmaxf(0.f, 1.f - fabsf(lanef - (float)pi));
        if (pi >= 2) asm volatile("" : "+v"(wlr) : "v"(Tc[pi - 2]));
        float sb1 = 0.f, sb2 = 0.f, sb3 = 0.f;
#pragma unroll
        for (int q = 0; q < (pi + 3) / 4; ++q) { const f32x4 l4 = *(const LAS f32x4*)(wlr + ti * 64 + (DIR ? 60 - 4 * q : 4 * q));
            if (DIR) { sacc -= l4.w * Tc[4 * q]; sb1 -= l4.z * Tc[4 * q + 1]; sb2 -= l4.y * Tc[4 * q + 2]; sb3 -= l4.x * Tc[4 * q + 3]; }
            else { sacc -= l4.x * Tc[4 * q]; sb1 -= l4.y * Tc[4 * q + 1]; sb2 -= l4.z * Tc[4 * q + 2]; sb3 -= l4.w * Tc[4 * q + 3]; } }
        Tc[pi] = (sacc + sb1) + (sb2 + sb3);
    }
    bf16* tb = (dry ? WSP(bf16, WS_OF) : WSP(bf16, WS_TB)) + ((size_t)(DIR * 544 + c) * 8 + h) * 4096 + (DIR ? 63 - lane : lane);
#pragma unroll
    for (int pi = 0; pi < 64; ++pi) tb[(DIR ? 63 - pi : pi) * 64] = (bf16)f2bf(Tc[pi]);
}
__device__ __forceinline__ void phase_prep(Frame& F, bool dry) {
    const int gw = F.wave * F.G + F.bid, NGW = F.G * 8;
    LAS float* wl = (LAS float*)(F.lds + F.wave * 17408);
    if (gw & 1) { for (int u = gw; u < 544 * 16; u += NGW) prep_unit<1>(F, u, wl, dry); }
    else { for (int u = gw; u < 544 * 16; u += NGW) prep_unit<0>(F, u, wl, dry); }
}

constexpr int SC_WF = 0, SC_QF = 16384, SC_KF = 32768, SC_AF = 49152, SC_TUF = 57344, SC_EGL = 65536, SC_BUF = 65600, SC_VEC = 2 * SC_BUF, SC_OST = SC_VEC + 1280, SC_OCNT = SC_OST + 16384;
__device__ __forceinline__ int scan_chunk(int b, int d, int n) { return n < 4 ? (b * 4 + (d ? 3 - n : n)) : (32 + b * 64 + (d ? 67 - n : n - 4)); }
struct HLoad {
    float gc, be; bf16x8 KA[4]; u32x4 T8[2][4]; bf16x8 ka[8], qb[8]; u32x2 ql[2][2], qh[2][2];
};
__device__ __forceinline__ void scan_load(Frame& F, int h, int d, int chunk, int hw, HLoad& R) {
    int lane_ = F.lane; asm volatile("" : "+v"(lane_));
    const int lane = lane_, r = lane & 31, hh = lane >> 5, tok0 = chunk * 64;
    R.gc = WSP(float, WS_GB)[(size_t)(d * 8 + h) * NTOK + tok0 + lane]; R.be = WSP(float, WS_GB)[(size_t)(16 + d * 8 + h) * NTOK + tok0 + lane];
    const bf16* tb = WSP(bf16, WS_TB) + ((size_t)(d * 544 + chunk) * 8 + h) * 4096;
    const bf16* kt = WSP(bf16, WS_KT) + (size_t)(chunk * 8 + h) * 8192;
    const bf16* qp = WSP(bf16, WS_PM) + (size_t)tok0 * PM_LD + h * 128;
    const int d4 = hw, jb = hw >> 1, ib = hw & 1;
#pragma unroll
    for (int s4 = 0; s4 < 4; ++s4) R.KA[s4] = *(const bf16x8*)(kt + (32 * d4 + r) * 64 + 16 * s4 + 8 * hh);
#pragma unroll
    for (int tb_ = 0; tb_ < 2; ++tb_)
#pragma unroll
        for (int s4 = 0; s4 < 4; ++s4) R.T8[tb_][s4] = *(const u32x4*)(tb + (32 * tb_ + r) * 64 + 16 * s4 + 8 * hh);
#pragma unroll
    for (int s8 = 0; s8 < 8; ++s8) { R.ka[s8] = *(const bf16x8*)(qp + (size_t)(32 * jb + r) * PM_LD + 1024 + 16 * s8 + 8 * hh);
        R.qb[s8] = *(const bf16x8*)(qp + (size_t)(32 * ib + r) * PM_LD + 16 * s8 + 8 * hh); }
#pragma unroll
    for (int tb_ = 0; tb_ < 2; ++tb_)
#pragma unroll
        for (int s = 0; s < 2; ++s) { const bf16* q0 = qp + (size_t)(32 * tb_ + r) * PM_LD + 32 * d4 + 16 * s + 4 * hh;
            R.ql[tb_][s] = *(const u32x2*)q0; R.qh[tb_][s] = *(const u32x2*)(q0 + 8); }
}
__device__ __forceinline__ void scan_produce(Frame& F, int h, int d, LAS unsigned char* buf, int hw, HLoad& R, int nchunk) {
    int lane_ = F.lane; asm volatile("" : "+v"(lane_));
    const int lane = lane_, r = lane & 31, hh = lane >> 5;
    constexpr bool more = true; const int ntok0 = nchunk * 64;
    const bf16* ntb = WSP(bf16, WS_TB) + ((size_t)(d * 544 + nchunk) * 8 + h) * 4096;
    const bf16* nkt = WSP(bf16, WS_KT) + (size_t)(nchunk * 8 + h) * 8192;
    const bf16* nqp = WSP(bf16, WS_PM) + (size_t)ntok0 * PM_LD + h * 128;
    LAS float* vec = (LAS float*)(F.lds + SC_VEC);
    { const float gc = R.gc, be = R.be;
      const float gl = __shfl(gc, d ? 0 : 63), eg = __expf(gc);
      vec[lane] = gc; vec[64 + lane] = eg; vec[128 + lane] = -be * eg; vec[192 + lane] = be; vec[256 + lane] = __expf(gl - gc);
      if (hw == 0 && lane == 0) *(LAS float*)(buf + SC_EGL) = __expf(gl); }
    if (more) { R.gc = WSP(float, WS_GB)[(size_t)(d * 8 + h) * NTOK + ntok0 + lane]; R.be = WSP(float, WS_GB)[(size_t)(16 + d * 8 + h) * NTOK + ntok0 + lane]; }
    __builtin_amdgcn_sched_barrier(0);
    {
        const int jb = hw >> 1, ib = hw & 1;
        f32x16 acc;
#pragma unroll
        for (int i = 0; i < 16; ++i) acc[i] = 0.f;
#pragma unroll
        for (int s8 = 0; s8 < 8; ++s8) acc = MFMA32(R.ka[s8], R.qb[s8], acc);
        __builtin_amdgcn_sched_barrier(0);
        if (more) { int l2_ = F.lane; asm volatile("" : "+v"(l2_)); const int r = l2_ & 31, hh = l2_ >> 5;
#pragma unroll
            for (int s8 = 0; s8 < 8; ++s8) { R.ka[s8] = *(const bf16x8*)(nqp + (size_t)(32 * jb + r) * PM_LD + 1024 + 16 * s8 + 8 * hh);
                R.qb[s8] = *(const bf16x8*)(nqp + (size_t)(32 * ib + r) * PM_LD + 16 * s8 + 8 * hh); } }
        __builtin_amdgcn_sched_barrier(0);
        const int ti = 32 * ib + r; const float gci = vec[ti];
#pragma unroll
        for (int i = 0; i < 16; ++i) { const int tj = 32 * jb + crow(i, hh); const float msk = fminf(fmaxf((float)((d ? tj - ti : ti - tj) + 1), 0.f), 1.f);
            acc[i] = msk * acc[i] * __expf(fminf(gci - vec[tj], 0.f)); }
#pragma unroll
        for (int s = 0; s < 2; ++s) *(LAS bf16x8*)(buf + SC_AF + ((ib * 2 + jb) * 2 + s) * 1024 + lane * 16) = pack_step(acc, s);
    }
    __builtin_amdgcn_sched_barrier(0);
    {
        const int d4 = hw;
#pragma unroll
        for (int tb_ = 0; tb_ < 2; ++tb_) { const float eq = vec[64 + 32 * tb_ + r];
#pragma unroll
            for (int s = 0; s < 2; ++s) {
                const u32x2 lo = R.ql[tb_][s], hi = R.qh[tb_][s];
                const u32x4 qv = {pkbf(bf_lo(lo.x) * eq, bf_hi(lo.x) * eq), pkbf(bf_lo(lo.y) * eq, bf_hi(lo.y) * eq), pkbf(bf_lo(hi.x) * eq, bf_hi(hi.x) * eq), pkbf(bf_lo(hi.y) * eq, bf_hi(hi.y) * eq)};
                *(LAS u32x4*)(buf + SC_QF + ((tb_ * 4 + d4) * 2 + s) * 1024 + lane * 16) = qv;
                const u32x4 own = __builtin_bit_cast(u32x4, R.KA[2 * tb_ + s]);
                const unsigned sx = hh ? own.x : own.z, sy = hh ? own.y : own.w; const unsigned rx = __shfl_xor(sx, 32), ry = __shfl_xor(sy, 32);
                const u32x2 kl = hh ? (u32x2){rx, ry} : (u32x2){own.x, own.y}, kh = hh ? (u32x2){own.z, own.w} : (u32x2){rx, ry};
                const f32x4 e0 = *(const LAS f32x4*)(vec + 256 + 32 * tb_ + 16 * s + 4 * hh), e1 = *(const LAS f32x4*)(vec + 256 + 32 * tb_ + 16 * s + 8 + 4 * hh);
                const u32x4 kv = {pkbf(bf_lo(kl.x) * e0.x, bf_hi(kl.x) * e0.y), pkbf(bf_lo(kl.y) * e0.z, bf_hi(kl.y) * e0.w), pkbf(bf_lo(kh.x) * e1.x, bf_hi(kh.x) * e1.y), pkbf(bf_lo(kh.y) * e1.z, bf_hi(kh.y) * e1.w)};
                *(LAS u32x4*)(buf + SC_KF + ((d4 * 2 + tb_) * 2 + s) * 1024 + lane * 16) = kv;
            } }
        __builtin_amdgcn_sched_barrier(0);
        if (more) { int l2_ = F.lane; asm volatile("" : "+v"(l2_)); const int r = l2_ & 31, hh = l2_ >> 5;
#pragma unroll
            for (int tb_ = 0; tb_ < 2; ++tb_)
#pragma unroll
                for (int s = 0; s < 2; ++s) { const bf16* q0 = nqp + (size_t)(32 * tb_ + r) * PM_LD + 32 * d4 + 16 * s + 4 * hh;
                    R.ql[tb_][s] = *(const u32x2*)q0; R.qh[tb_][s] = *(const u32x2*)(q0 + 8); } }
    }
    __builtin_amdgcn_sched_barrier(0);
    {
        const int d4 = hw;
#pragma unroll
        for (int tb_ = 0; tb_ < 2; ++tb_) {
            f32x16 acc;
#pragma unroll
            for (int i = 0; i < 16; ++i) acc[i] = 0.f;
#pragma unroll
            for (int s4 = 0; s4 < 4; ++s4) {
                const f32x4 s0 = *(const LAS f32x4*)(vec + 128 + 16 * s4 + 8 * hh), s1 = *(const LAS f32x4*)(vec + 128 + 16 * s4 + 8 * hh + 4);
                acc = MFMA32(R.KA[s4], scale8(R.T8[tb_][s4], s0, s1), acc); }
#pragma unroll
            for (int s = 0; s < 2; ++s) *(LAS bf16x8*)(buf + SC_WF + ((tb_ * 4 + d4) * 2 + s) * 1024 + lane * 16) = pack_step(acc, s);
        }
        __builtin_amdgcn_sched_barrier(0);
        if (more) { int l2_ = F.lane; asm volatile("" : "+v"(l2_)); const int r = l2_ & 31, hh = l2_ >> 5;
#pragma unroll
            for (int s4 = 0; s4 < 4; ++s4) R.KA[s4] = *(const bf16x8*)(nkt + (32 * d4 + r) * 64 + 16 * s4 + 8 * hh); }
    }
    __builtin_amdgcn_sched_barrier(0);
#pragma unroll
    for (int q = 0; q < 2; ++q) { const int s4q = 2 * (hw & 1) + q;
        const f32x4 s0 = *(const LAS f32x4*)(vec + 192 + 16 * s4q + 8 * hh), s1 = *(const LAS f32x4*)(vec + 192 + 16 * s4q + 8 * hh + 4);
        u32x4 t8;
        if (hw == 0) t8 = R.T8[0][q]; else if (hw == 1) t8 = R.T8[0][2 + q]; else if (hw == 2) t8 = R.T8[1][q]; else t8 = R.T8[1][2 + q];
        *(LAS bf16x8*)(buf + SC_TUF + ((hw >> 1) * 4 + s4q) * 1024 + lane * 16) = scale8(t8, s0, s1); }
    __builtin_amdgcn_sched_barrier(0);
    if (more) { int l2_ = F.lane; asm volatile("" : "+v"(l2_)); const int r = l2_ & 31, hh = l2_ >> 5;
#pragma unroll
        for (int tb_ = 0; tb_ < 2; ++tb_)
#pragma unroll
            for (int s4 = 0; s4 < 4; ++s4) R.T8[tb_][s4] = *(const u32x4*)(ntb + (32 * tb_ + r) * 64 + 16 * s4 + 8 * hh); }
}
#define SCAN_BAR() do { asm volatile("s_waitcnt lgkmcnt(0)" ::: "memory"); __builtin_amdgcn_s_barrier(); asm volatile("" ::: "memory"); } while (0)
__device__ __forceinline__ void phase_scan(Frame& F) {
    if (F.bid >= 128) return;
    const int b = F.bid >> 4, h = (F.bid >> 1) & 7, d = F.bid & 1, lane = F.lane, r = lane & 31, hh = lane >> 5;
    const int sl = F.wave & 3;
    if (F.tid == 0) *(LAS unsigned*)(F.lds + SC_OCNT) = 0u;
    if (F.wave >= 4) {
        constexpr int NIT = 68 * REPS(5);
        HLoad R;
        bf16* obase = WSP(bf16, d ? WS_OB : WS_OF) + h * 128;
        const int hl = sl * 64 + lane;
#define SCAN_OSTORE(chunk_) do { u32x4 ov[4]; \
            _Pragma("unroll") for (int p = 0; p < 4; ++p) ov[p] = *(const LAS u32x4*)(F.lds + SC_OST + ((hl >> 4) + 16 * p) * 256 + (hl & 15) * 16); \
            _Pragma("unroll") for (int p = 0; p < 4; ++p) *(u32x4*)(obase + (size_t)((chunk_) * 64 + (hl >> 4) + 16 * p) * D + (hl & 15) * 8) = ov[p]; \
            asm volatile("s_waitcnt lgkmcnt(0)" ::: "memory"); \
            if (lane == 0) __hip_atomic_fetch_add((LAS unsigned*)(F.lds + SC_OCNT), 1u, __ATOMIC_RELAXED, __HIP_MEMORY_SCOPE_WORKGROUP); } while (0)
        scan_load(F, h, d, scan_chunk(b, d, 0), sl, R);
        for (int n = -1; n < NIT; ++n) {
            if (n > 0) SCAN_OSTORE(scan_chunk(b, d, (n - 1) % 68));
            if (n + 1 < NIT) scan_produce(F, h, d, F.lds + ((n + 1) & 1) * SC_BUF, sl, R, scan_chunk(b, d, (n + 2 < NIT ? n + 2 : n + 1) % 68));
            SCAN_BAR();
        }
        SCAN_OSTORE(scan_chunk(b, d, (NIT - 1) % 68));
#undef SCAN_OSTORE
        return;
    }
    __builtin_amdgcn_s_setprio(3);
    f32x16 S[4]; bf16x8 vtf[4];
#pragma unroll
    for (int d4 = 0; d4 < 4; ++d4)
#pragma unroll
        for (int i = 0; i < 16; ++i) S[d4][i] = 0.f;
    const int dv = 32 * sl + r;
#define SCAN_VT(chunk_) do { const bf16* vp = WSP(bf16, WS_PM) + (size_t)((chunk_) * 64 + (dv >> 1)) * PM_LD + 2048 + h * 128 + (dv & 1) * 64 + 8 * hh; \
        _Pragma("unroll") for (int s4 = 0; s4 < 4; ++s4) vtf[s4] = *(const bf16x8*)(vp + 16 * s4); } while (0)
#define SCAN_FR(off, idx) (*(const LAS bf16x8*)(buf + (off) + (idx) * 1024 + lane * 16))
    SCAN_VT(scan_chunk(b, d, 0));
    SCAN_BAR();
    for (int n = 0; n < 68 * REPS(5); ++n) {
        LAS unsigned char* buf = F.lds + (n & 1) * SC_BUF;
        if (REPS(5) > 1 && n == 68) {
#pragma unroll
            for (int d4 = 0; d4 < 4; ++d4)
#pragma unroll
                for (int i = 0; i < 16; ++i) S[d4][i] = 0.f; }
#define LDG(dst, off, i0, i1, i2, i3) do { dst[0] = SCAN_FR(off, i0); dst[1] = SCAN_FR(off, i1); dst[2] = SCAN_FR(off, i2); dst[3] = SCAN_FR(off, i3); } while (0)
#define PIPE() __builtin_amdgcn_sched_barrier(0)
        bf16x8 ga[4], gb[4];
        f32x16 vn[2], o[2];
#pragma unroll
        for (int tb_ = 0; tb_ < 2; ++tb_)
#pragma unroll
            for (int i = 0; i < 16; ++i) { vn[tb_][i] = 0.f; o[tb_][i] = 0.f; }
        LDG(ga, SC_TUF, 0, 1, 2, 3); PIPE();
        LDG(gb, SC_TUF, 4, 5, 6, 7); PIPE();
#pragma unroll
        for (int s4 = 0; s4 < 4; ++s4) vn[0] = MFMA32(ga[s4], vtf[s4], vn[0]);
        PIPE();
        LDG(ga, SC_WF, 0, 8, 0 + 16, 8 + 16); PIPE();
#pragma unroll
        for (int s4 = 0; s4 < 4; ++s4) vn[1] = MFMA32(gb[s4], vtf[s4], vn[1]);
        PIPE();
        if (n + 1 < 68 * REPS(5)) SCAN_VT(scan_chunk(b, d, (n + 1) % 68));
#pragma unroll
        for (int st = 0; st < 8; st += 2) {
            { const int e = st + 1; LDG(gb, SC_WF, e, 8 + e, 16 + e, 24 + e); PIPE(); }
            { const bf16x8 sf = pack_step(S[st >> 1], 0);
              vn[0] = MFMA32(ga[0], sf, vn[0]); vn[1] = MFMA32(ga[1], sf, vn[1]); o[0] = MFMA32(ga[2], sf, o[0]); o[1] = MFMA32(ga[3], sf, o[1]); PIPE(); }
            if (st + 2 < 8) { const int e = st + 2; LDG(ga, SC_WF, e, 8 + e, 16 + e, 24 + e); } else { LDG(ga, SC_AF, 0, 1, 2, 3); }
            PIPE();
            { const bf16x8 sf = pack_step(S[st >> 1], 1);
              vn[0] = MFMA32(gb[0], sf, vn[0]); vn[1] = MFMA32(gb[1], sf, vn[1]); o[0] = MFMA32(gb[2], sf, o[0]); o[1] = MFMA32(gb[3], sf, o[1]); PIPE(); }
        }
        bf16x8 vf[2][2];
#pragma unroll
        for (int tb_ = 0; tb_ < 2; ++tb_)
#pragma unroll
            for (int s = 0; s < 2; ++s) vf[tb_][s] = pack_step(vn[tb_], s);
        LDG(gb, SC_AF, 4, 5, 6, 7); PIPE();
        o[0] = MFMA32(ga[0], vf[0][0], o[0]); o[0] = MFMA32(ga[1], vf[0][1], o[0]); o[0] = MFMA32(ga[2], vf[1][0], o[0]); o[0] = MFMA32(ga[3], vf[1][1], o[0]);
        PIPE();
        LDG(ga, SC_KF, 0, 1, 2, 3); PIPE();
        o[1] = MFMA32(gb[0], vf[0][0], o[1]); o[1] = MFMA32(gb[1], vf[0][1], o[1]); o[1] = MFMA32(gb[2], vf[1][0], o[1]); o[1] = MFMA32(gb[3], vf[1][1], o[1]);
        PIPE();
        const float egl = *(const LAS float*)(buf + SC_EGL);
#pragma unroll
        for (int d4 = 0; d4 < 4; d4 += 2) {
            LDG(gb, SC_KF, 4 * (d4 + 1), 4 * (d4 + 1) + 1, 4 * (d4 + 1) + 2, 4 * (d4 + 1) + 3); PIPE();
#pragma unroll
            for (int i = 0; i < 16; ++i) S[d4][i] *= egl;
            S[d4] = MFMA32(ga[0], vf[0][0], S[d4]); S[d4] = MFMA32(ga[1], vf[0][1], S[d4]); S[d4] = MFMA32(ga[2], vf[1][0], S[d4]); S[d4] = MFMA32(ga[3], vf[1][1], S[d4]);
            PIPE();
            if (d4 + 2 < 4) { LDG(ga, SC_KF, 4 * (d4 + 2), 4 * (d4 + 2) + 1, 4 * (d4 + 2) + 2, 4 * (d4 + 2) + 3); PIPE(); }
#pragma unroll
            for (int i = 0; i < 16; ++i) S[d4 + 1][i] *= egl;
            S[d4 + 1] = MFMA32(gb[0], vf[0][0], S[d4 + 1]); S[d4 + 1] = MFMA32(gb[1], vf[0][1], S[d4 + 1]); S[d4 + 1] = MFMA32(gb[2], vf[1][0], S[d4 + 1]); S[d4 + 1] = MFMA32(gb[3], vf[1][1], S[d4 + 1]);
            PIPE();
        }
        if (n > 0) { unsigned sp = 0; while (*(volatile LAS unsigned*)(F.lds + SC_OCNT) < 4u * (unsigned)n && ++sp < (1u << 20)) __builtin_amdgcn_s_sleep(1); }
#pragma unroll
        for (int ib = 0; ib < 2; ++ib)
#pragma unroll
            for (int i = 0; i < 16; i += 2) { const unsigned w_ = pkbf(o[ib][i], o[ib][i + 1]);
                *(LAS bf16*)(F.lds + SC_OST + (32 * ib + crow(i, hh)) * 256 + dv * 2) = (bf16)(w_ & 0xffffu); *(LAS bf16*)(F.lds + SC_OST + (32 * ib + crow(i + 1, hh)) * 256 + dv * 2) = (bf16)(w_ >> 16); }
        SCAN_BAR();
    }
#undef LDG
#undef PIPE
    __builtin_amdgcn_s_setprio(0);
#undef SCAN_VT
#undef SCAN_FR
}

__device__ __forceinline__ void phase_od(Frame& F, const Args& a, int layer, int row0, int row1, int wg0, int nwg) {
    const int gw = row0 + (F.bid - wg0) * 8 + F.wave, NGW = nwg * 8; const int NTOK_ = row1;
    const f32x4 on = *((const f32x4*)(inp(F, I_ONORM) + layer * 128) + (F.lane & 31));
    u32x2 nf[4], nb[4], nz[4];
#define OD_LOAD(row_) do { const u32x2* of_ = WSP(u32x2, WS_OF) + (size_t)(row_) * 256 + F.lane; const u32x2* ob_ = WSP(u32x2, WS_OB) + (size_t)(row_) * 256 + F.lane; \
        const bf16* zr_ = WSP(bf16, WS_PM) + (size_t)(row_) * PM_LD + PM_Z + 4 * F.lane; \
        _Pragma("unroll") for (int j = 0; j < 4; ++j) { nf[j] = of_[64 * j]; nb[j] = ob_[64 * j]; nz[j] = *(const u32x2*)(zr_ + 256 * j); } } while (0)
    if (gw < NTOK_) OD_LOAD(gw);
    for (int row = gw; row < NTOK_; row += NGW) {
        u32x2 pf[4], pb[4], pz[4];
#pragma unroll
        for (int j = 0; j < 4; ++j) { pf[j] = nf[j]; pb[j] = nb[j]; pz[j] = nz[j]; }
        if (row + NGW < NTOK_) OD_LOAD(row + NGW);
        u32x2* od = WSP(u32x2, WS_H) + (size_t)row * 256 + F.lane;
#pragma unroll
        for (int j = 0; j < 4; ++j) { const u32x2 p = pf[j], q = pb[j]; const u32x2 z = pz[j];
            f32x4 o = (f32x4){bf_lo(p.x) + bf_lo(q.x), bf_hi(p.x) + bf_hi(q.x), bf_lo(p.y) + bf_lo(q.y), bf_hi(p.y) + bf_hi(q.y)};
            float ss = (o.x * o.x + o.y * o.y) + (o.z * o.z + o.w * o.w);
            ss = sum32(ss, F.lane);
            const float r = rsqrtf(ss * (1.f / 128.f) + EPS);
            o = o * r * on;
            o.x *= siluf_(bf_lo(z.x)); o.y *= siluf_(bf_hi(z.x)); o.z *= siluf_(bf_lo(z.y)); o.w *= siluf_(bf_hi(z.y));
            od[64 * j] = (u32x2){pk2(o.x, o.y), pk2(o.z, o.w)}; }
    }
#undef OD_LOAD
}

struct SchedMain {
    const char* H; const char* W; int G, c;
    __device__ __forceinline__ bool next(int i, Unit& u) const {
        int L = i * G + c; constexpr int NM = NTILE * 25;
        if (REPS(2) > 1 && L >= NM + 2 * NTILE) L -= NM + 2 * NTILE - 0;
        if (REPS(2) > 1 ? (i * G + c >= NM + 2 * NTILE + 768) : (L >= NM + 2 * NTILE)) return false;
        if (L < NM) { int pm, pn; pg8::tile_map(L, NTILE, 25, pm, pn); u.pm = pm; u.pn = pn; u.aux = 0; }
        else { const int f = L - NM; u.pm = f & 1; u.pn = f >> 1; u.aux = 1; }
        return true;
    }
    __device__ __forceinline__ const char* a_ptr(const Unit& u) const { return u.aux ? W + (size_t)(PM_LD + u.pm * 256) * D * 2 : H + (size_t)u.pm * 256 * D * 2; }
    __device__ __forceinline__ const char* b_ptr(const Unit& u) const { return u.aux ? H + (size_t)u.pn * 256 * D * 2 : W + (size_t)u.pn * 256 * D * 2; }
};
#define EPI_LANE_IDX int tz_ = threadIdx.x; asm volatile("" : "+v"(tz_)); const int wr_ = tz_ >> 8, wc_ = (tz_ >> 6) & 3, fr_ = tz_ & 15, fq_ = (tz_ >> 4) & 3; (void)wr; (void)wc; (void)fr; (void)fq;
#define EPI_ROWS_BEGIN EPI_LANE_IDX const int rbase = wr_ * 64 + fr_, cbase = wc_ * 32 + 8 * fq_; (void)rbase; (void)cbase;
struct EpiMain {
    static constexpr bool PERM = true;
    bf16* PM; bf16* UTL; bf16* UTC;
    __device__ __forceinline__ void operator()(const f32x4 (&acc)[2][2][4][2], const Unit& u, int wr, int wc, int fr, int fq) const {
        EPI_ROWS_BEGIN
#pragma unroll
        for (int ai = 0; ai < 2; ++ai)
#pragma unroll
            for (int m = 0; m < 4; ++m) { const int r = ai * 128 + m * 16 + rbase;
                bf16* rowp;
                if (u.aux == 0) rowp = PM + (size_t)(u.pm * 256 + r) * PM_LD + u.pn * 256 + cbase;
                else { const int ch = u.pm * 256 + r;
                    if (u.pn < 8) rowp = UTC + ((size_t)(u.pn * 512 + ch)) * 256 + cbase;
                    else { const int q = u.pn - 8; rowp = UTL + ((size_t)((q >> 4) * 512 + ch)) * 4096 + (q & 15) * 256 + cbase; } }
#pragma unroll
                for (int bj = 0; bj < 2; ++bj) { const f32x4 v0 = acc[ai][bj][m][0], v1 = acc[ai][bj][m][1];
                    *(u32x4*)(rowp + bj * 128) = (u32x4){cvt_pk_bf16(v0[0], v0[1]), cvt_pk_bf16(v0[2], v0[3]), cvt_pk_bf16(v1[0], v1[1]), cvt_pk_bf16(v1[2], v1[3])}; } }
    }
};
template <int LAT> struct SchedDft {
    const char* A; const char* B; int G, c;
    __device__ __forceinline__ bool next(int i, Unit& u) const {
        const int L = i * G + c;
        if (LAT) { if (L >= 256) return false; u.aux = L >> 5; u.pm = (L & 31) >> 1; u.pn = L & 1; }
        else { if (L >= 32) return false; u.aux = L >> 2; u.pm = (L >> 1) & 1; u.pn = L & 1; }
        return true;
    }
    __device__ __forceinline__ const char* a_ptr(const Unit& u) const { return A + (size_t)u.pm * 256 * (LAT ? 4096 : 256) * 2; }
    __device__ __forceinline__ const char* b_ptr(const Unit& u) const { return B + ((size_t)u.aux * 512 + u.pn * 256) * (LAT ? 4096 : 256) * 2; }
};
template <int LAT> struct EpiDft {
    static constexpr bool PERM = true;
    bf16* PBUF;
    __device__ __forceinline__ void operator()(const f32x4 (&acc)[2][2][4][2], const Unit& u, int wr, int wc, int fr, int fq) const {
        EPI_ROWS_BEGIN
        const int ri = LAT ? (u.pm >> 3) : u.pm;
        const int tokb = LAT ? (NCTX + u.aux * 4096) : (u.aux * 256);
        const int t0 = LAT ? (u.pm & 7) * 256 : 0;
        const unsigned sgn = ri ? 0x80008000u : 0u;
#pragma unroll
        for (int ai = 0; ai < 2; ++ai)
#pragma unroll
            for (int m = 0; m < 4; ++m) { const int tp = t0 + ai * 128 + m * 16 + rbase;
#pragma unroll
                for (int bj = 0; bj < 2; ++bj) { const int ch = u.pn * 256 + bj * 128 + cbase; const f32x4 v0 = acc[ai][bj][m][0], v1 = acc[ai][bj][m][1];
                    const u32x4 w = (u32x4){cvt_pk_bf16(v0[0], v0[1]), cvt_pk_bf16(v0[2], v0[3]), cvt_pk_bf16(v1[0], v1[1]), cvt_pk_bf16(v1[2], v1[3])};
                    const size_t colo = (size_t)(ch >> 7) * 256 + ri * 128 + (ch & 127);
                    *(u32x4*)(PBUF + (size_t)(tokb + tp) * D + colo) = w;
                    if (LAT && tp > 0) *(u32x4*)(PBUF + (size_t)(tokb + 4096 - tp) * D + colo) = (u32x4){w.x ^ sgn, w.y ^ sgn, w.z ^ sgn, w.w ^ sgn}; } }
    }
};
__device__ __forceinline__ void dft_row2048(Frame& F, int wg0) {
    const int gw = (F.bid - wg0) * 8 + F.wave, NGW = (F.G - wg0) * 8;
    for (int rw = gw; rw < NB * 512; rw += NGW) { const int b = rw >> 9, ch = rw & 511;
        const u32x4* up = (const u32x4*)(WSP(bf16, WS_UTL) + (size_t)rw * 4096) + F.lane;
        float s = 0.f;
#pragma unroll
        for (int j = 0; j < 8; ++j) { const u32x4 q = up[64 * j];
            s += (bf_lo(q.x) - bf_hi(q.x)) + (bf_lo(q.y) - bf_hi(q.y)) + (bf_lo(q.z) - bf_hi(q.z)) + (bf_lo(q.w) - bf_hi(q.w)); }
        s = wave_sum(s) * (1.f / 64.f);
        if (F.lane == 0) { bf16* o = WSP(bf16, WS_PBUF) + (size_t)(NCTX + b * 4096 + 2048) * D + (ch >> 7) * 256 + (ch & 127); o[0] = (bf16)f2bf(s); o[128] = 0; }
    }
}
__device__ __forceinline__ bf16* ma_tile(unsigned char GAS* ws, int pm) {
    size_t off;
    if (pm < 8) off = WS_MAC + (size_t)pm * 256 * D * 2;
    else { const int q = pm - 8, b = q >> 4;
        off = (b < 4 ? WS_MA0 + (size_t)q * 256 * D * 2 : b < 7 ? WS_MA1 + (size_t)(q - 64) * 256 * D * 2 : WS_MA2 + (size_t)(q - 112) * 256 * D * 2); }
    return (bf16*)(GAS bf16*)(ws + off);
}
struct SchedRows {
    const char* A; const char* B; int G, c, Lbeg, Lend, pm0, nM;
    __device__ __forceinline__ bool next(int i, Unit& u) const {
        const int L = Lbeg + i * G + c; if (L >= Lend) return false;
        int pm, pn; pg8::tile_map(L, nM, 4, pm, pn); u.pm = pm0 + pm; u.pn = pn; u.aux = 0; return true;
    }
    __device__ __forceinline__ const char* a_ptr(const Unit& u) const { return A + (size_t)u.pm * 256 * D * 2; }
    __device__ __forceinline__ const char* b_ptr(const Unit& u) const { return B + (size_t)u.pn * 256 * D * 2; }
};
template <int MODE> struct EpiGate {
    static constexpr bool PERM = true;
    bf16* M; const bf16* PM; unsigned char GAS* ws;
    __device__ __forceinline__ void operator()(const f32x4 (&acc)[2][2][4][2], const Unit& u, int wr, int wc, int fr, int fq) const {
        EPI_ROWS_BEGIN
        bf16* mat = ma_tile(ws, u.pm);
#pragma unroll
        for (int ai = 0; ai < 2; ++ai) {
            u32x4 gq[4][2], pq[4][2];
#pragma unroll
            for (int m = 0; m < 4; ++m)
#pragma unroll
                for (int bj = 0; bj < 2; ++bj) { const int rt = ai * 128 + m * 16 + rbase, col = u.pn * 256 + bj * 128 + cbase;
                    gq[m][bj] = *(const u32x4*)(PM + (size_t)(u.pm * 256 + rt) * PM_LD + (MODE == 0 ? PM_GA : PM_GB) + col);
                    if (MODE == 1) pq[m][bj] = *(const u32x4*)(mat + (size_t)rt * D + col); }
#pragma unroll
            for (int m = 0; m < 4; ++m) { const int rt = ai * 128 + m * 16 + rbase, row = u.pm * 256 + rt;
#pragma unroll
                for (int bj = 0; bj < 2; ++bj) { const int col = u.pn * 256 + bj * 128 + cbase; const f32x4 v0 = acc[ai][bj][m][0], v1 = acc[ai][bj][m][1];
                    const u32x4 g = gq[m][bj];
                    float o[8] = {v0[0] * sigmoidf_(bf_lo(g.x)), v0[1] * sigmoidf_(bf_hi(g.x)), v0[2] * sigmoidf_(bf_lo(g.y)), v0[3] * sigmoidf_(bf_hi(g.y)),
                                  v1[0] * sigmoidf_(bf_lo(g.z)), v1[1] * sigmoidf_(bf_hi(g.z)), v1[2] * sigmoidf_(bf_lo(g.w)), v1[3] * sigmoidf_(bf_hi(g.w))};
                    if (MODE == 1) { const u32x4 p = pq[m][bj]; o[0] += bf_lo(p.x); o[1] += bf_hi(p.x); o[2] += bf_lo(p.y); o[3] += bf_hi(p.y); o[4] += bf_lo(p.z); o[5] += bf_hi(p.z); o[6] += bf_lo(p.w); o[7] += bf_hi(p.w); }
                    u32x4* mp = (MODE == 1) ? (u32x4*)(M + (size_t)row * D + col) : (u32x4*)(mat + (size_t)rt * D + col);
                    *mp = (u32x4){cvt_pk_bf16(o[0], o[1]), cvt_pk_bf16(o[2], o[3]), cvt_pk_bf16(o[4], o[5]), cvt_pk_bf16(o[6], o[7])}; } }
        }
    }
};
__device__ __forceinline__ void sub_barrier(unsigned* ctr, unsigned n) {
    asm volatile("s_waitcnt vmcnt(0)" ::: "memory");
    __syncthreads();
    if (threadIdx.x == 0) {
        __builtin_amdgcn_fence(__ATOMIC_RELEASE, "agent");
        asm volatile("s_waitcnt vmcnt(0)" ::: "memory");
        (void)xb_add(ctr, 1u);
        unsigned sp = 0; while (xb_ld(ctr) < n && ++sp < (1u << 22)) __builtin_amdgcn_s_sleep(1);
        __builtin_amdgcn_fence(__ATOMIC_ACQUIRE, "agent");
        asm volatile("s_waitcnt vmcnt(0)" ::: "memory");
    }
    __syncthreads();
}
__device__ __forceinline__ void sub_arrive(unsigned* ctr) {
    asm volatile("s_waitcnt vmcnt(0)" ::: "memory");
    __syncthreads();
    if (threadIdx.x == 0) { __builtin_amdgcn_fence(__ATOMIC_RELEASE, "agent"); asm volatile("s_waitcnt vmcnt(0)" ::: "memory"); (void)xb_add(ctr, 1u); }
}
__device__ __forceinline__ void sub_wait(unsigned* ctr, unsigned n) {
    if (threadIdx.x == 0) {
        unsigned sp = 0; while (xb_ld(ctr) < n && ++sp < (1u << 22)) __builtin_amdgcn_s_sleep(1);
        __builtin_amdgcn_fence(__ATOMIC_ACQUIRE, "agent");
        asm volatile("s_waitcnt vmcnt(0)" ::: "memory");
    }
    __syncthreads();
}
struct EpiResid {
    static constexpr bool PERM = false;
    float* X; const float* MODL;
    __device__ __forceinline__ void operator()(const f32x4 (&acc)[2][2][4][2], const Unit& u, int wr, int wc, int fr, int fq) const {
        EPI_LANE_IDX
        const int rbase = wr_ * 64 + fr_, cb = u.pn * 256 + wc_ * 32 + 4 * fq_;
        const int mb = mod_row(u.pm * 256);
        f32x4 gv[2][2];
#pragma unroll
        for (int bj = 0; bj < 2; ++bj)
#pragma unroll
            for (int n = 0; n < 2; ++n) gv[bj][n] = *(const f32x4*)(MODL + (size_t)mb * 6144 + 2048 + cb + bj * 128 + n * 16);
#pragma unroll
        for (int ai = 0; ai < 2; ++ai) {
            f32x4 xq[4][2][2];
#pragma unroll
            for (int m = 0; m < 4; ++m)
#pragma unroll
                for (int bj = 0; bj < 2; ++bj)
#pragma unroll
                    for (int n = 0; n < 2; ++n) xq[m][bj][n] = *(const f32x4*)(X + (size_t)(u.pm * 256 + ai * 128 + m * 16 + rbase) * D + cb + bj * 128 + n * 16);
#pragma unroll
            for (int m = 0; m < 4; ++m)
#pragma unroll
                for (int bj = 0; bj < 2; ++bj)
#pragma unroll
                    for (int n = 0; n < 2; ++n) *(f32x4*)(X + (size_t)(u.pm * 256 + ai * 128 + m * 16 + rbase) * D + cb + bj * 128 + n * 16) = xq[m][bj][n] + gv[bj][n] * acc[ai][bj][m][n];
        }
    }
};
template <int KD, bool GATH = false> struct SchedMoe {
    const char* A; const char* W; volatile LAS unsigned* LCTL; int G, c, ntile;
    __device__ __forceinline__ bool next(int i, Unit& u) const {
        const int cr = ((G & 7) || (i + 1) * G > ntile * 4) ? c : (c & 7) * (G >> 3) + (c >> 3);
        const int L = i * G + cr;
        if (L >= ntile * 4) return false;
        u.pm = L >> 2; u.pn = L & 3; u.aux = __builtin_amdgcn_readfirstlane((int)LCTL[128 + (L >> 2)]); return true;
    }
    __device__ __forceinline__ const char* a_ptr(const Unit& u) const { return GATH ? A : A + (size_t)u.pm * 256 * KD * 2; }
    __device__ __forceinline__ const char* b_ptr(const Unit& u) const { return W + ((size_t)u.aux * 1024 + u.pn * 256) * KD * 2; }
};
struct EpiGU {
    static constexpr bool PERM = true;
    bf16* HID;
    __device__ __forceinline__ void operator()(const f32x4 (&acc)[2][2][4][2], const Unit& u, int wr, int wc, int fr, int fq) const {
        EPI_ROWS_BEGIN
#pragma unroll
        for (int ai = 0; ai < 2; ++ai)
#pragma unroll
            for (int m = 0; m < 4; ++m) { const int row = u.pm * 256 + ai * 128 + m * 16 + rbase;
#pragma unroll
                for (int bj = 0; bj < 2; ++bj) { const f32x4 v0 = acc[ai][bj][m][0], v1 = acc[ai][bj][m][1];
                    *(u32x2*)(HID + (size_t)row * EDIM + u.pn * 128 + ((bj * 128 + cbase) >> 1)) =
                        (u32x2){cvt_pk_bf16(siluf_(v0[0]) * v0[1], siluf_(v0[2]) * v0[3]), cvt_pk_bf16(siluf_(v1[0]) * v1[1], siluf_(v1[2]) * v1[3])}; } }
    }
};
struct EpiDown {
    static constexpr bool PERM = true;
    bf16* YS;
    __device__ __forceinline__ void operator()(const f32x4 (&acc)[2][2][4][2], const Unit& u, int wr, int wc, int fr, int fq) const {
        EPI_ROWS_BEGIN
#pragma unroll
        for (int ai = 0; ai < 2; ++ai)
#pragma unroll
            for (int m = 0; m < 4; ++m) { const int row = u.pm * 256 + ai * 128 + m * 16 + rbase;
#pragma unroll
                for (int bj = 0; bj < 2; ++bj) { const f32x4 v0 = acc[ai][bj][m][0], v1 = acc[ai][bj][m][1];
                    *(u32x4*)(YS + (size_t)row * D + u.pn * 256 + bj * 128 + cbase) = (u32x4){cvt_pk_bf16(v0[0], v0[1]), cvt_pk_bf16(v0[2], v0[3]), cvt_pk_bf16(v1[0], v1[1]), cvt_pk_bf16(v1[2], v1[3])}; } }
    }
};

constexpr int PH_PER_LAYER = 11, PH_FINAL = 1 + DEPTH * PH_PER_LAYER, N_PHASES = PH_FINAL + 1;
__global__ void __launch_bounds__(512, 2) fwd_kernel(Args args) {
    extern __shared__ __attribute__((aligned(16))) unsigned char lds[];
    Frame F;
    F.lds = (LAS unsigned char*)lds; F.LCTL = (volatile LAS unsigned*)(F.lds + LDSCTL_OFF);
    F.ws = (GAS unsigned char*)args.ws; F.tid = threadIdx.x; F.lane = F.tid & 63; F.wave = __builtin_amdgcn_readfirstlane(F.tid >> 6); F.G = gridDim.x; F.bid = blockIdx.x;
    for (int u = F.tid; u < 512; u += 512) F.LCTL[u] = 0u;
    if (F.tid < 25) { const unsigned long long p = (F.tid < 24) ? (unsigned long long)args.in[F.tid] : (unsigned long long)args.out; F.LCTL[512 + 2 * F.tid] = (unsigned)p; F.LCTL[513 + 2 * F.tid] = (unsigned)(p >> 32); }
    __syncthreads();
    XcdBarrier bar; bar.bar = WSP(unsigned, WS_CTL) + CW_BAR; bar.x = 0; bar.st = F.LCTL;
    if (ONE_LAUNCH) bar = xcd_barrier_post(WSP(unsigned, WS_CTL) + CW_BAR, F.LCTL);
    const int lo = args.ph_lo, hi = args.ph_hi;
#define IN(k) (lo <= (k) && (k) < hi)
#ifdef PROBE_MASK
    unsigned long long t_last = __builtin_amdgcn_s_memrealtime(), t_sum = 0;
#define PSTAMP(type) do { const unsigned long long now_ = __builtin_amdgcn_s_memrealtime(); if ((PROBE_MASK >> (type)) & 1) t_sum += now_ - t_last; t_last = now_; } while (0)
#else
#define PSTAMP(type) do {} while (0)
#endif
#define SEAM(k) do { if (IN(k) && IN((k) + 1)) { XcdBarrier b2_ = bar; GAS unsigned* gb_ = (GAS unsigned*)b2_.bar; asm volatile("" : "+s"(gb_)); b2_.bar = (unsigned*)gb_; xcd_barrier(b2_); } } while (0)

    if (PHON(0) && IN(0)) { LAUNDER(F); for (int rep_ = 0; rep_ < REPS(0); ++rep_) phase_prologue(F, args); SEAM(0); PSTAMP(0); }

    for (int layer = 0; layer < DEPTH; ++layer) {
        const int pb = 1 + layer * PH_PER_LAYER;
        const char* WL = (const char*)(WSP(bf16, WS_WIN) + (size_t)layer * WIN_ROWS * D);
        if (PHON(1) && IN(pb + 0)) { LAUNDER(F); if (layer == 0) phase_norm<0, false>(F, args, layer); else phase_norm<0, true>(F, args, layer); if (REPS(1) > 1) { LAUNDER(F); phase_norm<0, false>(F, args, layer); } SEAM(pb + 0); PSTAMP(1); }
        if (PHON(2) && IN(pb + 1)) { LAUNDER(F);
            SchedMain S{(const char*)WSP(bf16, WS_H), WL, F.G, F.bid}; EpiMain E{WSP(bf16, WS_PM), WSP(bf16, WS_UTL), WSP(bf16, WS_UTC)};
            pg8::gemm_phase<EpiMain, SchedMain>(F.lds, D, D, D, S, E);
            SEAM(pb + 1); PSTAMP(2);
        }
        if (PHON(3) && IN(pb + 2)) { LAUNDER(F);
            phase_conv<false>(F, args, layer);
            if (REPS(18) > 1) { LAUNDER(F); phase_conv<true>(F, args, layer); }
            SEAM(pb + 2); PSTAMP(3);
        }
        if (PHON(4) && IN(pb + 3)) { LAUNDER(F); phase_prep(F, false); if (REPS(4) > 1) phase_prep(F, true); SEAM(pb + 3); PSTAMP(4); }
        if (PHON(13) && IN(pb + 4)) { LAUNDER(F);
            if (F.bid < 128) phase_scan(F);
            else {
            LAUNDER(F);
            { SchedDft<1> S{(const char*)WSP(bf16, WS_DFTL), (const char*)WSP(bf16, WS_UTL), F.G - 128, F.bid - 128}; EpiDft<1> E{WSP(bf16, WS_PBUF)};
              for (int rep_ = 0; rep_ < REPS(3); ++rep_) pg8::gemm_phase<EpiDft<1>, SchedDft<1>>(F.lds, 4096, 4096, 4096, S, E); }
            { SchedDft<0> S{(const char*)WSP(bf16, WS_DFTC), (const char*)WSP(bf16, WS_UTC), F.G - 128, F.bid - 128}; EpiDft<0> E{WSP(bf16, WS_PBUF)};
              pg8::gemm_phase<EpiDft<0>, SchedDft<0>>(F.lds, 256, 256, 256, S, E); }
            LAUNDER(F); dft_row2048(F, 128);
            sub_barrier(WSP(unsigned, WS_CTL) + CW_SUB + layer * 64, (unsigned)(F.G - 128));
            LAUNDER(F);
            { SchedRows S{(const char*)WSP(bf16, WS_PBUF), (const char*)(WSP(bf16, WS_WPA) + (size_t)layer * D * D), F.G - 128, F.bid - 128, 0, NTILE * 4, 0, NTILE}; EpiGate<0> E{nullptr, WSP(bf16, WS_PM), F.ws};
              pg8::gemm_phase<EpiGate<0>, SchedRows>(F.lds, D, D, D, S, E); }
            }
            SEAM(pb + 4); PSTAMP(5); }
        if (PHON(5) && IN(pb + 5)) { LAUNDER(F);
            const bool chain = layer < DEPTH - 1;
            unsigned* sb = WSP(unsigned, WS_CTL) + CW_SUB + layer * 64;
            if (chain) { phase_od(F, args, layer, 0, NCTX, 0, F.G); sub_arrive(sb + 16); LAUNDER(F); }
            if (chain && F.bid < 32) {
                sub_wait(sb + 16, (unsigned)F.G);
                LAUNDER(F);
                { SchedRows S{(const char*)WSP(bf16, WS_H), (const char*)(WSP(bf16, WS_WDL) + (size_t)layer * D * D), 32, F.bid, 0, 32, 0, 8}; EpiGate<1> E{WSP(bf16, WS_OF), WSP(bf16, WS_PM), F.ws};
                  pg8::gemm_phase<EpiGate<1>, SchedRows>(F.lds, D, D, D, S, E); }
                sub_barrier(sb + 32, 32u);
                LAUNDER(F);
                { SchedRows S{(const char*)WSP(bf16, WS_OF), (const char*)(WSP(bf16, WS_WOUT) + (size_t)layer * D * D), 32, F.bid, 0, 32, 0, 8}; EpiResid E{WSP(float, WS_X), WSP(float, WS_MOD) + (size_t)layer * 9 * 6144};
                  pg8::gemm_phase<EpiResid, SchedRows>(F.lds, D, D, D, S, E); }
            } else {
                const int wg0 = chain ? 32 : 0;
                for (int rep_ = 0; rep_ < REPS(6); ++rep_) { phase_od(F, args, layer, NCTX, NTOK, wg0, F.G - wg0); }
                for (int rep2_ = 0; rep2_ < REPS(19); ++rep2_) {LAUNDER(F); moe_weight_convert(F, layer, true, wg0, (LAS float*)(F.lds + F.wave * 16640)); moe_weight_convert(F, layer, false, wg0, (LAS float*)(F.lds + F.wave * 16640)); }
            }
            SEAM(pb + 5); PSTAMP(6); }
        if (PHON(6) && IN(pb + 6)) { LAUNDER(F);
            { SchedRows S{(const char*)WSP(bf16, WS_H), (const char*)(WSP(bf16, WS_WDL) + (size_t)layer * D * D), F.G, F.bid, 0, 512, 8, NTILE - 8}; EpiGate<1> E{WSP(bf16, WS_OF), WSP(bf16, WS_PM), F.ws};
              pg8::gemm_phase<EpiGate<1>, SchedRows>(F.lds, D, D, D, S, E);
              if (REPS(7) > 1) { LAUNDER(F); pg8::gemm_phase<EpiGate<1>, SchedRows>(F.lds, D, D, D, S, E); } }
            SEAM(pb + 6); PSTAMP(7);
        }
        if (PHON(7) && IN(pb + 7)) { LAUNDER(F);
            SchedRows S{(const char*)WSP(bf16, WS_OF), (const char*)(WSP(bf16, WS_WOUT) + (size_t)layer * D * D), F.G, F.bid, 0, 512, 8, NTILE - 8}; EpiResid E{WSP(float, WS_X), WSP(float, WS_MOD) + (size_t)layer * 9 * 6144};
            pg8::gemm_phase<EpiResid, SchedRows>(F.lds, D, D, D, S, E);
            SEAM(pb + 7); PSTAMP(8);
        }
        if (PHON(8) && IN(pb + 8)) { LAUNDER(F); phase_route(F, args, layer, false); if (REPS(9) > 1) { LAUNDER(F); phase_route(F, args, layer, true); } SEAM(pb + 8); PSTAMP(9); }
        if (PHON(10) && IN(pb + 9)) { LAUNDER(F);
            build_moe_tables(F, layer);
            SchedMoe<D, true> S{(const char*)WSP(bf16, WS_H), (const char*)WSP(bf16, WS_MOEW), F.LCTL, F.G, F.bid, __builtin_amdgcn_readfirstlane((int)(F.LCTL[16 + NEXP] >> 8))}; EpiGU E{WSP(bf16, WS_HID)};
            { LAS unsigned* gi = (LAS unsigned*)(F.lds + 131072); Unit u;
              int tokv[3];
#pragma unroll
              for (int ii = 0; ii < 3; ++ii) { const int i = 2 * ii + (F.tid >> 8); tokv[ii] = -1;
                  if (S.next(i, u)) { const int e = u.aux, t0 = (u.pm << 8) - (int)F.LCTL[16 + e], cnt = (int)F.LCTL[64 + e];
                      const int rk = t0 + (F.tid & 255); tokv[ii] = rk < cnt ? WSP(int, WS_TOKOF)[(size_t)e * NTOK + rk] : NTOK; } }
#pragma unroll
              for (int ii = 0; ii < 3; ++ii) if (tokv[ii] >= 0) gi[(2 * ii + (F.tid >> 8)) * 256 + (F.tid & 255)] = (unsigned)tokv[ii] * (unsigned)(D * 2);
              for (int i = 6; S.next(i, u); ++i) { const int e = u.aux, t0 = (u.pm << 8) - (int)F.LCTL[16 + e], cnt = (int)F.LCTL[64 + e];
                  if (F.tid < 256) { const int rk = t0 + F.tid; const int tok = rk < cnt ? WSP(int, WS_TOKOF)[(size_t)e * NTOK + rk] : NTOK; gi[i * 256 + F.tid] = (unsigned)tok * (unsigned)(D * 2); } }
              __syncthreads(); }
            for (int rep_ = 0; rep_ < REPS(11); ++rep_) pg8::gemm_phase<EpiGU, SchedMoe<D, true>, true>(F.lds, D, D, D, S, E, (const LAS unsigned*)(F.lds + 131072));
            SEAM(pb + 9); PSTAMP(11);
        }
        if (PHON(11) && IN(pb + 10)) { LAUNDER(F);
            build_moe_tables(F, layer);
            SchedMoe<EDIM> S{(const char*)WSP(bf16, WS_HID), (const char*)WSP(bf16, WS_MOEWD), F.LCTL, F.G, F.bid, __builtin_amdgcn_readfirstlane((int)(F.LCTL[16 + NEXP] >> 8))}; EpiDown E{WSP(bf16, WS_YS)};
            for (int rep_ = 0; rep_ < REPS(12); ++rep_) pg8::gemm_phase<EpiDown, SchedMoe<EDIM>>(F.lds, EDIM, EDIM, EDIM, S, E);
            SEAM(pb + 10); PSTAMP(12);
        }
    }
    float out_scale = 1.f;
#ifdef PROBE_MASK
    if (F.bid == 0 && F.tid == 0) __hip_atomic_store(WSP(unsigned, WS_CTL) + 32, (unsigned)t_sum, __ATOMIC_RELAXED, __HIP_MEMORY_SCOPE_AGENT);
    { XcdBarrier b2_ = bar; GAS unsigned* gb_ = (GAS unsigned*)b2_.bar; asm volatile("" : "+s"(gb_)); b2_.bar = (unsigned*)gb_; xcd_barrier(b2_); }
    out_scale = 1.f + (float)__hip_atomic_load(WSP(unsigned, WS_CTL) + 32, __ATOMIC_RELAXED, __HIP_MEMORY_SCOPE_AGENT) * 1e-5f;
#endif
    if (PHON(12) && IN(PH_FINAL)) { LAUNDER(F); phase_norm<1, true>(F, args, DEPTH, out_scale); }
#undef IN
#undef SEAM
}

extern "C" void kernel_launch(void* const* d_in, const int* in_sizes, int n_in, void* d_out, int out_size, void* d_ws, size_t ws_size, hipStream_t stream) {
    static int grid = 0;
    if (grid == 0) {
        if (n_in != 24 || out_size != NLAT * D || ws_size < WS_END) { fprintf(stderr, "kernel_launch: unexpected problem (n_in %d, out %d, ws %zu < %zu)\n", n_in, out_size, ws_size, (size_t)WS_END); grid = -1; return; }
        int dev = 0, cus = 0, per_cu = 0;
        if (hipGetDevice(&dev) != hipSuccess || hipDeviceGetAttribute(&cus, hipDeviceAttributeMultiprocessorCount, dev) != hipSuccess) { grid = -1; return; }
        if (hipFuncSetAttribute((const void*)fwd_kernel, hipFuncAttributeMaxDynamicSharedMemorySize, LDS_BYTES) != hipSuccess) { fprintf(stderr, "kernel_launch: hipFuncSetAttribute failed\n"); grid = -1; return; }
        if (hipOccupancyMaxActiveBlocksPerMultiprocessor(&per_cu, (const void*)fwd_kernel, 512, LDS_BYTES) != hipSuccess || per_cu < 1) fprintf(stderr, "kernel_launch: occupancy query reports %d\n", per_cu);
        (void)hipGetLastError();
        grid = cus;
    }
    if (grid < 0) return;
    hipMemsetAsync((char*)d_ws + WS_CTL, 0, CTL_ZERO_BYTES, stream);
    Args a{};
    for (int i = 0; i < 24; ++i) a.in[i] = (const float*)d_in[i];
    a.out = (float*)d_out; a.ws = (unsigned char*)d_ws;
#if ONE_LAUNCH
    a.ph_lo = 0; a.ph_hi = N_PHASES;
    hipLaunchKernelGGL(fwd_kernel, dim3(grid), dim3(512), LDS_BYTES, stream, a);
#else
    for (int p = 0; p < N_PHASES; ++p) { a.ph_lo = p; a.ph_hi = p + 1; hipLaunchKernelGGL(fwd_kernel, dim3(grid), dim3(512), LDS_BYTES, stream, a); }
#endif
}
```
